# Optimizing an MI355X kernel written in HIP

```python
import jax
import jax.numpy as jnp
from jax import lax

D_MODEL = 1024
BATCH = 8
SEQ = 8192
DEPTH = 2

GLA_HEADS = 4
GLA_DK = 64
GLA_DV = 128
GLA_RANK = 16
GLA_TAU = 16.0
GLA_CHUNK = 64
SWA_HEADS = 8
SWA_KV_HEADS = 2
SWA_HD = 64
WINDOW = 128
ROPE_DIMS = SWA_HD // 4
ROPE_THETA = 500000.0
N_EXPERTS = 16
N_GROUPS = 4
EXPERTS_PER_GROUP = N_EXPERTS // N_GROUPS
TOP_K = 2
D_FF = 512
MOE_BLOCK = 128
EPS = 1e-6
POS_OFFSET_MAX = 1024
IN_WIDTH = 2 * GLA_HEADS * GLA_DK + 2 * GLA_HEADS * GLA_DV + GLA_RANK + SWA_HEADS * SWA_HD + 2 * SWA_KV_HEADS * SWA_HD + 2 * D_MODEL

kernel_name = "hybrid_gla_swa_sink_grouped_moe_adaln"


def rms_norm(x, g):
    xf = x.astype(jnp.float32)
    y = xf * lax.rsqrt(jnp.mean(xf * xf, axis=-1, keepdims=True) + EPS)
    return (y * g).astype(x.dtype)


def partial_rope(x, positions):
    half = ROPE_DIMS // 2
    inv_freq = jnp.power(ROPE_THETA, -jnp.arange(half, dtype=jnp.float32) / half)
    ang = positions.astype(jnp.float32)[..., None] * inv_freq
    cos = jnp.cos(ang)[:, :, None, :]
    sin = jnp.sin(ang)[:, :, None, :]
    xr = x[..., :ROPE_DIMS].astype(jnp.float32)
    x1, x2 = xr[..., :half], xr[..., half:]
    rot = jnp.concatenate([x1 * cos - x2 * sin, x2 * cos + x1 * sin], axis=-1)
    return jnp.concatenate([rot.astype(x.dtype), x[..., ROPE_DIMS:]], axis=-1)


def split_columns(z):
    sizes = (GLA_HEADS * GLA_DK, GLA_HEADS * GLA_DK, GLA_HEADS * GLA_DV, GLA_RANK, GLA_HEADS * GLA_DV,
             SWA_HEADS * SWA_HD, SWA_KV_HEADS * SWA_HD, SWA_KV_HEADS * SWA_HD, D_MODEL, D_MODEL)
    idx, acc = [], 0
    for s in sizes[:-1]:
        acc += s
        idx.append(acc)
    return jnp.split(z, idx, axis=-1)


def gla_branch(q, k, v, a_low, r, w_alpha2, b_alpha, gn_gain):
    B, S, _ = q.shape
    N = S // GLA_CHUNK
    f32 = jnp.float32
    shp_k = (B, N, GLA_CHUNK, GLA_HEADS, GLA_DK)
    shp_v = (B, N, GLA_CHUNK, GLA_HEADS, GLA_DV)
    log_a = jax.nn.log_sigmoid((a_low @ w_alpha2 + b_alpha).astype(f32)) / GLA_TAU
    b = jnp.cumsum(log_a.reshape(shp_k), axis=2)
    q = q.astype(f32).reshape(shp_k) * (GLA_DK ** -0.5)
    k = k.astype(f32).reshape(shp_k)
    v = v.astype(f32).reshape(shp_v)
    q_dec = q * jnp.exp(b)
    k_inv = k * jnp.exp(-b)
    causal = jnp.tril(jnp.ones((GLA_CHUNK, GLA_CHUNK), dtype=bool))
    att = jnp.where(causal, jnp.einsum('bnihd,bnjhd->bnhij', q_dec, k_inv), 0.0)
    o_intra = jnp.einsum('bnhij,bnjhe->bnihe', att, v)
    b_end = b[:, :, -1]
    k_end = k * jnp.exp(b_end[:, :, None] - b)
    kv = jnp.einsum('bnjhd,bnjhe->nbhde', k_end, v)

    def step(state, inp):
        decay, kv_n = inp
        return decay[..., None] * state + kv_n, state

    s0 = jnp.zeros((B, GLA_HEADS, GLA_DK, GLA_DV), f32)
    _, s_prev = lax.scan(step, s0, (jnp.exp(b_end).transpose(1, 0, 2, 3), kv))
    o_inter = jnp.einsum('bnihd,nbhde->bnihe', q_dec, s_prev)
    o = (o_intra + o_inter).reshape(B, S, GLA_HEADS, GLA_DV)
    o = rms_norm(o, gn_gain.reshape(GLA_HEADS, GLA_DV))
    return (o.reshape(B, S, GLA_HEADS * GLA_DV) * jax.nn.silu(r.astype(f32))).astype(r.dtype)


def swa_branch(q, k, v, positions, qn_gain, kn_gain, sinks):
    B, S, _ = q.shape
    N = S // WINDOW
    G = SWA_HEADS // SWA_KV_HEADS
    q = partial_rope(rms_norm(q.reshape(B, S, SWA_HEADS, SWA_HD), qn_gain), positions)
    k = partial_rope(rms_norm(k.reshape(B, S, SWA_KV_HEADS, SWA_HD), kn_gain), positions)
    v = v.reshape(B, S, SWA_KV_HEADS, SWA_HD)
    qb = q.reshape(B, N, WINDOW, SWA_KV_HEADS, G, SWA_HD)
    kb = k.reshape(B, N, WINDOW, SWA_KV_HEADS, SWA_HD)
    vb = v.reshape(B, N, WINDOW, SWA_KV_HEADS, SWA_HD)
    pad = ((0, 0), (1, 0), (0, 0), (0, 0), (0, 0))
    k_band = jnp.concatenate([jnp.pad(kb[:, :-1], pad), kb], axis=2)
    v_band = jnp.concatenate([jnp.pad(vb[:, :-1], pad), vb], axis=2)
    s = jnp.einsum('bnikgd,bnjkd->bnkgij', qb, k_band).astype(jnp.float32) * (SWA_HD ** -0.5)
    i = jnp.arange(WINDOW)[:, None]
    j = jnp.arange(2 * WINDOW)[None, :]
    band = (j > i) & (j <= i + WINDOW)
    valid = band[None] & ((jnp.arange(N)[:, None, None] > 0) | (j >= WINDOW)[None])
    s = jnp.where(valid[None, :, None, None], s, jnp.float32(-1e30))
    sink = sinks.astype(jnp.float32).reshape(SWA_KV_HEADS, G)[None, None, :, :, None, None]
    m = jnp.maximum(jnp.max(s, axis=-1, keepdims=True), sink)
    p = jnp.exp(s - m)
    p = p / (jnp.sum(p, axis=-1, keepdims=True) + jnp.exp(sink - m))
    o = jnp.einsum('bnkgij,bnjkd->bnikgd', p.astype(v.dtype), v_band)
    return o.reshape(B, S, SWA_HEADS * SWA_HD)


def group_limited_route(h, w_router, b_router):
    aff = jax.nn.sigmoid((h @ w_router).astype(jnp.float32))
    sel = (aff + b_router.astype(jnp.float32)).reshape(-1, N_GROUPS, EXPERTS_PER_GROUP)
    group_score = lax.top_k(sel, TOP_K)[0].sum(-1)
    group = jnp.argmax(group_score, axis=-1)
    in_group = jnp.take_along_axis(sel, group[:, None, None], axis=1)[:, 0]
    _, local = lax.top_k(in_group, TOP_K)
    expert = (group[:, None] * EXPERTS_PER_GROUP + local).astype(jnp.int32)
    w = jnp.take_along_axis(aff, expert, axis=1)
    return expert, w / jnp.sum(w, axis=-1, keepdims=True)


def moe_ffn(h, w_router, b_router, w_gate, w_up, w_down):
    T, D = h.shape
    expert, weight = group_limited_route(h, w_router, b_router)
    A = T * TOP_K
    e_flat = expert.reshape(A)
    tok_flat = jnp.repeat(jnp.arange(T, dtype=jnp.int32), TOP_K)
    order = jnp.argsort(e_flat)
    e_s = e_flat[order]
    tok_s = tok_flat[order]
    w_s = weight.reshape(A)[order]
    counts = jnp.bincount(e_flat, length=N_EXPERTS)
    starts = jnp.cumsum(counts) - counts
    padded = (counts + MOE_BLOCK - 1) // MOE_BLOCK * MOE_BLOCK
    pad_end = jnp.cumsum(padded)
    dest = pad_end[e_s] - padded[e_s] + jnp.arange(A, dtype=jnp.int32) - starts[e_s]
    n_blocks = -(-A // MOE_BLOCK) + N_EXPERTS
    slots = n_blocks * MOE_BLOCK
    tok_buf = jnp.zeros((slots,), jnp.int32).at[dest].set(tok_s)
    w_buf = jnp.zeros((slots,), jnp.float32).at[dest].set(w_s)
    blk_start = jnp.arange(n_blocks, dtype=jnp.int32) * MOE_BLOCK
    blk_exp = jnp.minimum(jnp.searchsorted(pad_end, blk_start, side='right'), N_EXPERTS - 1)

    def expert_block(args):
        tok, e = args
        xb = h[tok]
        return (jax.nn.silu(xb @ w_gate[e]) * (xb @ w_up[e])) @ w_down[e]

    y = lax.map(expert_block, (tok_buf.reshape(n_blocks, MOE_BLOCK), blk_exp))
    contrib = y.reshape(slots, D) * w_buf[:, None].astype(h.dtype)
    return jnp.zeros_like(h).at[tok_buf].add(contrib)


def setup_inputs(seed: int = 0) -> dict:
    key = jax.random.key(seed)
    ks = jax.random.split(key, 24)
    f32 = jnp.float32
    L, D = DEPTH, D_MODEL

    def nrm(k, shape, scale):
        return jax.random.normal(k, shape, f32) * scale

    offsets = jax.random.randint(ks[2], (BATCH, 1), 0, POS_OFFSET_MAX, dtype=jnp.int32)
    return {
        'x': nrm(ks[0], (BATCH, SEQ, D), 1.0),
        'c': nrm(ks[1], (BATCH, D), 1.0),
        'positions': offsets + jnp.arange(SEQ, dtype=jnp.int32)[None, :],
        'w_ada': nrm(ks[3], (L, D, 6 * D), 0.5 * D ** -0.5),
        'b_ada': nrm(ks[4], (L, 6 * D), 0.02),
        'norm_mix': 1.0 + nrm(ks[5], (L, D), 0.05),
        'w_in': nrm(ks[6], (L, D, IN_WIDTH), D ** -0.5),
        'w_alpha2': nrm(ks[7], (L, GLA_RANK, GLA_HEADS * GLA_DK), GLA_RANK ** -0.5),
        'b_alpha': nrm(ks[8], (L, GLA_HEADS * GLA_DK), 0.02),
        'gla_norm': 1.0 + nrm(ks[9], (L, GLA_HEADS * GLA_DV), 0.05),
        'q_norm': 1.0 + nrm(ks[10], (L, SWA_HD), 0.05),
        'k_norm': 1.0 + nrm(ks[11], (L, SWA_HD), 0.05),
        'sinks': nrm(ks[12], (L, SWA_HEADS), 0.5),
        'w_up_gla': nrm(ks[13], (L, GLA_HEADS * GLA_DV, D), (GLA_HEADS * GLA_DV) ** -0.5),
        'w_up_swa': nrm(ks[14], (L, SWA_HEADS * SWA_HD, D), (SWA_HEADS * SWA_HD) ** -0.5),
        'w_out': nrm(ks[15], (L, D, D), D ** -0.5),
        'norm_ffn': 1.0 + nrm(ks[16], (L, D), 0.05),
        'w_router': nrm(ks[17], (D, N_EXPERTS), D ** -0.5),
        'b_router': nrm(ks[18], (N_EXPERTS,), 0.01),
        'w_gate': nrm(ks[19], (L, N_EXPERTS, D, D_FF), D ** -0.5),
        'w_up': nrm(ks[20], (L, N_EXPERTS, D, D_FF), D ** -0.5),
        'w_down': nrm(ks[21], (L, N_EXPERTS, D_FF, D), D_FF ** -0.5),
    }


def reference(x, c, positions, w_ada, b_ada, norm_mix, w_in, w_alpha2, b_alpha, gla_norm,
              q_norm, k_norm, sinks, w_up_gla, w_up_swa, w_out, norm_ffn, w_router, b_router,
              w_gate, w_up, w_down):
    B, S, D = x.shape
    cond = jax.nn.silu(c)
    for l in range(DEPTH):
        mod = cond @ w_ada[l] + b_ada[l]
        sh1, sc1, g1, sh2, sc2, g2 = [m[:, None, :] for m in jnp.split(mod, 6, axis=-1)]
        h = rms_norm(x, norm_mix[l]) * (1.0 + sc1) + sh1
        gq, gk, gv, ga, gr, sq, sk, sv, mix_a, mix_b = split_columns(h @ w_in[l])
        y_gla = gla_branch(gq, gk, gv, ga, gr, w_alpha2[l], b_alpha[l], gla_norm[l]) @ w_up_gla[l]
        y_swa = swa_branch(sq, sk, sv, positions, q_norm[l], k_norm[l], sinks[l]) @ w_up_swa[l]
        merged = jax.nn.sigmoid(mix_a) * y_gla + jax.nn.sigmoid(mix_b) * y_swa
        x = x + g1 * (merged @ w_out[l])
        h2 = rms_norm(x, norm_ffn[l]) * (1.0 + sc2) + sh2
        y = moe_ffn(h2.reshape(B * S, D), w_router, b_router, w_gate[l], w_up[l], w_down[l])
        x = x + g2 * y.reshape(B, S, D)
    return x
```

```cpp
#include <hip/hip_runtime.h>
#include <cstdio>
#include <cstdint>

#ifndef MK_PER_PHASE
#define MK_PER_PHASE 0
#endif

constexpr int D = 1024, BATCH = 8, SEQ = 8192, T = BATCH * SEQ, DEPTH = 2;
constexpr int GH = 4, GDK = 64, GDV = 128, GRANK = 16, GCH = 64, NCH = SEQ / GCH;
constexpr int SH = 8, SKV = 2, SHD = 64, WIN = 128;
constexpr int NE = 16, DFF = 512, ECAP = T;
constexpr int INW = 4368;
constexpr int C_GQ = 0, C_GK = 256, C_GV = 512, C_GA = 1024, C_GR = 1040, C_SQ = 1552, C_SK = 2064, C_SV = 2192, C_MA = 2320, C_MB = 3344;
constexpr float EPS = 1e-6f;
constexpr int NTHREADS = 512, NWAVES = 8;

constexpr size_t MiB = 1u << 20;
constexpr size_t WS_CTL = 0, CTL_ZERO_BYTES = 1 * MiB;
constexpr size_t WS_MOD = 1 * MiB;
constexpr size_t WS_TOKL = 2 * MiB;
constexpr size_t WS_WL = 6 * MiB;
constexpr size_t WS_GA = 10 * MiB;
constexpr size_t WS_DECAY = 14 * MiB;
constexpr size_t WS_H = 138 * MiB;
constexpr size_t WS_STATE = WS_H;
constexpr size_t WS_GQ = 266 * MiB, WS_GK = 298 * MiB, WS_GV = 330 * MiB;
constexpr size_t WS_MERGED = WS_GQ;
constexpr size_t WS_GR = 394 * MiB;
constexpr size_t WS_SQ = 458 * MiB;
constexpr size_t WS_SK = 522 * MiB, WS_SV = 538 * MiB;
constexpr size_t WS_MA = 554 * MiB, WS_MB = 682 * MiB;
constexpr size_t WS_ACT = WS_MA;
constexpr size_t WS_GLAO = 810 * MiB, WS_SWAO = 874 * MiB;
constexpr size_t WS_GB = 938 * MiB;
constexpr size_t WS_END = 1002 * MiB;

constexpr int CW_BAR = 4096;
constexpr int CW_CNT = 16384;

#define GAS __attribute__((address_space(1)))
#define LAS __attribute__((address_space(3)))
typedef unsigned short bf16;
typedef float f32x4 __attribute__((ext_vector_type(4)));
typedef unsigned u32x4 __attribute__((ext_vector_type(4)));

__device__ __forceinline__ unsigned f2bf(float f) { unsigned u = __builtin_bit_cast(unsigned, f); return (u + 0x7fffu + ((u >> 16) & 1u)) >> 16; }
__device__ __forceinline__ float bf2f(unsigned h) { return __builtin_bit_cast(float, h << 16); }
__device__ __forceinline__ float sigmoidf_(float v) { return 1.f / (1.f + __expf(-v)); }
__device__ __forceinline__ float siluf_(float v) { return v / (1.f + __expf(-v)); }
__device__ __forceinline__ float wave_sum(float v) {
#pragma unroll
    for (int o = 1; o < 64; o <<= 1) v += __shfl_xor(v, o);
    return v;
}

#define XB_TMO      128
#define XB_XCNT(j)  (256  + 64 * (j))
#define XB_XSUB(j)  (1280 + 64 * (j))
#define XB_XGEN(j)  (2304 + 64 * (j))
#define XB_TOP      3328
#define XB_TOPGEN   3392
#define XCD_BAR_WORDS 3456
#define XB_SPIN_CAP (1u << 24)
__device__ __forceinline__ unsigned xb_ld(unsigned* p)              { return __hip_atomic_load(p, __ATOMIC_RELAXED, __HIP_MEMORY_SCOPE_AGENT); }
__device__ __forceinline__ unsigned xb_add(unsigned* p, unsigned v) { return __hip_atomic_fetch_add(p, v, __ATOMIC_RELAXED, __HIP_MEMORY_SCOPE_AGENT); }
__device__ __forceinline__ unsigned xb_xcc_id() { return (unsigned)__builtin_amdgcn_s_getreg((3 << 11) | 20) & 0xFu; }
#define XB_SPIN(cond, bar) do { unsigned _sp = 0; while (cond) { __builtin_amdgcn_s_sleep(1); \
    if ((++_sp & 255u) == 0u) { if (xb_ld(&(bar)[XB_TMO])) break; if (_sp > XB_SPIN_CAP) { atomicAdd(&(bar)[XB_TMO], 1u); break; } } } } while (0)
struct XcdBarrier { unsigned* bar; unsigned x; volatile LAS unsigned* st; };
__device__ __forceinline__ XcdBarrier xcd_barrier_post(unsigned* bar, volatile LAS unsigned* st) {
    XcdBarrier b; b.bar = bar; b.x = xb_xcc_id(); b.st = st;
    if (threadIdx.x == 0) (void)xb_add(&bar[XB_XCNT(b.x)], 1u);
    return b;
}
__device__ __forceinline__ void xcd_barrier_complete(unsigned* bar, unsigned x, unsigned& nloc, unsigned& nx) {
    const unsigned G = gridDim.x * gridDim.y * gridDim.z;
    unsigned sum, cnt, mine, sp = 0u;
    for (;;) {
        sum = 0u; cnt = 0u; mine = 0u;
#pragma unroll
        for (unsigned j = 0; j < 16; ++j) { const unsigned c = xb_ld(&bar[XB_XCNT(j)]); sum += c; cnt += (c > 0u) ? 1u : 0u; mine = (j == x) ? c : mine; }
        if (sum == G) break;
        __builtin_amdgcn_s_sleep(1);
        if ((++sp & 255u) == 0u) { if (xb_ld(&bar[XB_TMO])) break; if (sp > XB_SPIN_CAP) { atomicAdd(&bar[XB_TMO], 1u); break; } }
    }
    nloc = mine > 0u ? mine : 1u; nx = cnt > 0u ? cnt : 1u;
}
__device__ __forceinline__ void xcd_barrier(const XcdBarrier& b) {
    asm volatile("s_waitcnt vmcnt(0)" ::: "memory");
    __syncthreads();
    if (threadIdx.x == 0) {
        unsigned* bar = b.bar;
        __builtin_amdgcn_s_waitcnt(0);
        unsigned nloc = b.st[0], nx = b.st[1];
        if (nloc == 0u) { xcd_barrier_complete(bar, b.x, nloc, nx); b.st[0] = nloc; b.st[1] = nx; }
        const unsigned old = xb_add(&bar[XB_XSUB(b.x)], 1u);
        const unsigned gen = old / nloc;
        if (old + 1u == (gen + 1u) * nloc) {
            __builtin_amdgcn_fence(__ATOMIC_RELEASE, "agent");
            asm volatile("s_waitcnt vmcnt(0)" ::: "memory");
            const unsigned og = xb_add(&bar[XB_TOP], 1u);
            const unsigned tg = og / nx;
            if (og + 1u == (tg + 1u) * nx) xb_add(&bar[XB_TOPGEN], 1u);
            else XB_SPIN(xb_ld(&bar[XB_TOPGEN]) == tg, bar);
            __builtin_amdgcn_fence(__ATOMIC_ACQUIRE, "agent");
            xb_add(&bar[XB_XGEN(b.x)], 1u);
            asm volatile("s_waitcnt vmcnt(0)" ::: "memory");
        } else {
            XB_SPIN(xb_ld(&bar[XB_XGEN(b.x)]) == gen, bar);
            __builtin_amdgcn_fence(__ATOMIC_ACQUIRE, "agent");
            asm volatile("s_waitcnt vmcnt(0)" ::: "memory");
        }
    }
    __syncthreads();
}

constexpr int LDS_BYTES = 147456;
constexpr int MISC_OFF = 131072 + 320;

struct Args { const float* in[22]; float* out; unsigned char* ws; int ph_lo, ph_hi; };

constexpr int PTR_OFF = MISC_OFF + 128;
struct Frame {
    LAS unsigned char* lds;
    int tid, lane, wave, G, bid;
    __device__ __forceinline__ unsigned long long ptr(int i) const {
        const unsigned long long v = ((volatile LAS unsigned long long*)(lds + PTR_OFF))[i];
        const unsigned lo = __builtin_amdgcn_readfirstlane((unsigned)v), hi = __builtin_amdgcn_readfirstlane((unsigned)(v >> 32));
        return ((unsigned long long)hi << 32) | lo;
    }
    __device__ __forceinline__ const float* in(int i) const { return (const float*)ptr(i); }
    __device__ __forceinline__ float* out() const { return (float*)ptr(22); }
    __device__ __forceinline__ unsigned char* ws() const { return (unsigned char*)ptr(23); }
};
__device__ __forceinline__ Frame phase_frame(const Frame& F) {
    Frame P = F; unsigned l = (unsigned)(unsigned long long)P.lds;
    asm volatile("" : "+v"(P.tid), "+v"(P.lane), "+s"(P.wave), "+s"(P.G), "+s"(P.bid), "+s"(l));
    P.lds = (LAS unsigned char*)(unsigned long long)l; return P;
}
enum { I_X = 0, I_C, I_POS, I_WADA, I_BADA, I_NMIX, I_WIN, I_WA2, I_BA, I_GNORM, I_QN, I_KN, I_SINK, I_WUG, I_WUS, I_WOUT, I_NFFN, I_WR, I_BR, I_WGATE, I_WUP, I_WDOWN };

template <bool DUAL, class RowFn, class RowFn2, class Epi>
__device__ __forceinline__ void naive_gemm(const Frame& F, int M, int N, int K, RowFn rowp, RowFn2 rowp2, const float* Bw, const float* Bw2, int ldb, Epi epi) {
    const int tx = F.tid & 31, ty = F.tid >> 5;
    const int tilesN = (N + 127) / 128, tilesM = (M + 63) / 64;
    for (int tile = F.bid; tile < tilesM * tilesN; tile += F.G) {
        const int tm = tile / tilesN, tn = tile % tilesN;
        const int r0 = tm * 64 + ty * 4, c0 = tn * 128 + tx * 4;
        if (c0 >= N || r0 >= M) continue;
        float acc[4][4], acc2[4][4];
#pragma unroll
        for (int i = 0; i < 4; ++i)
#pragma unroll
            for (int j = 0; j < 4; ++j) { acc[i][j] = 0.f; acc2[i][j] = 0.f; }
        const bf16* ar0 = rowp(r0 + 0 < M ? r0 + 0 : M - 1); const bf16* ar1 = rowp(r0 + 1 < M ? r0 + 1 : M - 1);
        const bf16* ar2 = rowp(r0 + 2 < M ? r0 + 2 : M - 1); const bf16* ar3 = rowp(r0 + 3 < M ? r0 + 3 : M - 1);
        const bf16* br0 = ar0; const bf16* br1 = ar1; const bf16* br2 = ar2; const bf16* br3 = ar3;
        if (DUAL) { br0 = rowp2(r0 + 0 < M ? r0 + 0 : M - 1); br1 = rowp2(r0 + 1 < M ? r0 + 1 : M - 1); br2 = rowp2(r0 + 2 < M ? r0 + 2 : M - 1); br3 = rowp2(r0 + 3 < M ? r0 + 3 : M - 1); }
        for (int k = 0; k < K; k += 8) {
            u32x4 av[4], aw[4];
            av[0] = *(const u32x4*)(ar0 + k); av[1] = *(const u32x4*)(ar1 + k); av[2] = *(const u32x4*)(ar2 + k); av[3] = *(const u32x4*)(ar3 + k);
            if (DUAL) { aw[0] = *(const u32x4*)(br0 + k); aw[1] = *(const u32x4*)(br1 + k); aw[2] = *(const u32x4*)(br2 + k); aw[3] = *(const u32x4*)(br3 + k); }
#pragma unroll
            for (int kk = 0; kk < 8; ++kk) {
                const f32x4 bv = *(const f32x4*)(Bw + (size_t)(k + kk) * ldb + c0);
                f32x4 bw = bv; if (DUAL) bw = *(const f32x4*)(Bw2 + (size_t)(k + kk) * ldb + c0);
#pragma unroll
                for (int i = 0; i < 4; ++i) {
                    const unsigned w = av[i][kk >> 1]; const float a = (kk & 1) ? bf2f(w >> 16) : bf2f(w & 0xffffu);
                    acc[i][0] += a * bv[0]; acc[i][1] += a * bv[1]; acc[i][2] += a * bv[2]; acc[i][3] += a * bv[3];
                    if (DUAL) { const unsigned w2 = aw[i][kk >> 1]; const float a2 = (kk & 1) ? bf2f(w2 >> 16) : bf2f(w2 & 0xffffu);
                        acc2[i][0] += a2 * bw[0]; acc2[i][1] += a2 * bw[1]; acc2[i][2] += a2 * bw[2]; acc2[i][3] += a2 * bw[3]; }
                }
            }
        }
#pragma unroll
        for (int i = 0; i < 4; ++i) if (r0 + i < M) {
#pragma unroll
            for (int j = 0; j < 4; ++j) epi(r0 + i, c0 + j, acc[i][j], acc2[i][j]);
        }
    }
}

__device__ __forceinline__ const float* mod_ptr(const Frame& F, int l, int b, int chunk) { return (const float*)(F.ws() + WS_MOD) + ((size_t)(l * BATCH + b) * 6 + chunk) * D; }

__device__ __forceinline__ void ph_mod(const Frame& F) {
    LAS float* cond = (LAS float*)F.lds;
    for (int i = F.tid; i < BATCH * D; i += NTHREADS) cond[i] = siluf_(F.in(I_C)[i]);
    __syncthreads();
    float* mod = (float*)(F.ws() + WS_MOD);
    for (int idx = F.bid * NTHREADS + F.tid; idx < DEPTH * 6 * D; idx += F.G * NTHREADS) {
        const int l = idx / (6 * D), j = idx % (6 * D);
        float acc[BATCH];
        const float bb = F.in(I_BADA)[l * 6 * D + j];
#pragma unroll
        for (int b = 0; b < BATCH; ++b) acc[b] = bb;
        const float* w = F.in(I_WADA) + (size_t)l * D * 6 * D + j;
        for (int k = 0; k < D; ++k) { const float wv = w[(size_t)k * 6 * D];
#pragma unroll
            for (int b = 0; b < BATCH; ++b) acc[b] += cond[b * D + k] * wv; }
#pragma unroll
        for (int b = 0; b < BATCH; ++b) mod[(size_t)(l * BATCH + b) * 6 * D + j] = acc[b];
    }
    __syncthreads();
}

template <bool ROUTE>
__device__ __forceinline__ void ph_norm(const Frame& F, int l, const float* xin, const float* gain, int ch_sh, int ch_sc) {
    bf16* H = (bf16*)(F.ws() + WS_H);
    const int gw = F.bid * NWAVES + F.wave, NGW = F.G * NWAVES;
    for (int m = gw; m < T; m += NGW) {
        const int b = m / SEQ;
        const f32x4* xr = (const f32x4*)(xin + (size_t)m * D) + F.lane;
        f32x4 v[4]; float s = 0.f;
#pragma unroll
        for (int j = 0; j < 4; ++j) { v[j] = xr[64 * j]; s += (v[j].x * v[j].x + v[j].y * v[j].y) + (v[j].z * v[j].z + v[j].w * v[j].w); }
        const float rstd = 1.0f / sqrtf(wave_sum(s) * (1.f / D) + EPS);
        const float* sh = mod_ptr(F, l, b, ch_sh); const float* sc = mod_ptr(F, l, b, ch_sc);
        float lg[NE];
#pragma unroll
        for (int e = 0; e < NE; ++e) lg[e] = 0.f;
#pragma unroll
        for (int j = 0; j < 4; ++j) {
            const int col = 4 * F.lane + 256 * j;
            const f32x4 g = *(const f32x4*)(gain + col), s4 = *(const f32x4*)(sc + col), h4 = *(const f32x4*)(sh + col);
            f32x4 y;
#pragma unroll
            for (int q = 0; q < 4; ++q) y[q] = (v[j][q] * rstd * g[q]) * (1.f + s4[q]) + h4[q];
            unsigned long long o = (unsigned long long)(f2bf(y[0]) | (f2bf(y[1]) << 16)) | ((unsigned long long)(f2bf(y[2]) | (f2bf(y[3]) << 16)) << 32);
            *((unsigned long long*)(H + (size_t)m * D + col)) = o;
            if (ROUTE) {
#pragma unroll
                for (int q = 0; q < 4; ++q) {
                    const f32x4* wr = (const f32x4*)(F.in(I_WR) + (size_t)(col + q) * NE);
#pragma unroll
                    for (int e4 = 0; e4 < 4; ++e4) { const f32x4 w = wr[e4]; lg[e4 * 4 + 0] += y[q] * w[0]; lg[e4 * 4 + 1] += y[q] * w[1]; lg[e4 * 4 + 2] += y[q] * w[2]; lg[e4 * 4 + 3] += y[q] * w[3]; }
                }
            }
        }
        if (ROUTE) {
            float aff[NE], sel[NE];
#pragma unroll
            for (int e = 0; e < NE; ++e) { lg[e] = wave_sum(lg[e]); aff[e] = sigmoidf_(lg[e]); sel[e] = aff[e] + F.in(I_BR)[e]; }
            float best = 0.f; int bg = 0; float s0 = 0.f, s1 = 0.f, s2 = 0.f, s3 = 0.f, a0 = 0.f, a1 = 0.f, a2 = 0.f, a3 = 0.f;
#pragma unroll
            for (int g = 0; g < 4; ++g) {
                const float x0 = sel[4 * g], x1 = sel[4 * g + 1], x2 = sel[4 * g + 2], x3 = sel[4 * g + 3];
                const float mx = fmaxf(fmaxf(x0, x1), fmaxf(x2, x3));
                const float lo01 = fminf(x0, x1), hi01 = fmaxf(x0, x1), lo23 = fminf(x2, x3), hi23 = fmaxf(x2, x3);
                const float second = fmaxf(fminf(hi01, hi23), fmaxf(lo01, lo23));
                const float sc_ = mx + second;
                if (g == 0 || sc_ > best) { best = sc_; bg = g; s0 = x0; s1 = x1; s2 = x2; s3 = x3; a0 = aff[4 * g]; a1 = aff[4 * g + 1]; a2 = aff[4 * g + 2]; a3 = aff[4 * g + 3]; }
            }
            int i1 = 0; float m1 = s0; if (s1 > m1) { m1 = s1; i1 = 1; } if (s2 > m1) { m1 = s2; i1 = 2; } if (s3 > m1) { m1 = s3; i1 = 3; }
            int i2 = -1; float m2 = 0.f;
            if (i1 != 0) { m2 = s0; i2 = 0; }
            if (i1 != 1 && (i2 < 0 || s1 > m2)) { m2 = s1; i2 = 1; }
            if (i1 != 2 && (i2 < 0 || s2 > m2)) { m2 = s2; i2 = 2; }
            if (i1 != 3 && (i2 < 0 || s3 > m2)) { m2 = s3; i2 = 3; }
            const float w1 = i1 == 0 ? a0 : i1 == 1 ? a1 : i1 == 2 ? a2 : a3;
            const float w2 = i2 == 0 ? a0 : i2 == 1 ? a1 : i2 == 2 ? a2 : a3;
            const float inv = 1.f / (w1 + w2);
            if (F.lane == 0) {
                unsigned* cnt = (unsigned*)(F.ws() + WS_CTL) + CW_CNT + 64 * (NE * l);
                int* tokl = (int*)(F.ws() + WS_TOKL); float* wl = (float*)(F.ws() + WS_WL);
                const int e1 = bg * 4 + i1, e2 = bg * 4 + i2;
                const unsigned p1 = atomicAdd(&cnt[64 * e1], 1u); tokl[(size_t)e1 * ECAP + p1] = m; wl[(size_t)e1 * ECAP + p1] = w1 * inv;
                const unsigned p2 = atomicAdd(&cnt[64 * e2], 1u); tokl[(size_t)e2 * ECAP + p2] = m; wl[(size_t)e2 * ECAP + p2] = w2 * inv;
            }
        }
    }
}

__device__ __forceinline__ void ph_gemm1(const Frame& F, int l) {
    const bf16* H = (const bf16*)(F.ws() + WS_H);
    bf16* GQ = (bf16*)(F.ws() + WS_GQ); bf16* GK = (bf16*)(F.ws() + WS_GK); bf16* GV = (bf16*)(F.ws() + WS_GV); float* GA = (float*)(F.ws() + WS_GA);
    bf16* GR = (bf16*)(F.ws() + WS_GR); bf16* SQ = (bf16*)(F.ws() + WS_SQ); bf16* SK = (bf16*)(F.ws() + WS_SK); bf16* SV = (bf16*)(F.ws() + WS_SV);
    bf16* MA = (bf16*)(F.ws() + WS_MA); bf16* MB = (bf16*)(F.ws() + WS_MB);
    auto rowp = [=](int m) { return H + (size_t)m * D; };
    auto epi = [=](int m, int n, float v, float) {
        if (n < C_GK) GQ[(size_t)m * 256 + n] = (bf16)f2bf(v * 0.125f);
        else if (n < C_GV) GK[(size_t)m * 256 + (n - C_GK)] = (bf16)f2bf(v);
        else if (n < C_GA) GV[(size_t)m * 512 + (n - C_GV)] = (bf16)f2bf(v);
        else if (n < C_GR) GA[(size_t)m * 16 + (n - C_GA)] = v;
        else if (n < C_SQ) GR[(size_t)m * 512 + (n - C_GR)] = (bf16)f2bf(siluf_(v));
        else if (n < C_SK) SQ[(size_t)m * 512 + (n - C_SQ)] = (bf16)f2bf(v);
        else if (n < C_SV) SK[(size_t)m * 128 + (n - C_SK)] = (bf16)f2bf(v);
        else if (n < C_MA) SV[(size_t)m * 128 + (n - C_SV)] = (bf16)f2bf(v);
        else if (n < C_MB) MA[(size_t)m * 1024 + (n - C_MA)] = (bf16)f2bf(sigmoidf_(v));
        else MB[(size_t)m * 1024 + (n - C_MB)] = (bf16)f2bf(sigmoidf_(v));
    };
    naive_gemm<false>(F, T, INW, D, rowp, rowp, F.in(I_WIN) + (size_t)l * D * INW, nullptr, INW, epi);
}

__device__ __forceinline__ void ph_headnorm(const Frame& F, int l) {
    bf16* SQ = (bf16*)(F.ws() + WS_SQ); bf16* SK = (bf16*)(F.ws() + WS_SK);
    const int* pos = (const int*)F.in(I_POS);
    const int NT = F.G * NTHREADS, gt = F.bid * NTHREADS + F.tid;
    for (int item = gt; item < T * 10; item += NT) {
        const int t = item / 10, hh = item % 10;
        bf16* p = hh < 8 ? SQ + (size_t)t * 512 + hh * 64 : SK + (size_t)t * 128 + (hh - 8) * 64;
        const float* gain = hh < 8 ? F.in(I_QN) + l * SHD : F.in(I_KN) + l * SHD;
        const float osc = hh < 8 ? 0.125f : 1.f;
        float v[64]; float ss = 0.f;
#pragma unroll
        for (int c = 0; c < 8; ++c) { const u32x4 w = *(const u32x4*)(p + c * 8);
#pragma unroll
            for (int q = 0; q < 4; ++q) { v[c * 8 + 2 * q] = bf2f(w[q] & 0xffffu); v[c * 8 + 2 * q + 1] = bf2f(w[q] >> 16); } }
#pragma unroll
        for (int i = 0; i < 64; ++i) ss += v[i] * v[i];
        const float rstd = 1.0f / sqrtf(ss * (1.f / 64.f) + EPS);
#pragma unroll
        for (int i = 0; i < 64; ++i) v[i] = v[i] * rstd * gain[i];
        const float pf = (float)pos[t];
#pragma unroll
        for (int i = 0; i < 8; ++i) {
            const float invf = (float)exp2(-(double)i * (1.0 / 8.0) * 18.931568569324174);
            const float ang = pf * invf;
            const double rev = (double)ang * 0.15915494309189535; const float fr = (float)(rev - floor(rev));
            const float cs = __builtin_amdgcn_cosf(fr), sn = __builtin_amdgcn_sinf(fr);
            const float x1 = v[i], x2 = v[i + 8];
            v[i] = x1 * cs - x2 * sn; v[i + 8] = x2 * cs + x1 * sn;
        }
#pragma unroll
        for (int c = 0; c < 8; ++c) { u32x4 w;
#pragma unroll
            for (int q = 0; q < 4; ++q) w[q] = f2bf(v[c * 8 + 2 * q] * osc) | (f2bf(v[c * 8 + 2 * q + 1] * osc) << 16);
            *(u32x4*)(p + c * 8) = w; }
    }
    const float* GA = (const float*)(F.ws() + WS_GA); float* GB = (float*)(F.ws() + WS_GB);
    const float* wa2 = F.in(I_WA2) + (size_t)l * GRANK * 256; const float* ba = F.in(I_BA) + l * 256;
    for (int item = gt; item < BATCH * NCH * GH * GDK; item += NT) {
        const int d = item & 63, ch = item >> 6, h = ch & 3, bn = ch >> 2;
        const int t0 = bn * GCH, col = h * 64 + d;
        float w[GRANK];
#pragma unroll
        for (int r = 0; r < GRANK; ++r) w[r] = wa2[r * 256 + col];
        const float bias = ba[col];
        float cum = 0.f;
        for (int i = 0; i < GCH; ++i) {
            const f32x4* a = (const f32x4*)(GA + (size_t)(t0 + i) * 16);
            float u = bias;
#pragma unroll
            for (int r4 = 0; r4 < 4; ++r4) { const f32x4 av = a[r4]; u += av[0] * w[r4 * 4] + av[1] * w[r4 * 4 + 1] + av[2] * w[r4 * 4 + 2] + av[3] * w[r4 * 4 + 3]; }
            const float ls = fminf(u, 0.f) - log1pf(__expf(-fabsf(u)));
            cum += ls * (1.f / 16.f);
            GB[(size_t)(t0 + i) * 256 + col] = cum;
        }
    }
}

__device__ __forceinline__ void ph_swa(const Frame& F, int l) {
    const bf16* SQ = (const bf16*)(F.ws() + WS_SQ); const bf16* SK = (const bf16*)(F.ws() + WS_SK); const bf16* SV = (const bf16*)(F.ws() + WS_SV);
    bf16* O = (bf16*)(F.ws() + WS_SWAO);
    const int NT = F.G * NTHREADS, gt = F.bid * NTHREADS + F.tid;
    for (int it = gt >> 2; it < T * SH; it += NT >> 2) {
        const int part = gt & 3, t = it >> 3, h = it & 7, kvh = h >> 2, sp = t % SEQ;
        float q[16], o[16];
        { const u32x4* qp = (const u32x4*)(SQ + (size_t)t * 512 + h * 64 + part * 16);
#pragma unroll
          for (int c = 0; c < 2; ++c) { const u32x4 w = qp[c];
#pragma unroll
              for (int x = 0; x < 4; ++x) { q[c * 8 + 2 * x] = bf2f(w[x] & 0xffffu); q[c * 8 + 2 * x + 1] = bf2f(w[x] >> 16); } } }
#pragma unroll
        for (int i = 0; i < 16; ++i) o[i] = 0.f;
        float mx = F.in(I_SINK)[l * SH + h], den = 1.f;
        const int j0 = sp - (WIN - 1) < 0 ? 0 : sp - (WIN - 1);
        for (int j = j0; j <= sp; ++j) {
            const size_t tk = (size_t)(t - sp + j);
            const u32x4* kp = (const u32x4*)(SK + tk * 128 + kvh * 64 + part * 16);
            const u32x4* vp = (const u32x4*)(SV + tk * 128 + kvh * 64 + part * 16);
            float s = 0.f;
#pragma unroll
            for (int c = 0; c < 2; ++c) { const u32x4 w = kp[c];
#pragma unroll
                for (int x = 0; x < 4; ++x) s += q[c * 8 + 2 * x] * bf2f(w[x] & 0xffffu) + q[c * 8 + 2 * x + 1] * bf2f(w[x] >> 16); }
            s += __shfl_xor(s, 1); s += __shfl_xor(s, 2);
            const float mn = fmaxf(mx, s), scl = __expf(mx - mn), p = __expf(s - mn);
            den = den * scl + p; mx = mn;
#pragma unroll
            for (int c = 0; c < 2; ++c) { const u32x4 w = vp[c];
#pragma unroll
                for (int x = 0; x < 4; ++x) { o[c * 8 + 2 * x] = o[c * 8 + 2 * x] * scl + p * bf2f(w[x] & 0xffffu); o[c * 8 + 2 * x + 1] = o[c * 8 + 2 * x + 1] * scl + p * bf2f(w[x] >> 16); } }
        }
        const float inv = 1.f / den;
        u32x4* op = (u32x4*)(O + (size_t)t * 512 + h * 64 + part * 16);
#pragma unroll
        for (int c = 0; c < 2; ++c) { u32x4 w;
#pragma unroll
            for (int x = 0; x < 4; ++x) w[x] = f2bf(o[c * 8 + 2 * x] * inv) | (f2bf(o[c * 8 + 2 * x + 1] * inv) << 16);
            op[c] = w; }
    }
}

__device__ __forceinline__ void ph_gla_kv(const Frame& F) {
    const bf16* GK = (const bf16*)(F.ws() + WS_GK); const bf16* GV = (const bf16*)(F.ws() + WS_GV); const float* GB = (const float*)(F.ws() + WS_GB);
    float* ST = (float*)(F.ws() + WS_STATE); float* DEC = (float*)(F.ws() + WS_DECAY);
    const size_t NT = (size_t)F.G * NTHREADS, gt = (size_t)F.bid * NTHREADS + F.tid;
    for (size_t item = gt; item < (size_t)BATCH * NCH * GH * GDK * GDV; item += NT) {
        const int e = (int)(item & 127), d = (int)((item >> 7) & 63), ch = (int)(item >> 13), h = ch & 3, bn = ch >> 2, t0 = bn * GCH;
        const float bend = GB[(size_t)(t0 + GCH - 1) * 256 + h * 64 + d];
        float acc = 0.f;
        for (int j = 0; j < GCH; ++j) {
            const float kk = bf2f(GK[(size_t)(t0 + j) * 256 + h * 64 + d]) * __expf(bend - GB[(size_t)(t0 + j) * 256 + h * 64 + d]);
            acc += kk * bf2f(GV[(size_t)(t0 + j) * 512 + h * 128 + e]);
        }
        ST[item] = acc;
        if (e == 0) DEC[ch * 64 + d] = __expf(bend);
    }
}
__device__ __forceinline__ void ph_gla_scan(const Frame& F) {
    float* ST = (float*)(F.ws() + WS_STATE); const float* DEC = (const float*)(F.ws() + WS_DECAY);
    const int NT = F.G * NTHREADS, gt = F.bid * NTHREADS + F.tid;
    for (int item = gt; item < BATCH * GH * GDK * GDV; item += NT) {
        const int e = item & 127, d = (item >> 7) & 63, h = (item >> 13) & 3, b = item >> 15;
        float S = 0.f;
        for (int n = 0; n < NCH; ++n) {
            const int ch = (b * NCH + n) * 4 + h; const size_t idx = ((size_t)ch * 64 + d) * 128 + e;
            const float kv = ST[idx]; ST[idx] = S; S = DEC[ch * 64 + d] * S + kv;
        }
    }
}
__device__ __forceinline__ void ph_gla_out(const Frame& F, int l) {
    const bf16* GQ = (const bf16*)(F.ws() + WS_GQ); const bf16* GK = (const bf16*)(F.ws() + WS_GK); const bf16* GV = (const bf16*)(F.ws() + WS_GV); const bf16* GR = (const bf16*)(F.ws() + WS_GR);
    const float* GB = (const float*)(F.ws() + WS_GB); const float* ST = (const float*)(F.ws() + WS_STATE);
    bf16* O = (bf16*)(F.ws() + WS_GLAO);
    LAS float* qd = (LAS float*)F.lds; LAS float* ki = qd + 64 * 65; LAS float* att = ki + 64 * 65; LAS float* ob = att + 64 * 65;
    const float* gn = F.in(I_GNORM) + l * 512;
    for (int ch = F.bid; ch < BATCH * NCH * GH; ch += F.G) {
        const int h = ch & 3, bn = ch >> 2, t0 = bn * GCH;
        for (int x = F.tid; x < 4096; x += NTHREADS) { const int i = x >> 6, d = x & 63; const float bb = GB[(size_t)(t0 + i) * 256 + h * 64 + d];
            qd[i * 65 + d] = bf2f(GQ[(size_t)(t0 + i) * 256 + h * 64 + d]) * __expf(bb); ki[i * 65 + d] = bf2f(GK[(size_t)(t0 + i) * 256 + h * 64 + d]) * __expf(-bb); }
        __syncthreads();
        for (int x = F.tid; x < 4096; x += NTHREADS) { const int i = x >> 6, j = x & 63; float a = 0.f;
            if (j <= i) { for (int d = 0; d < 64; ++d) a += qd[i * 65 + d] * ki[j * 65 + d]; }
            att[i * 65 + j] = a; }
        __syncthreads();
        { const int e = F.tid & 127, ig = F.tid >> 7;
          for (int ii = 0; ii < 16; ++ii) { const int i = ig * 16 + ii; float acc = 0.f;
              for (int j = 0; j <= i; ++j) acc += att[i * 65 + j] * bf2f(GV[(size_t)(t0 + j) * 512 + h * 128 + e]);
              for (int d = 0; d < 64; ++d) acc += qd[i * 65 + d] * ST[((size_t)ch * 64 + d) * 128 + e];
              ob[i * 129 + e] = acc; } }
        __syncthreads();
        for (int r = 0; r < 8; ++r) { const int i = F.wave * 8 + r; const float v0 = ob[i * 129 + F.lane], v1 = ob[i * 129 + 64 + F.lane];
            const float rstd = 1.0f / sqrtf(wave_sum(v0 * v0 + v1 * v1) * (1.f / 128.f) + EPS);
            const size_t t = (size_t)(t0 + i);
            O[t * 512 + h * 128 + F.lane] = (bf16)f2bf(v0 * rstd * gn[h * 128 + F.lane] * bf2f(GR[t * 512 + h * 128 + F.lane]));
            O[t * 512 + h * 128 + 64 + F.lane] = (bf16)f2bf(v1 * rstd * gn[h * 128 + 64 + F.lane] * bf2f(GR[t * 512 + h * 128 + 64 + F.lane])); }
        __syncthreads();
    }
}
__device__ __forceinline__ void ph_gemm2(const Frame& F, int l) {
    const bf16* GO = (const bf16*)(F.ws() + WS_GLAO); const bf16* SO = (const bf16*)(F.ws() + WS_SWAO);
    const bf16* MA = (const bf16*)(F.ws() + WS_MA); const bf16* MB = (const bf16*)(F.ws() + WS_MB); bf16* MG = (bf16*)(F.ws() + WS_MERGED);
    auto rowp = [=](int m) { return GO + (size_t)m * 512; }; auto rowp2 = [=](int m) { return SO + (size_t)m * 512; };
    auto epi = [=](int m, int n, float a, float b) { MG[(size_t)m * D + n] = (bf16)f2bf(bf2f(MA[(size_t)m * D + n]) * a + bf2f(MB[(size_t)m * D + n]) * b); };
    naive_gemm<true>(F, T, D, 512, rowp, rowp2, F.in(I_WUG) + (size_t)l * 512 * D, F.in(I_WUS) + (size_t)l * 512 * D, D, epi);
}
__device__ __forceinline__ void ph_gemm3(const Frame& F, int l, const float* xin) {
    const bf16* MG = (const bf16*)(F.ws() + WS_MERGED); float* out = F.out(); const float* modl = (const float*)(F.ws() + WS_MOD) + (size_t)l * BATCH * 6 * D;
    auto rowp = [=](int m) { return MG + (size_t)m * D; };
    auto epi = [=](int m, int n, float a, float) { const int b = m / SEQ; out[(size_t)m * D + n] = xin[(size_t)m * D + n] + modl[((size_t)b * 6 + 2) * D + n] * a; };
    naive_gemm<false>(F, T, D, D, rowp, rowp, F.in(I_WOUT) + (size_t)l * D * D, nullptr, D, epi);
}
__device__ __forceinline__ void ph_moe_up(const Frame& F, int l) {
    const bf16* H = (const bf16*)(F.ws() + WS_H); bf16* ACT = (bf16*)(F.ws() + WS_ACT);
    const unsigned* cnt = (const unsigned*)(F.ws() + WS_CTL) + CW_CNT + 64 * (NE * l); const int* tokl = (const int*)(F.ws() + WS_TOKL);
    int seg = 0;
    for (int e = 0; e < NE; ++e) {
        const int ce = (int)cnt[64 * e]; const int* tl = tokl + (size_t)e * ECAP; bf16* act = ACT + (size_t)seg * DFF;
        auto rowp = [=](int m) { return H + (size_t)tl[m] * D; };
        auto epi = [=](int m, int n, float a, float b) { act[(size_t)m * DFF + n] = (bf16)f2bf(siluf_(a) * b); };
        naive_gemm<true>(F, ce, DFF, D, rowp, rowp, F.in(I_WGATE) + ((size_t)l * NE + e) * D * DFF, F.in(I_WUP) + ((size_t)l * NE + e) * D * DFF, DFF, epi);
        seg += (ce + 255) / 256 * 256;
    }
}
__device__ __forceinline__ void ph_moe_down(const Frame& F, int l) {
    const bf16* ACT = (const bf16*)(F.ws() + WS_ACT); float* out = F.out(); const float* modl = (const float*)(F.ws() + WS_MOD) + (size_t)l * BATCH * 6 * D;
    const unsigned* cnt = (const unsigned*)(F.ws() + WS_CTL) + CW_CNT + 64 * (NE * l); const int* tokl = (const int*)(F.ws() + WS_TOKL); const float* wl = (const float*)(F.ws() + WS_WL);
    int seg = 0;
    for (int e = 0; e < NE; ++e) {
        const int ce = (int)cnt[64 * e]; const int* tl = tokl + (size_t)e * ECAP; const float* wle = wl + (size_t)e * ECAP; const bf16* act = ACT + (size_t)seg * DFF;
        auto rowp = [=](int m) { return act + (size_t)m * DFF; };
        auto epi = [=](int m, int n, float a, float) { const int tok = tl[m]; const int b = tok / SEQ; unsafeAtomicAdd(&out[(size_t)tok * D + n], modl[((size_t)b * 6 + 5) * D + n] * wle[m] * a); };
        naive_gemm<false>(F, ce, D, DFF, rowp, rowp, F.in(I_WDOWN) + ((size_t)l * NE + e) * DFF * D, nullptr, D, epi);
        seg += (ce + 255) / 256 * 256;
    }
}

constexpr int NPH_LAYER = 11, NPHASES = 1 + DEPTH * NPH_LAYER;
__global__ void __launch_bounds__(NTHREADS, 2) fwd(Args args) {
    extern __shared__ __attribute__((aligned(16))) unsigned char lds[];
    Frame F;
    F.lds = (LAS unsigned char*)lds; F.tid = threadIdx.x; F.lane = F.tid & 63; F.wave = __builtin_amdgcn_readfirstlane(F.tid >> 6);
    F.G = gridDim.x; F.bid = blockIdx.x;
    volatile LAS unsigned* MISC = (volatile LAS unsigned*)(F.lds + MISC_OFF);
    if (F.tid < 32) MISC[F.tid] = 0u;
    if (F.tid == 0) { volatile LAS unsigned long long* tb = (volatile LAS unsigned long long*)(F.lds + PTR_OFF);
#pragma unroll
        for (int i = 0; i < 22; ++i) tb[i] = (unsigned long long)args.in[i];
        tb[22] = (unsigned long long)args.out; tb[23] = (unsigned long long)args.ws; }
    __syncthreads();
    XcdBarrier bar; bar.bar = (unsigned*)(F.ws() + WS_CTL) + CW_BAR; bar.x = 0; bar.st = nullptr;
#if !MK_PER_PHASE
    bar = xcd_barrier_post((unsigned*)(F.ws() + WS_CTL) + CW_BAR, MISC + 8);
#endif
    const int lo = args.ph_lo, hi = args.ph_hi;
#define IN(k) (lo <= (k) && (k) < hi)
#define SEAM(k) do { if (IN(k) && IN((k) + 1)) xcd_barrier(bar); } while (0)
    if (IN(0)) { ph_mod(phase_frame(F)); } SEAM(0);
    for (int l = 0; l < DEPTH; ++l) {
        const int p0 = 1 + l * NPH_LAYER;
        const float* xin = l == 0 ? F.in(I_X) : F.out();
        if (IN(p0 + 0)) ph_norm<false>(phase_frame(F), l, xin, F.in(I_NMIX) + l * D, 0, 1); SEAM(p0 + 0);
        if (IN(p0 + 1)) ph_gemm1(phase_frame(F), l); SEAM(p0 + 1);
        if (IN(p0 + 2)) ph_headnorm(phase_frame(F), l); SEAM(p0 + 2);
        if (IN(p0 + 3)) { ph_swa(phase_frame(F), l); ph_gla_kv(phase_frame(F)); } SEAM(p0 + 3);
        if (IN(p0 + 4)) ph_gla_scan(phase_frame(F)); SEAM(p0 + 4);
        if (IN(p0 + 5)) ph_gla_out(phase_frame(F), l); SEAM(p0 + 5);
        if (IN(p0 + 6)) ph_gemm2(phase_frame(F), l); SEAM(p0 + 6);
        if (IN(p0 + 7)) ph_gemm3(phase_frame(F), l, xin); SEAM(p0 + 7);
        if (IN(p0 + 8)) ph_norm<true>(phase_frame(F), l, F.out(), F.in(I_NFFN) + l * D, 3, 4); SEAM(p0 + 8);
        if (IN(p0 + 9)) ph_moe_up(phase_frame(F), l); SEAM(p0 + 9);
        if (IN(p0 + 10)) ph_moe_down(phase_frame(F), l); if (l + 1 < DEPTH) SEAM(p0 + 10);
    }
#undef IN
#undef SEAM
}

extern "C" void kernel_launch(void* const* d_in, const int* in_sizes, int n_in, void* d_out, int out_size, void* d_ws, size_t ws_size, hipStream_t stream) {
    static int grid = 0;
    if (grid == 0) {
        if (n_in != 22 || in_sizes[0] != T * D || out_size != T * D || ws_size < WS_END) { fprintf(stderr, "kernel_launch: unexpected shapes: n_in %d in0 %d out %d ws %zu (need %zu)\n", n_in, n_in > 0 ? in_sizes[0] : -1, out_size, ws_size, (size_t)WS_END); grid = -1; return; }
        int dev = 0, cus = 0, per_cu = 0;
        if (hipGetDevice(&dev) != hipSuccess || hipDeviceGetAttribute(&cus, hipDeviceAttributeMultiprocessorCount, dev) != hipSuccess) { grid = -1; return; }
        if (hipFuncSetAttribute((const void*)fwd, hipFuncAttributeMaxDynamicSharedMemorySize, LDS_BYTES) != hipSuccess) { fprintf(stderr, "kernel_launch: hipFuncSetAttribute failed\n"); grid = -1; return; }
        if (hipOccupancyMaxActiveBlocksPerMultiprocessor(&per_cu, (const void*)fwd, NTHREADS, LDS_BYTES) != hipSuccess || per_cu < 1) fprintf(stderr, "kernel_launch: occupancy query reports %d\n", per_cu);
        (void)hipGetLastError();
        grid = cus;
    }
    if (grid < 0) return;
    if (hipMemsetAsync((char*)d_ws + WS_CTL, 0, CTL_ZERO_BYTES, stream) != hipSuccess) return;
    Args a{};
    for (int i = 0; i < 22; ++i) a.in[i] = (const float*)d_in[i];
    a.out = (float*)d_out; a.ws = (unsigned char*)d_ws;
#if MK_PER_PHASE
    for (int p = 0; p < NPHASES; ++p) { a.ph_lo = p; a.ph_hi = p + 1; hipLaunchKernelGGL(fwd, dim3(grid), dim3(NTHREADS), LDS_BYTES, stream, a); }
#else
    a.ph_lo = 0; a.ph_hi = NPHASES; hipLaunchKernelGGL(fwd, dim3(grid), dim3(NTHREADS), LDS_BYTES, stream, a);
#endif
}
```

```cpp
#include <hip/hip_runtime.h>
#include <cstdio>
#include <cstdint>

#ifndef MK_PER_PHASE
#define MK_PER_PHASE 0
#endif

constexpr int D = 1024, BATCH = 8, SEQ = 8192, T = BATCH * SEQ, DEPTH = 2;
constexpr int GH = 4, GDK = 64, GDV = 128, GRANK = 16, GCH = 64, NCH = SEQ / GCH;
constexpr int SH = 8, SKV = 2, SHD = 64, WIN = 128;
constexpr int NE = 16, DFF = 512, ECAP = T;
constexpr int INW = 4368, NIN = 4608;
constexpr int C_GQ = 0, C_GK = 256, C_GV = 512, C_GA = 1024, C_GR = 1040, C_SQ = 1552, C_SK = 2064, C_SV = 2192, C_MA = 2320, C_MB = 3344;
constexpr float EPS = 1e-6f;
constexpr int NTHREADS = 512, NWAVES = 8;

constexpr size_t MiB = 1u << 20;
constexpr size_t WS_CTL = 0, CTL_ZERO_BYTES = 1 * MiB;
constexpr size_t WS_MOD = 1 * MiB;
constexpr size_t WS_TOKL = 2 * MiB;
constexpr size_t WS_WL = 6 * MiB;
constexpr size_t WS_GA = 10 * MiB;
constexpr size_t WS_DECAY = 14 * MiB;
constexpr size_t WS_WIN_T = 16 * MiB;
constexpr size_t WS_WG_T = 34 * MiB, WS_WS_T = 36 * MiB;
constexpr size_t WS_WOUT_T = 38 * MiB;
constexpr size_t WS_WGU_T = 42 * MiB;
constexpr size_t WS_WD_T = 106 * MiB;
constexpr size_t WS_H = 138 * MiB;
constexpr size_t WS_STATE = WS_H;
constexpr size_t WS_GQ = 266 * MiB, WS_GK = 298 * MiB, WS_GV = 330 * MiB;
constexpr size_t WS_MERGED = WS_GQ;
constexpr size_t WS_GR = 394 * MiB;
constexpr size_t WS_SQ = 458 * MiB;
constexpr size_t WS_SK = 522 * MiB, WS_SV = 538 * MiB;
constexpr size_t WS_MA = 554 * MiB, WS_MB = 682 * MiB;
constexpr size_t WS_ACT = WS_MA;
constexpr size_t WS_GLAO = 810 * MiB, WS_SWAO = 874 * MiB;
constexpr size_t WS_Y0 = 266 * MiB, WS_Y1 = 394 * MiB;
constexpr size_t WS_GB = 938 * MiB;
constexpr size_t WS_ROPE = 1002 * MiB;
constexpr size_t WS_END = 1006 * MiB;

constexpr int CW_BAR = 4096;
constexpr int CW_CNT = 16384;

#define GAS __attribute__((address_space(1)))
#define LAS __attribute__((address_space(3)))
typedef unsigned short bf16;
typedef float f32x4 __attribute__((ext_vector_type(4)));
typedef unsigned u32x4 __attribute__((ext_vector_type(4)));

__device__ __forceinline__ unsigned f2bf(float f) { unsigned u = __builtin_bit_cast(unsigned, f); return (u + 0x7fffu + ((u >> 16) & 1u)) >> 16; }
__device__ __forceinline__ float bf2f(unsigned h) { return __builtin_bit_cast(float, h << 16); }
__device__ __forceinline__ float sigmoidf_(float v) { return 1.f / (1.f + __expf(-v)); }
__device__ __forceinline__ float siluf_(float v) { return v / (1.f + __expf(-v)); }
__device__ __forceinline__ float shx(float v, int o, int lane) { return __builtin_bit_cast(float, __builtin_amdgcn_ds_bpermute((lane ^ o) << 2, __builtin_bit_cast(int, v))); }
__device__ __forceinline__ float wave_sum(float v, int lane) {
#pragma unroll
    for (int o = 1; o < 64; o <<= 1) v += shx(v, o, lane);
    return v;
}

#define XB_TMO      128
#define XB_XCNT(j)  (256  + 64 * (j))
#define XB_XSUB(j)  (1280 + 64 * (j))
#define XB_XGEN(j)  (2304 + 64 * (j))
#define XB_TOP      3328
#define XB_TOPGEN   3392
#define XCD_BAR_WORDS 3456
#define XB_SPIN_CAP (1u << 24)
__device__ __forceinline__ unsigned xb_ld(unsigned* p)              { return __hip_atomic_load(p, __ATOMIC_RELAXED, __HIP_MEMORY_SCOPE_AGENT); }
__device__ __forceinline__ unsigned xb_add(unsigned* p, unsigned v) { return __hip_atomic_fetch_add(p, v, __ATOMIC_RELAXED, __HIP_MEMORY_SCOPE_AGENT); }
__device__ __forceinline__ unsigned xb_xcc_id() { return (unsigned)__builtin_amdgcn_s_getreg((3 << 11) | 20) & 0xFu; }
#define XB_SPIN(cond, bar) do { unsigned _sp = 0; while (cond) { __builtin_amdgcn_s_sleep(1); \
    if ((++_sp & 255u) == 0u) { if (xb_ld(&(bar)[XB_TMO])) break; if (_sp > XB_SPIN_CAP) { atomicAdd(&(bar)[XB_TMO], 1u); break; } } } } while (0)
struct XcdBarrier { unsigned* bar; unsigned x; volatile LAS unsigned* st; };
__device__ __forceinline__ XcdBarrier xcd_barrier_post(unsigned* bar, volatile LAS unsigned* st) {
    XcdBarrier b; b.bar = bar; b.x = xb_xcc_id(); b.st = st;
    if (threadIdx.x == 0) (void)xb_add(&bar[XB_XCNT(b.x)], 1u);
    return b;
}
__device__ __forceinline__ void xcd_barrier_complete(unsigned* bar, unsigned x, unsigned& nloc, unsigned& nx) {
    const unsigned G = gridDim.x * gridDim.y * gridDim.z;
    unsigned sum, cnt, mine, sp = 0u;
    for (;;) {
        sum = 0u; cnt = 0u; mine = 0u;
#pragma unroll
        for (unsigned j = 0; j < 16; ++j) { const unsigned c = xb_ld(&bar[XB_XCNT(j)]); sum += c; cnt += (c > 0u) ? 1u : 0u; mine = (j == x) ? c : mine; }
        if (sum == G) break;
        __builtin_amdgcn_s_sleep(1);
        if ((++sp & 255u) == 0u) { if (xb_ld(&bar[XB_TMO])) break; if (sp > XB_SPIN_CAP) { atomicAdd(&bar[XB_TMO], 1u); break; } }
    }
    nloc = mine > 0u ? mine : 1u; nx = cnt > 0u ? cnt : 1u;
}
__device__ __forceinline__ void xcd_barrier(const XcdBarrier& b) {
    asm volatile("s_waitcnt vmcnt(0)" ::: "memory");
    __syncthreads();
    if (threadIdx.x == 0) {
        unsigned* bar = b.bar;
        __builtin_amdgcn_s_waitcnt(0);
        unsigned nloc = b.st[0], nx = b.st[1];
        if (nloc == 0u) { xcd_barrier_complete(bar, b.x, nloc, nx); b.st[0] = nloc; b.st[1] = nx; }
        const unsigned old = xb_add(&bar[XB_XSUB(b.x)], 1u);
        const unsigned gen = old / nloc;
        if (old + 1u == (gen + 1u) * nloc) {
            __builtin_amdgcn_fence(__ATOMIC_RELEASE, "agent");
            asm volatile("s_waitcnt vmcnt(0)" ::: "memory");
            const unsigned og = xb_add(&bar[XB_TOP], 1u);
            const unsigned tg = og / nx;
            if (og + 1u == (tg + 1u) * nx) xb_add(&bar[XB_TOPGEN], 1u);
            else XB_SPIN(xb_ld(&bar[XB_TOPGEN]) == tg, bar);
            __builtin_amdgcn_fence(__ATOMIC_ACQUIRE, "agent");
            xb_add(&bar[XB_XGEN(b.x)], 1u);
            asm volatile("s_waitcnt vmcnt(0)" ::: "memory");
        } else {
            XB_SPIN(xb_ld(&bar[XB_XGEN(b.x)]) == gen, bar);
            __builtin_amdgcn_fence(__ATOMIC_ACQUIRE, "agent");
            asm volatile("s_waitcnt vmcnt(0)" ::: "memory");
        }
    }
    __syncthreads();
}

constexpr int LDS_BYTES = 147456;
constexpr int MISC_OFF = 131072 + 320;

struct Args { const float* in[22]; float* out; unsigned char* ws; int ph_lo, ph_hi; };

constexpr int PTR_OFF = MISC_OFF + 128;
struct Frame {
    LAS unsigned char* lds;
    int tid, lane, wave, G, bid;
    __device__ __forceinline__ unsigned long long ptr(int i) const {
        const unsigned long long v = ((volatile LAS unsigned long long*)(lds + PTR_OFF))[i];
        const unsigned lo = __builtin_amdgcn_readfirstlane((unsigned)v), hi = __builtin_amdgcn_readfirstlane((unsigned)(v >> 32));
        return ((unsigned long long)hi << 32) | lo;
    }
    __device__ __forceinline__ const float* in(int i) const { return (const float*)ptr(i); }
    __device__ __forceinline__ float* out() const { return (float*)ptr(22); }
    __device__ __forceinline__ unsigned char* ws() const { return (unsigned char*)ptr(23); }
};
__device__ __forceinline__ Frame phase_frame(const Frame& F) {
    Frame P = F; unsigned l = (unsigned)(unsigned long long)P.lds;
    asm volatile("" : "+v"(P.tid), "+v"(P.lane), "+s"(P.wave), "+s"(P.G), "+s"(P.bid), "+s"(l));
    P.lds = (LAS unsigned char*)(unsigned long long)l; return P;
}
enum { I_X = 0, I_C, I_POS, I_WADA, I_BADA, I_NMIX, I_WIN, I_WA2, I_BA, I_GNORM, I_QN, I_KN, I_SINK, I_WUG, I_WUS, I_WOUT, I_NFFN, I_WR, I_BR, I_WGATE, I_WUP, I_WDOWN };

__device__ __forceinline__ const float* mod_ptr(const Frame& F, int l, int b, int chunk) { return (const float*)(F.ws() + WS_MOD) + ((size_t)(l * BATCH + b) * 6 + chunk) * D; }
namespace pg {
typedef short bf16x8 __attribute__((ext_vector_type(8)));
constexpr int BM = 256, BK = 64, HALF = 128, HTB = HALF * BK * 2, STAGE_BYTES = 8 * HTB;
__host__ __device__ __forceinline__ int lds_byte(int r, int c) { const int st = (r >> 4) * 2 + (c >> 5), rr = r & 15, cc = c & 31, ob = rr * 64 + cc * 2; return st * 1024 + (ob ^ (((ob >> 9) & 1) << 5)); }
__host__ __device__ __forceinline__ void stage_rc(int b, int& R, int& C) { const int st = b / 1024, sb = b % 1024, swz = sb ^ (((sb >> 9) & 1) << 5); R = (st >> 1) * 16 + swz / 64; C = (st & 1) * 32 + (swz % 64) / 2; }
__host__ __device__ __forceinline__ int perm32(int rho) { const int n = rho >> 4, i = rho & 15; return 8 * (i >> 2) + 4 * n + (i & 3); }
struct Unit { const char* A; const char* B; int pm, pn, e, j, valid, keep; };
__device__ __forceinline__ unsigned cvt_pk_bf16(float lo, float hi) { unsigned r; asm volatile("v_cvt_pk_bf16_f32 %0, %1, %2" : "=v"(r) : "v"(lo), "v"(hi)); return r; }

template <class Epi, class Sched>
__device__ __forceinline__ void gemm_phase(LAS unsigned char* lds, const int tid, const int K, const Sched& S, const Epi& E) {
    const int wid = __builtin_amdgcn_readfirstlane(tid >> 6), lane = tid & 63, wr = wid >> 2, wc = wid & 3, fr = lane & 15, fq = lane >> 4;
    const int nt = K / BK;
    int RA[2], CA[2]; unsigned voffB[2];
#pragma unroll
    for (int i = 0; i < 2; ++i) { int R, C; stage_rc(tid * 16 + i * 8192, R, C); const int Rb = (R & ~31) + perm32(R & 31); RA[i] = R; CA[i] = C * 2; voffB[i] = (unsigned)(Rb * K + C) * 2u; }
    const size_t kstep = (size_t)(BK * 2);
    const size_t hstep = (size_t)HALF * K * 2;
    const unsigned ldsw = (unsigned)wid * 1024u;
    const int aoff = lds_byte(wr * 64 + fr, fq * 8), boff = lds_byte(wc * 32 + fr, fq * 8);
#define PG_SA(b, h) (((b) * 2 + (h)) * HTB)
#define PG_SB(b, h) ((4 + (b) * 2 + (h)) * HTB)
#define PG_STAGEB(bufoff, gbase) do { _Pragma("unroll") for (int _i = 0; _i < 2; ++_i) \
        __builtin_amdgcn_global_load_lds((const unsigned*)((const char*)(gbase) + voffB[_i]), (LAS unsigned*)(lds + (bufoff) + ldsw + _i * 8192), 16, 0, 0); } while (0)
#define PG_STAGEA(bufoff, gbase, o0, o1) do { \
        __builtin_amdgcn_global_load_lds((const unsigned*)((const char*)(gbase) + (o0)), (LAS unsigned*)(lds + (bufoff) + ldsw), 16, 0, 0); \
        __builtin_amdgcn_global_load_lds((const unsigned*)((const char*)(gbase) + (o1)), (LAS unsigned*)(lds + (bufoff) + ldsw + 8192), 16, 0, 0); } while (0)
#define PG_LDA(dst, b, h) do { _Pragma("unroll") for (int m = 0; m < 4; ++m) _Pragma("unroll") for (int k = 0; k < 2; ++k) dst[m][k] = *(const LAS bf16x8*)(lds + PG_SA(b, h) + aoff + m * 2048 + k * 1024); } while (0)
#define PG_LDB(dst, b, h) do { _Pragma("unroll") for (int n = 0; n < 2; ++n) _Pragma("unroll") for (int k = 0; k < 2; ++k) dst[n][k] = *(const LAS bf16x8*)(lds + PG_SB(b, h) + boff + n * 2048 + k * 1024); } while (0)
#define PG_MMA(ai, bj, At, Bt) do { __builtin_amdgcn_s_setprio(1); _Pragma("unroll") for (int m = 0; m < 4; ++m) _Pragma("unroll") for (int n = 0; n < 2; ++n) _Pragma("unroll") for (int k = 0; k < 2; ++k) \
        acc[ai][bj][m][n] = __builtin_amdgcn_mfma_f32_16x16x32_bf16(Bt[n][k], At[m][k], acc[ai][bj][m][n], 0, 0, 0); __builtin_amdgcn_s_setprio(0); } while (0)
#define PG_WAIT_V(n) asm volatile("s_waitcnt vmcnt(" #n ")" ::: "memory")
#define PG_WAIT_L(n) asm volatile("s_waitcnt lgkmcnt(" #n ")" ::: "memory")
#define PG_BAR __builtin_amdgcn_s_barrier()
#define PG_SCHED __builtin_amdgcn_sched_barrier(0)
    Unit cur, nxt; int ui = 0;
    if (!S.next(0, cur)) return;
    f32x4 acc[2][2][4][2];
#pragma unroll
    for (int a = 0; a < 2; ++a)
#pragma unroll
        for (int b = 0; b < 2; ++b)
#pragma unroll
            for (int m = 0; m < 4; ++m)
#pragma unroll
                for (int n = 0; n < 2; ++n) acc[a][b][m][n] = (f32x4){0.f, 0.f, 0.f, 0.f};
    bf16x8 At[4][2], B0[2][2], B1[2][2];
    unsigned vA0, vA1, vA2, vA3, vN0, vN1, vN2, vN3;
    vA0 = S.rowoff(cur, RA[0]) + CA[0]; vA1 = S.rowoff(cur, RA[1]) + CA[1]; vA2 = S.rowoff(cur, HALF + RA[0]) + CA[0]; vA3 = S.rowoff(cur, HALF + RA[1]) + CA[1];
    const char* cA = cur.A; const char* cB = cur.B;
    PG_STAGEB(PG_SB(0, 0), cB); PG_STAGEB(PG_SB(0, 1), cB + hstep); PG_STAGEA(PG_SA(0, 0), cA, vA0, vA1); PG_STAGEA(PG_SA(0, 1), cA, vA2, vA3);
    if (wr == 1) PG_BAR;
    PG_WAIT_V(2); PG_BAR;
    PG_STAGEB(PG_SB(1, 0), cB + kstep); PG_STAGEA(PG_SA(1, 0), cA + kstep, vA0, vA1); PG_STAGEB(PG_SB(1, 1), cB + hstep + kstep);
    PG_WAIT_V(6); PG_BAR;
    for (;;) {
        const bool has_next = S.next(ui + 1, nxt);
        const char* nA = has_next ? nxt.A : cA; const char* nB = has_next ? nxt.B : cB;
        if (has_next) { vN0 = S.rowoff(nxt, RA[0]) + CA[0]; vN1 = S.rowoff(nxt, RA[1]) + CA[1]; vN2 = S.rowoff(nxt, HALF + RA[0]) + CA[0]; vN3 = S.rowoff(nxt, HALF + RA[1]) + CA[1]; }
        else { vN0 = vA0; vN1 = vA1; vN2 = vA2; vN3 = vA3; }
        for (int t = 0; t < nt; t += 2) {
            const bool last = (t == nt - 2);
            const char* a1 = cA + (size_t)(t + 1) * kstep;
            const char* a2 = last ? nA : cA + (size_t)(t + 2) * kstep; const char* b2 = last ? nB : cB + (size_t)(t + 2) * kstep;
            const char* a3 = a2 + kstep; const char* b3 = b2 + kstep;
            const unsigned w0 = last ? vN0 : vA0, w1 = last ? vN1 : vA1, w2 = last ? vN2 : vA2, w3 = last ? vN3 : vA3;
            PG_LDB(B0, 0, 0); PG_LDB(B1, 0, 1); PG_SCHED; PG_LDA(At, 0, 0); PG_STAGEA(PG_SA(1, 1), a1, vA2, vA3);
            PG_WAIT_V(8); PG_WAIT_L(0); PG_BAR; PG_MMA(0, 0, At, B0); PG_MMA(0, 1, At, B1); PG_BAR; PG_SCHED;
            PG_LDA(At, 0, 1); PG_STAGEB(PG_SB(0, 0), b2); PG_STAGEB(PG_SB(0, 1), b2 + hstep); PG_STAGEA(PG_SA(0, 0), a2, w0, w1);
            PG_WAIT_V(8); PG_WAIT_L(0); PG_BAR; PG_MMA(1, 0, At, B0); PG_MMA(1, 1, At, B1); PG_BAR; PG_SCHED;
            PG_LDB(B0, 1, 0); PG_LDB(B1, 1, 1); PG_SCHED; PG_LDA(At, 1, 0); PG_STAGEA(PG_SA(0, 1), a2, w2, w3);
            PG_WAIT_V(8); PG_WAIT_L(0); PG_BAR; PG_MMA(0, 0, At, B0); PG_MMA(0, 1, At, B1); PG_BAR; PG_SCHED;
            PG_LDA(At, 1, 1); PG_STAGEB(PG_SB(1, 0), b3); PG_STAGEB(PG_SB(1, 1), b3 + hstep); PG_STAGEA(PG_SA(1, 0), a3, w0, w1);
            PG_WAIT_V(8); PG_WAIT_L(0); PG_BAR; PG_MMA(1, 0, At, B0); PG_MMA(1, 1, At, B1); PG_BAR; PG_SCHED;
        }
        if (wr == 0) PG_BAR;
        E(acc, cur, wr, wc, fr, fq);
        if (!has_next) break;
        if (!cur.keep) {
#pragma unroll
            for (int a = 0; a < 2; ++a)
#pragma unroll
                for (int b = 0; b < 2; ++b)
#pragma unroll
                    for (int m = 0; m < 4; ++m)
#pragma unroll
                        for (int n = 0; n < 2; ++n) acc[a][b][m][n] = (f32x4){0.f, 0.f, 0.f, 0.f};
        }
        cur = nxt; cA = nA; cB = nB; vA0 = vN0; vA1 = vN1; vA2 = vN2; vA3 = vN3; ++ui;
        if (wr == 1) PG_BAR;
    }
    PG_WAIT_V(0);
    PG_BAR;
#undef PG_SA
#undef PG_SB
#undef PG_STAGEA
#undef PG_STAGEB
#undef PG_LDA
#undef PG_LDB
#undef PG_MMA
#undef PG_WAIT_V
#undef PG_WAIT_L
#undef PG_BAR
#undef PG_SCHED
}
struct DenseOrder {
    const char* A; const char* B; int K, nM, nN, nwg, G, c;
    __device__ __forceinline__ void init(const void* A_, const void* B_, int M, int N, int K_, int G_, int c_) { A = (const char*)A_; B = (const char*)B_; K = K_; nM = M / BM; nN = N / BM; nwg = nM * nN; G = G_; c = c_; }
    __device__ __forceinline__ bool tile(int i, int& pm, int& pn) const {
        const long L = (long)i * G + c; if (L >= nwg) return false;
        int wgid = (int)L; { const int q = nwg / 8, r = nwg % 8, xcd = wgid % 8, off = wgid / 8; wgid = (xcd < r ? xcd * (q + 1) : r * (q + 1) + (xcd - r) * q) + off; }
        const int nig = 8 * nN, gid = wgid / nig, fm = gid * 8, gsz = (nM - fm) < 8 ? (nM - fm) : 8;
        pm = fm + ((wgid % nig) % gsz); pn = (wgid % nig) / gsz; return true;
    }
    __device__ __forceinline__ bool next(int i, Unit& u) const {
        int pm, pn; if (!tile(i, pm, pn)) return false;
        u.pm = pm; u.pn = pn; u.e = 0; u.j = 0; u.valid = 256; u.keep = 0;
        u.A = A + (size_t)pm * BM * K * 2; u.B = B + (size_t)pn * BM * K * 2; return true;
    }
    __device__ __forceinline__ unsigned rowoff(const Unit&, int r) const { return (unsigned)(r * K * 2); }
};
}

__device__ __forceinline__ unsigned pk2(float lo, float hi) { return f2bf(lo) | (f2bf(hi) << 16); }
__device__ __forceinline__ void tr_item(const float* W, int ldw, int src_c0, int k0, bf16* WT0, int K, LAS float* scr, int lane) {
#pragma unroll 8
    for (int i = 0; i < 32; ++i) { const int kk = 2 * i + (lane >> 5); scr[kk * 33 + (lane & 31)] = W[(size_t)(k0 + kk) * ldw + src_c0 + (lane & 31)]; }
    asm volatile("s_waitcnt lgkmcnt(0)" ::: "memory");
    const int c = lane & 7;
#pragma unroll
    for (int j = 0; j < 4; ++j) { const int n = (lane >> 3) + 8 * j; const LAS float* sp = scr + (8 * c) * 33 + n;
        u32x4 o; o.x = pk2(sp[0 * 33], sp[1 * 33]); o.y = pk2(sp[2 * 33], sp[3 * 33]); o.z = pk2(sp[4 * 33], sp[5 * 33]); o.w = pk2(sp[6 * 33], sp[7 * 33]);
        *(u32x4*)(WT0 + (size_t)n * K + 8 * c) = o; }
    asm volatile("s_waitcnt lgkmcnt(0)" ::: "memory");
}
__device__ __forceinline__ int win_src_col(int d) {
    return d < 256 ? C_GQ + d : d < 512 ? C_GK + (d - 256) : d < 1024 ? C_GV + (d - 512) : d < 1536 ? C_GR + (d - 1024) : d < 2048 ? C_SQ + (d - 1536) : d < 2176 ? C_SK + (d - 2048)
         : d < 2304 ? C_SV + (d - 2176) : d < 3328 ? C_MA + (d - 2304) : C_MB + (d - 3328);
}
__device__ __forceinline__ void ph_weights(const Frame& F) {
    LAS float* scr = (LAS float*)(F.lds + F.wave * 16384);
    const int gw = F.bid * NWAVES + F.wave, NGW = F.G * NWAVES;
    unsigned char* ws = F.ws();
    constexpr int IA = 16 * 136, IB1 = 8 * 32, IB3 = 16 * 32, IC = 16 * 32, ID = 8 * 32;
    constexpr int NA = DEPTH * IA, NB = DEPTH * (2 * IB1 + IB3), NC = DEPTH * NE * IC, ND = DEPTH * NE * ID;
    for (int it = gw; it < NA + NB + NC + ND; it += NGW) {
        int r = it;
        if (r < NA) { const int l = r / IA, q = r % IA, kb = q / 136, nb = q % 136;
            tr_item(F.in(I_WIN) + (size_t)l * D * INW, INW, win_src_col(32 * nb), 64 * kb, (bf16*)(ws + WS_WIN_T) + ((size_t)l * NIN + 32 * nb) * D + 64 * kb, D, scr, F.lane); continue; }
        r -= NA;
        if (r < NB) { const int l = r / (2 * IB1 + IB3); int q = r % (2 * IB1 + IB3);
            if (q < IB1) { const int kb = q / 32, nb = q % 32; tr_item(F.in(I_WUG) + (size_t)l * 512 * D, D, 32 * nb, 64 * kb, (bf16*)(ws + WS_WG_T) + ((size_t)l * D + 32 * nb) * 512 + 64 * kb, 512, scr, F.lane); continue; }
            q -= IB1;
            if (q < IB1) { const int kb = q / 32, nb = q % 32; tr_item(F.in(I_WUS) + (size_t)l * 512 * D, D, 32 * nb, 64 * kb, (bf16*)(ws + WS_WS_T) + ((size_t)l * D + 32 * nb) * 512 + 64 * kb, 512, scr, F.lane); continue; }
            q -= IB1;
            { const int kb = q / 32, nb = q % 32; tr_item(F.in(I_WOUT) + (size_t)l * D * D, D, 32 * nb, 64 * kb, (bf16*)(ws + WS_WOUT_T) + ((size_t)l * D + 32 * nb) * D + 64 * kb, D, scr, F.lane); continue; } }
        r -= NB;
        if (r < NC) { const int le = r / IC, q = r % IC, kb = q / 32, nb = q % 32, drow = 32 * nb, pn = drow >> 8, up = (drow >> 7) & 1, f0 = drow & 127;
            tr_item((up ? F.in(I_WUP) : F.in(I_WGATE)) + (size_t)le * D * DFF, DFF, 128 * pn + f0, 64 * kb, (bf16*)(ws + WS_WGU_T) + ((size_t)le * 1024 + drow) * D + 64 * kb, D, scr, F.lane); continue; }
        r -= NC;
        { const int le = r / ID, q = r % ID, kb = q / 32, nb = q % 32;
            tr_item(F.in(I_WDOWN) + (size_t)le * DFF * D, D, 32 * nb, 64 * kb, (bf16*)(ws + WS_WD_T) + ((size_t)le * D + 32 * nb) * DFF + 64 * kb, DFF, scr, F.lane); }
    }
    for (int idx = F.bid * NTHREADS + F.tid; idx < DEPTH * 256 * (D / 8); idx += F.G * NTHREADS) {
        const int l = idx / (256 * (D / 8)), q = idx % (256 * (D / 8)), rr = q / (D / 8), k0 = (q % (D / 8)) * 8;
        u32x4 o = (u32x4){0u, 0u, 0u, 0u};
        if (rr < GRANK) { const float* w = F.in(I_WIN) + (size_t)l * D * INW + C_GA + rr;
            o.x = pk2(w[(size_t)(k0 + 0) * INW], w[(size_t)(k0 + 1) * INW]); o.y = pk2(w[(size_t)(k0 + 2) * INW], w[(size_t)(k0 + 3) * INW]);
            o.z = pk2(w[(size_t)(k0 + 4) * INW], w[(size_t)(k0 + 5) * INW]); o.w = pk2(w[(size_t)(k0 + 6) * INW], w[(size_t)(k0 + 7) * INW]); }
        *(u32x4*)((bf16*)(ws + WS_WIN_T) + ((size_t)l * NIN + 4352 + rr) * D + k0) = o;
    }
    __syncthreads();
}

struct EpiG3 {
    const float* xin; float* out; const float* modl;
    __device__ __forceinline__ void operator()(f32x4 (&acc)[2][2][4][2], const pg::Unit& u, int wr, int wc, int fr, int fq) const {
        const float* g = modl + ((size_t)(u.pm >> 5) * 6 + 2) * D; const int col0 = u.pn * 256 + wc * 32 + fq * 8;
        f32x4 gv[2][2];
#pragma unroll
        for (int bj = 0; bj < 2; ++bj)
#pragma unroll
            for (int n = 0; n < 2; ++n) gv[bj][n] = *(const f32x4*)(g + col0 + bj * 128 + n * 4);
#pragma unroll
        for (int ai = 0; ai < 2; ++ai)
#pragma unroll
            for (int m = 0; m < 4; ++m) { const size_t ro = (size_t)(u.pm * 256 + ai * 128 + wr * 64 + m * 16 + fr) * D + col0;
#pragma unroll
                for (int bj = 0; bj < 2; ++bj)
#pragma unroll
                    for (int n = 0; n < 2; ++n) { const f32x4 xv = *(const f32x4*)(xin + ro + bj * 128 + n * 4); *(f32x4*)(out + ro + bj * 128 + n * 4) = xv + gv[bj][n] * acc[ai][bj][m][n]; } }
    }
};
__device__ __forceinline__ void ph_gemm3_mfma(const Frame& F, int l, const float* xin) {
    unsigned char* ws = F.ws();
    pg::DenseOrder S; S.init(ws + WS_MERGED, ws + WS_WOUT_T + (size_t)l * D * D * 2, T, D, D, F.G, F.bid);
    EpiG3 E{xin, F.out(), (const float*)(ws + WS_MOD) + (size_t)l * BATCH * 6 * D};
    pg::gemm_phase(F.lds, F.tid, D, S, E);
}

struct EpiG1 {
    unsigned char* ws;
    __device__ __forceinline__ void operator()(f32x4 (&acc)[2][2][4][2], const pg::Unit& u, int wr, int wc, int fr, int fq) const {
        const int pn = u.pn, row0 = u.pm * 256 + wr * 64 + fr, c8 = wc * 32 + fq * 8;
        if (pn == 17) {
            if (wc == 0 && fq < 2) { float* GA = (float*)(ws + WS_GA);
#pragma unroll
                for (int ai = 0; ai < 2; ++ai)
#pragma unroll
                    for (int m = 0; m < 4; ++m) { float* p = GA + (size_t)(row0 + ai * 128 + m * 16) * 16 + fq * 8; *(f32x4*)p = acc[ai][0][m][0]; *(f32x4*)(p + 4) = acc[ai][0][m][1]; } }
            return;
        }
        bf16* b0; bf16* b1; int ld, op = 0;
        if (pn == 0)      { b0 = (bf16*)(ws + WS_GQ); ld = 256; b1 = b0 + 128; op = 1; }
        else if (pn == 1) { b0 = (bf16*)(ws + WS_GK); ld = 256; b1 = b0 + 128; }
        else if (pn < 4)  { b0 = (bf16*)(ws + WS_GV) + (pn - 2) * 256; ld = 512; b1 = b0 + 128; }
        else if (pn < 6)  { b0 = (bf16*)(ws + WS_GR) + (pn - 4) * 256; ld = 512; b1 = b0 + 128; op = 2; }
        else if (pn < 8)  { b0 = (bf16*)(ws + WS_SQ) + (pn - 6) * 256; ld = 512; b1 = b0 + 128; }
        else if (pn == 8) { b0 = (bf16*)(ws + WS_SK); b1 = (bf16*)(ws + WS_SV); ld = 128; }
        else if (pn < 13) { b0 = (bf16*)(ws + WS_MA) + (pn - 9) * 256; ld = 1024; b1 = b0 + 128; op = 3; }
        else              { b0 = (bf16*)(ws + WS_MB) + (pn - 13) * 256; ld = 1024; b1 = b0 + 128; op = 3; }
#pragma unroll
        for (int ai = 0; ai < 2; ++ai)
#pragma unroll
            for (int m = 0; m < 4; ++m) { const size_t ro = (size_t)(row0 + ai * 128 + m * 16) * ld + c8;
#pragma unroll
                for (int bj = 0; bj < 2; ++bj) { f32x4 v0 = acc[ai][bj][m][0], v1 = acc[ai][bj][m][1];
                    if (op == 1) { v0 = v0 * 0.125f; v1 = v1 * 0.125f; }
                    else if (op == 2) {
#pragma unroll
                        for (int q = 0; q < 4; ++q) { v0[q] = v0[q] * __builtin_amdgcn_rcpf(1.f + __expf(-v0[q])); v1[q] = v1[q] * __builtin_amdgcn_rcpf(1.f + __expf(-v1[q])); } }
                    else if (op == 3) {
#pragma unroll
                        for (int q = 0; q < 4; ++q) { v0[q] = __builtin_amdgcn_rcpf(1.f + __expf(-v0[q])); v1[q] = __builtin_amdgcn_rcpf(1.f + __expf(-v1[q])); } }
                    u32x4 w; w.x = pg::cvt_pk_bf16(v0[0], v0[1]); w.y = pg::cvt_pk_bf16(v0[2], v0[3]); w.z = pg::cvt_pk_bf16(v1[0], v1[1]); w.w = pg::cvt_pk_bf16(v1[2], v1[3]);
                    *(u32x4*)((bj ? b1 : b0) + ro) = w; } }
    }
};
__device__ __forceinline__ void ph_gemm1_mfma(const Frame& F, int l) {
    unsigned char* ws = F.ws();
    pg::DenseOrder S; S.init(ws + WS_H, ws + WS_WIN_T + (size_t)l * NIN * D * 2, T, NIN, D, F.G, F.bid);
    EpiG1 E{ws};
    pg::gemm_phase(F.lds, F.tid, D, S, E);
}
struct G2Order {
    pg::DenseOrder d; const char* A2; const char* B2;
    __device__ __forceinline__ bool next(int i, pg::Unit& u) const {
        int pm, pn; if (!d.tile(i >> 1, pm, pn)) return false;
        const int seg = i & 1; u.pm = pm; u.pn = pn; u.e = seg; u.j = 0; u.valid = 256; u.keep = !seg;
        u.A = (seg ? A2 : d.A) + (size_t)pm * 256 * d.K * 2; u.B = (seg ? B2 : d.B) + (size_t)pn * 256 * d.K * 2; return true;
    }
    __device__ __forceinline__ unsigned rowoff(const pg::Unit&, int r) const { return (unsigned)(r * d.K * 2); }
};
struct EpiG2 {
    const bf16* MA; const bf16* MB; bf16* MG;
    __device__ __forceinline__ void operator()(f32x4 (&acc)[2][2][4][2], const pg::Unit& u, int wr, int wc, int fr, int fq) const {
        const int row0 = u.pm * 256 + wr * 64 + fr, col0 = u.pn * 256 + wc * 32 + fq * 8;
#pragma unroll
        for (int ai = 0; ai < 2; ++ai)
#pragma unroll
            for (int m = 0; m < 4; ++m) { const size_t ro = (size_t)(row0 + ai * 128 + m * 16) * D + col0;
#pragma unroll
                for (int bj = 0; bj < 2; ++bj) {
                    const u32x4 bw = *(const u32x4*)(MB + ro + bj * 128);
                    float sb[8];
#pragma unroll
                    for (int q = 0; q < 4; ++q) { sb[2 * q] = bf2f(bw[q] & 0xffffu); sb[2 * q + 1] = bf2f(bw[q] >> 16); }
                    if (u.e == 0) {
                        const u32x4 aw = *(const u32x4*)(MA + ro + bj * 128);
#pragma unroll
                        for (int q = 0; q < 4; ++q) { const float a0 = bf2f(aw[q] & 0xffffu), a1 = bf2f(aw[q] >> 16);
                            const float r0 = a0 * __builtin_amdgcn_rcpf(fmaxf(sb[2 * q], 1e-20f)), r1 = a1 * __builtin_amdgcn_rcpf(fmaxf(sb[2 * q + 1], 1e-20f));
                            if (q < 2) { acc[ai][bj][m][0][2 * q] *= r0; acc[ai][bj][m][0][2 * q + 1] *= r1; } else { acc[ai][bj][m][1][2 * q - 4] *= r0; acc[ai][bj][m][1][2 * q - 3] *= r1; } }
                    } else {
                        const f32x4 v0 = acc[ai][bj][m][0], v1 = acc[ai][bj][m][1];
                        u32x4 w; w.x = pg::cvt_pk_bf16(v0[0] * sb[0], v0[1] * sb[1]); w.y = pg::cvt_pk_bf16(v0[2] * sb[2], v0[3] * sb[3]);
                        w.z = pg::cvt_pk_bf16(v1[0] * sb[4], v1[1] * sb[5]); w.w = pg::cvt_pk_bf16(v1[2] * sb[6], v1[3] * sb[7]);
                        *(u32x4*)(MG + ro + bj * 128) = w; } } }
    }
};
__device__ __forceinline__ void ph_gemm2_mfma(const Frame& F, int l) {
    unsigned char* ws = F.ws();
    G2Order S; S.d.init(ws + WS_GLAO, ws + WS_WG_T + (size_t)l * D * 512 * 2, T, D, 512, F.G, F.bid); S.A2 = (const char*)(ws + WS_SWAO); S.B2 = (const char*)(ws + WS_WS_T + (size_t)l * D * 512 * 2);
    EpiG2 E{(const bf16*)(ws + WS_MA), (const bf16*)(ws + WS_MB), (bf16*)(ws + WS_MERGED)};
    pg::gemm_phase(F.lds, F.tid, 512, S, E);
}

constexpr int MOE_TAB = 131072 + 1024;
__device__ __forceinline__ void moe_table(const Frame& F, int l) {
    volatile LAS int* tb = (volatile LAS int*)(F.lds + MOE_TAB);
    if (F.tid == 0) { const unsigned* cnt = (const unsigned*)(F.ws() + WS_CTL) + CW_CNT + 64 * (NE * l); int run = 0;
        for (int e = 0; e < NE; ++e) { const int ce = (int)__hip_atomic_load(cnt + 64 * e, __ATOMIC_RELAXED, __HIP_MEMORY_SCOPE_AGENT); tb[e] = run; tb[32 + e] = ce; run += (ce + 255) >> 8; }
        tb[16] = run; }
    __syncthreads();
}
template <bool GATHER>
struct MoeOrder {
    LAS unsigned char* lds; const char* Abase; const char* Bbase; const int* tokl; int K, G, c;
    __device__ __forceinline__ bool next(int i, pg::Unit& u) const {
        volatile LAS int* tb = (volatile LAS int*)(lds + MOE_TAB);
        const int L = i * G + c, ti = L >> 2, pn = L & 3;
        if (ti >= tb[16]) return false;
        int e = 0;
#pragma unroll
        for (int k = 1; k < NE; ++k) e += (ti >= tb[k]) ? 1 : 0;
        e = __builtin_amdgcn_readfirstlane(e);
        const int j = ti - __builtin_amdgcn_readfirstlane(tb[e]), ce = __builtin_amdgcn_readfirstlane(tb[32 + e]);
        u.pm = ti; u.pn = pn; u.e = e; u.j = j; u.valid = (ce - 256 * j) < 256 ? (ce - 256 * j) : 256; u.keep = 0;
        u.A = GATHER ? Abase : Abase + (size_t)ti * 256 * K * 2;
        u.B = Bbase + ((size_t)e * 1024 + pn * 256) * K * 2; return true;
    }
    __device__ __forceinline__ unsigned rowoff(const pg::Unit& u, int r) const {
        if (!GATHER) return (unsigned)(r * K * 2);
        int tk = 0; if (r < u.valid) tk = tokl[(size_t)u.e * ECAP + 256 * u.j + r] >> 1;
        return (unsigned)tk * (unsigned)(K * 2);
    }
};
struct EpiMU {
    bf16* ACT;
    __device__ __forceinline__ void operator()(f32x4 (&acc)[2][2][4][2], const pg::Unit& u, int wr, int wc, int fr, int fq) const {
#pragma unroll
        for (int ai = 0; ai < 2; ++ai)
#pragma unroll
            for (int m = 0; m < 4; ++m) { bf16* p = ACT + (size_t)(u.pm * 256 + ai * 128 + wr * 64 + m * 16 + fr) * DFF + u.pn * 128 + wc * 32 + fq * 8;
                float o[8];
#pragma unroll
                for (int n = 0; n < 2; ++n)
#pragma unroll
                    for (int q = 0; q < 4; ++q) { const float g = acc[ai][0][m][n][q]; o[n * 4 + q] = g * __builtin_amdgcn_rcpf(1.f + __expf(-g)) * acc[ai][1][m][n][q]; }
                u32x4 w; w.x = pg::cvt_pk_bf16(o[0], o[1]); w.y = pg::cvt_pk_bf16(o[2], o[3]); w.z = pg::cvt_pk_bf16(o[4], o[5]); w.w = pg::cvt_pk_bf16(o[6], o[7]);
                *(u32x4*)p = w; }
    }
};
struct EpiMD {
    bf16* Y0; const int* tokl; const float* wl;
    __device__ __forceinline__ void operator()(f32x4 (&acc)[2][2][4][2], const pg::Unit& u, int wr, int wc, int fr, int fq) const {
        const size_t lb = (size_t)u.e * ECAP + 256 * u.j; const int c8 = u.pn * 256 + wc * 32 + fq * 8;
#pragma unroll
        for (int ai = 0; ai < 2; ++ai)
#pragma unroll
            for (int m = 0; m < 4; ++m) { const int r = ai * 128 + wr * 64 + m * 16 + fr;
                if (r < u.valid) { const int ent = tokl[lb + r]; const float w = wl[lb + r];
                    bf16* p = Y0 + (size_t)(ent & 1) * ((WS_Y1 - WS_Y0) / 2) + (size_t)(ent >> 1) * D + c8;
#pragma unroll
                    for (int bj = 0; bj < 2; ++bj) { const f32x4 v0 = acc[ai][bj][m][0] * w, v1 = acc[ai][bj][m][1] * w;
                        u32x4 o; o.x = pg::cvt_pk_bf16(v0[0], v0[1]); o.y = pg::cvt_pk_bf16(v0[2], v0[3]); o.z = pg::cvt_pk_bf16(v1[0], v1[1]); o.w = pg::cvt_pk_bf16(v1[2], v1[3]);
                        *(u32x4*)(p + bj * 128) = o; } } }
    }
};
__device__ __forceinline__ int vcu_of(const Frame& F) { return (F.G % 8 == 0) ? (F.bid % 8) * (F.G / 8) + F.bid / 8 : F.bid; }
__device__ __forceinline__ void ph_moe_up_mfma(const Frame& F, int l) {
    unsigned char* ws = F.ws(); moe_table(F, l);
    MoeOrder<true> S{F.lds, (const char*)(ws + WS_H), (const char*)(ws + WS_WGU_T + (size_t)l * NE * 1024 * D * 2), (const int*)(ws + WS_TOKL), D, F.G, vcu_of(F)};
    EpiMU E{(bf16*)(ws + WS_ACT)};
    pg::gemm_phase(F.lds, F.tid, D, S, E);
}
__device__ __forceinline__ void ph_moe_down_mfma(const Frame& F, int l) {
    unsigned char* ws = F.ws(); moe_table(F, l);
    MoeOrder<false> S{F.lds, (const char*)(ws + WS_ACT), (const char*)(ws + WS_WD_T + (size_t)l * NE * 1024 * DFF * 2), (const int*)(ws + WS_TOKL), DFF, F.G, vcu_of(F)};
    EpiMD E{(bf16*)(ws + WS_Y0), (const int*)(ws + WS_TOKL), (const float*)(ws + WS_WL)};
    pg::gemm_phase(F.lds, F.tid, DFF, S, E);
}
__device__ __forceinline__ void ph_final(const Frame& F) {
    const bf16* Y0 = (const bf16*)(F.ws() + WS_Y0); const bf16* Y1 = (const bf16*)(F.ws() + WS_Y1); float* xo = F.out();
    const int gw = F.bid * NWAVES + F.wave, NGW = F.G * NWAVES;
    for (int m = gw; m < T; m += NGW) { const int b = m / SEQ;
#pragma unroll
        for (int j = 0; j < 4; ++j) { const int col = 4 * F.lane + 256 * j; const f32x4 g2 = *(const f32x4*)(mod_ptr(F, DEPTH - 1, b, 5) + col);
            f32x4 v = *(const f32x4*)(xo + (size_t)m * D + col);
            const unsigned long long a = *(const unsigned long long*)(Y0 + (size_t)m * D + col), c = *(const unsigned long long*)(Y1 + (size_t)m * D + col);
            v.x += g2.x * (bf2f((unsigned)a & 0xffffu) + bf2f((unsigned)c & 0xffffu)); v.y += g2.y * (bf2f(((unsigned)a) >> 16) + bf2f(((unsigned)c) >> 16));
            v.z += g2.z * (bf2f((unsigned)(a >> 32) & 0xffffu) + bf2f((unsigned)(c >> 32) & 0xffffu)); v.w += g2.w * (bf2f((unsigned)(a >> 48)) + bf2f((unsigned)(c >> 48)));
            *(f32x4*)(xo + (size_t)m * D + col) = v; } }
}

__device__ __forceinline__ void ph_rope_table(const Frame& F) {
    const int* pos = (const int*)F.in(I_POS); float* RT = (float*)(F.ws() + WS_ROPE);
    for (int idx = F.bid * NTHREADS + F.tid; idx < T * 8; idx += F.G * NTHREADS) {
        const int t = idx >> 3, i = idx & 7;
        const float invf = (float)exp2(-(double)i * (1.0 / 8.0) * 18.931568569324174);
        const float ang = (float)pos[t] * invf;
        const double rev = (double)ang * 0.15915494309189535; const float fr = (float)(rev - floor(rev));
        RT[(size_t)t * 16 + i] = __builtin_amdgcn_cosf(fr); RT[(size_t)t * 16 + 8 + i] = __builtin_amdgcn_sinf(fr);
    }
}
typedef float f32x16 __attribute__((ext_vector_type(16)));
constexpr int SWA_KP = 144, SWA_VP = 520, SWA_VT_OFF = 256 * SWA_KP;
__device__ __forceinline__ void ph_swa_mfma(const Frame& F, int l) {
    unsigned char* ws = F.ws();
    const bf16* SQ = (const bf16*)(ws + WS_SQ); const bf16* SK = (const bf16*)(ws + WS_SK); const bf16* SV = (const bf16*)(ws + WS_SV); bf16* O = (bf16*)(ws + WS_SWAO);
    const float* RT = (const float*)(ws + WS_ROPE);
    const float* qn = F.in(I_QN) + l * SHD; const float* kn = F.in(I_KN) + l * SHD; const float* sinks = F.in(I_SINK) + l * SH;
    LAS unsigned char* Kb = F.lds; LAS unsigned char* Vt = F.lds + SWA_VT_OFF;
    const int tid = F.tid, lane = F.lane, w = F.wave, r = lane & 31, h = lane >> 5;
    constexpr float QSCALE = 0.125f * 1.4426950408889634f;
    for (int unit = F.bid; unit < BATCH * SKV * (SEQ / WIN); unit += F.G) {
        const int n = unit & 63, kvh = (unit >> 6) & 1, b = unit >> 7;
        const int tq0 = b * SEQ + n * WIN, tk0 = tq0 - WIN;
        __syncthreads();
#pragma unroll
        for (int it = 0; it < 4; ++it) {
            const int key = (tid >> 3) + 64 * it, c = tid & 7; const bool valid = (n > 0) || (key >= WIN); const int tok = valid ? tk0 + key : tq0;
            const u32x4 raw = *(const u32x4*)(SK + (size_t)tok * 128 + kvh * 64 + 8 * c);
            float v[8];
#pragma unroll
            for (int q = 0; q < 4; ++q) { v[2 * q] = bf2f(raw[q] & 0xffffu); v[2 * q + 1] = bf2f(raw[q] >> 16); }
            float ss = 0.f;
#pragma unroll
            for (int j = 0; j < 8; ++j) ss += v[j] * v[j];
            ss += shx(ss, 1, lane); ss += shx(ss, 2, lane); ss += shx(ss, 4, lane);
            const float rstd = 1.0f / sqrtf(ss * (1.f / 64.f) + EPS);
            const f32x4 g0 = *(const f32x4*)(kn + 8 * c), g1 = *(const f32x4*)(kn + 8 * c + 4);
#pragma unroll
            for (int j = 0; j < 4; ++j) { v[j] = v[j] * rstd * g0[j]; v[4 + j] = v[4 + j] * rstd * g1[j]; }
            float pr[8];
#pragma unroll
            for (int j = 0; j < 8; ++j) pr[j] = shx(v[j], 1, lane);
            if (c < 2) {
                const f32x4 c0 = *(const f32x4*)(RT + (size_t)tok * 16), c1 = *(const f32x4*)(RT + (size_t)tok * 16 + 4), s0 = *(const f32x4*)(RT + (size_t)tok * 16 + 8), s1 = *(const f32x4*)(RT + (size_t)tok * 16 + 12);
                const float sg = c == 0 ? -1.f : 1.f;
#pragma unroll
                for (int j = 0; j < 4; ++j) { v[j] = v[j] * c0[j] + sg * pr[j] * s0[j]; v[4 + j] = v[4 + j] * c1[j] + sg * pr[4 + j] * s1[j]; }
            }
            u32x4 o; o.x = pk2(v[0], v[1]); o.y = pk2(v[2], v[3]); o.z = pk2(v[4], v[5]); o.w = pk2(v[6], v[7]);
            if (!valid) o = (u32x4){0u, 0u, 0u, 0u};
            *(LAS u32x4*)(Kb + key * SWA_KP + 16 * c) = o;
        }
#pragma unroll
        for (int it = 0; it < 2; ++it) {
            const int kp = (tid >> 3) + 64 * it, c = tid & 7, key = 2 * kp; const bool valid = (n > 0) || (key >= WIN); const int tok = valid ? tk0 + key : tq0;
            u32x4 r0 = *(const u32x4*)(SV + (size_t)tok * 128 + kvh * 64 + 8 * c), r1 = *(const u32x4*)(SV + (size_t)(tok + 1) * 128 + kvh * 64 + 8 * c);
            if (!valid) { r0 = (u32x4){0u, 0u, 0u, 0u}; r1 = r0; }
#pragma unroll
            for (int q = 0; q < 4; ++q) {
                *(LAS unsigned*)(Vt + (8 * c + 2 * q) * SWA_VP + 4 * kp) = (r0[q] & 0xffffu) | (r1[q] << 16);
                *(LAS unsigned*)(Vt + (8 * c + 2 * q + 1) * SWA_VP + 4 * kp) = (r0[q] >> 16) | (r1[q] & 0xffff0000u);
            }
        }
        __syncthreads();
        const int g = w >> 1, hq = kvh * 4 + g; const float sink2 = sinks[hq] * 1.4426950408889634f;
#pragma unroll 1
        for (int qt = 0; qt < 2; ++qt) {
            const int p0 = 64 * (w & 1) + 32 * qt; const size_t tq = (size_t)(tq0 + p0 + r);
            float qv[4][8]; float ss = 0.f;
#pragma unroll
            for (int s4 = 0; s4 < 4; ++s4) { const u32x4 raw = *(const u32x4*)(SQ + tq * 512 + hq * 64 + 16 * s4 + 8 * h);
#pragma unroll
                for (int q = 0; q < 4; ++q) { qv[s4][2 * q] = bf2f(raw[q] & 0xffffu); qv[s4][2 * q + 1] = bf2f(raw[q] >> 16); } }
#pragma unroll
            for (int s4 = 0; s4 < 4; ++s4)
#pragma unroll
                for (int j = 0; j < 8; ++j) ss += qv[s4][j] * qv[s4][j];
            ss += shx(ss, 32, lane);
            const float rstd = 1.0f / sqrtf(ss * (1.f / 64.f) + EPS);
#pragma unroll
            for (int s4 = 0; s4 < 4; ++s4) { const f32x4 g0 = *(const f32x4*)(qn + 16 * s4 + 8 * h), g1 = *(const f32x4*)(qn + 16 * s4 + 8 * h + 4);
#pragma unroll
                for (int j = 0; j < 4; ++j) { qv[s4][j] = qv[s4][j] * rstd * g0[j]; qv[s4][4 + j] = qv[s4][4 + j] * rstd * g1[j]; } }
            { float pr[8];
#pragma unroll
              for (int j = 0; j < 8; ++j) pr[j] = shx(qv[0][j], 32, lane);
              const f32x4 c0 = *(const f32x4*)(RT + tq * 16), c1 = *(const f32x4*)(RT + tq * 16 + 4), s0 = *(const f32x4*)(RT + tq * 16 + 8), s1 = *(const f32x4*)(RT + tq * 16 + 12);
              const float sg = h == 0 ? -1.f : 1.f;
#pragma unroll
              for (int j = 0; j < 4; ++j) { qv[0][j] = qv[0][j] * c0[j] + sg * pr[j] * s0[j]; qv[0][4 + j] = qv[0][4 + j] * c1[j] + sg * pr[4 + j] * s1[j]; } }
            pg::bf16x8 qf[4];
#pragma unroll
            for (int s4 = 0; s4 < 4; ++s4) { u32x4 t; t.x = pk2(qv[s4][0] * QSCALE, qv[s4][1] * QSCALE); t.y = pk2(qv[s4][2] * QSCALE, qv[s4][3] * QSCALE); t.z = pk2(qv[s4][4] * QSCALE, qv[s4][5] * QSCALE); t.w = pk2(qv[s4][6] * QSCALE, qv[s4][7] * QSCALE);
                qf[s4] = __builtin_bit_cast(pg::bf16x8, t); }
            f32x16 sc[5];
#pragma unroll
            for (int kt = 0; kt < 5; ++kt) {
                f32x16 a16;
#pragma unroll
                for (int i = 0; i < 16; ++i) a16[i] = 0.f;
#pragma unroll
                for (int s4 = 0; s4 < 4; ++s4) { const pg::bf16x8 ka = *(const LAS pg::bf16x8*)(Kb + (p0 + 32 * kt + r) * SWA_KP + (16 * s4 + 8 * h) * 2);
                    a16 = __builtin_amdgcn_mfma_f32_32x32x16_bf16(ka, qf[s4], a16, 0, 0, 0); }
                sc[kt] = a16;
            }
            const int kt_lo = (n == 0) ? 4 - (p0 >> 5) : 0;
            float mx = sink2;
#pragma unroll
            for (int kt = 0; kt < 5; ++kt)
#pragma unroll
                for (int i = 0; i < 16; ++i) { const int kk = (i & 3) + 8 * (i >> 2) + 4 * h;
                    bool ok = kt >= kt_lo; if (kt == 0) ok = ok && (kk > r); if (kt == 4) ok = ok && (kk <= r);
                    const float sv = ok ? sc[kt][i] : -1e30f; sc[kt][i] = sv; mx = fmaxf(mx, sv); }
            mx = fmaxf(mx, shx(mx, 32, lane));
            float den = 0.f;
#pragma unroll
            for (int kt = 0; kt < 5; ++kt)
#pragma unroll
                for (int i = 0; i < 16; ++i) { const float p = __builtin_amdgcn_exp2f(sc[kt][i] - mx); sc[kt][i] = p; den += p; }
            den += shx(den, 32, lane); den += __builtin_amdgcn_exp2f(sink2 - mx);
            const float inv = 1.f / den;
            f32x16 o0, o1;
#pragma unroll
            for (int i = 0; i < 16; ++i) { o0[i] = 0.f; o1[i] = 0.f; }
#pragma unroll
            for (int kt = 0; kt < 5; ++kt)
#pragma unroll
                for (int s2 = 0; s2 < 2; ++s2) {
                    u32x4 t; t.x = pk2(sc[kt][8 * s2 + 0], sc[kt][8 * s2 + 1]); t.y = pk2(sc[kt][8 * s2 + 2], sc[kt][8 * s2 + 3]); t.z = pk2(sc[kt][8 * s2 + 4], sc[kt][8 * s2 + 5]); t.w = pk2(sc[kt][8 * s2 + 6], sc[kt][8 * s2 + 7]);
                    const pg::bf16x8 pf = __builtin_bit_cast(pg::bf16x8, t);
                    const int kb0 = p0 + 32 * kt + 16 * s2 + 4 * h;
                    typedef unsigned u32x2 __attribute__((ext_vector_type(2)));
                    const u32x2 a0 = *(const LAS u32x2*)(Vt + r * SWA_VP + kb0 * 2), a1 = *(const LAS u32x2*)(Vt + r * SWA_VP + (kb0 + 8) * 2);
                    const u32x2 b0 = *(const LAS u32x2*)(Vt + (32 + r) * SWA_VP + kb0 * 2), b1 = *(const LAS u32x2*)(Vt + (32 + r) * SWA_VP + (kb0 + 8) * 2);
                    u32x4 va; va.x = a0.x; va.y = a0.y; va.z = a1.x; va.w = a1.y; u32x4 vb; vb.x = b0.x; vb.y = b0.y; vb.z = b1.x; vb.w = b1.y;
                    o0 = __builtin_amdgcn_mfma_f32_32x32x16_bf16(__builtin_bit_cast(pg::bf16x8, va), pf, o0, 0, 0, 0);
                    o1 = __builtin_amdgcn_mfma_f32_32x32x16_bf16(__builtin_bit_cast(pg::bf16x8, vb), pf, o1, 0, 0, 0);
                }
            bf16* op = O + tq * 512 + hq * 64 + 4 * h;
#pragma unroll
            for (int i4 = 0; i4 < 4; ++i4) {
                const unsigned long long w0 = (unsigned long long)pk2(o0[4 * i4] * inv, o0[4 * i4 + 1] * inv) | ((unsigned long long)pk2(o0[4 * i4 + 2] * inv, o0[4 * i4 + 3] * inv) << 32);
                const unsigned long long w1 = (unsigned long long)pk2(o1[4 * i4] * inv, o1[4 * i4 + 1] * inv) | ((unsigned long long)pk2(o1[4 * i4 + 2] * inv, o1[4 * i4 + 3] * inv) << 32);
                *(unsigned long long*)(op + 8 * i4) = w0; *(unsigned long long*)(op + 32 + 8 * i4) = w1;
            }
        }
    }
    __syncthreads();
}

constexpr int GLA_GRP = 8, GLA_NG = NCH / GLA_GRP, GLA_UNITS = BATCH * GH * GLA_NG;
constexpr int GL_LA = 0, GL_SEG = 16384, GL_BEND = 18432, GL_DEC = 18688, GL_QD = 19456, GL_KI = 28672, GL_ATT = 37888, GL_KET = 47104, GL_VT = 56320, GL_OB = 75776, GL_P = 144;
typedef unsigned u32x2 __attribute__((ext_vector_type(2)));
template <bool OUT>
__device__ __forceinline__ void ph_gla_mfma(const Frame& F, int l) {
    unsigned char* ws = F.ws();
    const bf16* GQ = (const bf16*)(ws + WS_GQ); const bf16* GK = (const bf16*)(ws + WS_GK); const bf16* GV = (const bf16*)(ws + WS_GV); const bf16* GR = (const bf16*)(ws + WS_GR);
    const float* GA = (const float*)(ws + WS_GA); float* SLOC = (float*)(ws + WS_STATE); float* GDEC = (float*)(ws + WS_DECAY); bf16* GO = (bf16*)(ws + WS_GLAO);
    const float* wa2 = F.in(I_WA2) + (size_t)l * GRANK * 256; const float* ba = F.in(I_BA) + l * 256; const float* gn = F.in(I_GNORM) + l * 512;
    LAS unsigned char* L0 = F.lds;
    const int tid = F.tid, lane = F.lane, w = F.wave, L = lane & 15, q = lane >> 4;
    for (int ui = 0; ui < 2; ++ui) {
        int unit = ui == 0 ? F.bid : GLA_UNITS / 2 + (F.bid & ~15) + (15 - (F.bid & 15));
        if (F.G != GLA_UNITS / 2) { unit = F.bid + ui * F.G; }
        for (; unit < GLA_UNITS; unit += (F.G != GLA_UNITS / 2) ? 2 * F.G : GLA_UNITS) {
        const int g = unit & 15, h = (unit >> 4) & 3, b = unit >> 6;
        const int d_ = tid & 63;
        float w2r[GRANK];
#pragma unroll
        for (int r = 0; r < GRANK; ++r) w2r[r] = wa2[r * 256 + h * 64 + d_];
        const float ba_d = ba[h * 64 + d_];
        f32x4 S[4];
#pragma unroll
        for (int t = 0; t < 4; ++t) S[t] = (f32x4){0.f, 0.f, 0.f, 0.f};
        if (OUT) {
            for (int gp = 0; gp < g; ++gp) { const int up = unit - g + gp;
#pragma unroll
                for (int t = 0; t < 4; ++t) { const f32x4 dc = *(const f32x4*)(GDEC + (size_t)up * 64 + 16 * t + 4 * q);
#pragma unroll
                    for (int rg = 0; rg < 4; ++rg) S[t][rg] = dc[rg] * S[t][rg] + SLOC[((size_t)up * 64 + 16 * t + 4 * q + rg) * 128 + 16 * w + L]; } }
        }
        float gtot = 0.f;
#pragma unroll 1
        for (int c = 0; c < GLA_GRP; ++c) {
            const int t0 = b * SEQ + (g * GLA_GRP + c) * GCH;
            float p[8];
            { float run = 0.f;
#pragma unroll
              for (int ii = 0; ii < 8; ++ii) { const float* ar = GA + (size_t)(t0 + 8 * w + ii) * 16; float u = ba_d;
#pragma unroll
                  for (int r = 0; r < GRANK; ++r) u += ar[r] * w2r[r];
                  const float ls = fminf(u, 0.f) - log1pf(__expf(-fabsf(u)));
                  run += ls * (1.f / 16.f); p[ii] = run; }
              *(LAS float*)(L0 + GL_SEG + (w * 64 + d_) * 4) = run; }
            __syncthreads();
            { float off = 0.f, tot = 0.f;
#pragma unroll
              for (int sg = 0; sg < 8; ++sg) { const float v = *(LAS float*)(L0 + GL_SEG + (sg * 64 + d_) * 4); off += (sg < w) ? v : 0.f; tot += v; }
#pragma unroll
              for (int ii = 0; ii < 8; ++ii) *(LAS float*)(L0 + GL_LA + ((8 * w + ii) * 64 + d_) * 4) = off + p[ii];
              if (w == 0) { *(LAS float*)(L0 + GL_BEND + d_ * 4) = tot; *(LAS float*)(L0 + GL_DEC + d_ * 4) = __expf(tot); gtot += tot; } }
            __syncthreads();
            { const int ip = tid >> 4, c4 = tid & 15; const f32x4 be = *(LAS f32x4*)(L0 + GL_BEND + 16 * c4);
              float ke[2][4];
#pragma unroll
              for (int rr = 0; rr < 2; ++rr) { const int i = 2 * ip + rr; const f32x4 bb = *(LAS f32x4*)(L0 + GL_LA + (i * 64 + 4 * c4) * 4);
                  const u32x2 kr = *(const u32x2*)(GK + (size_t)(t0 + i) * 256 + h * 64 + 4 * c4);
                  const float k0 = bf2f(kr.x & 0xffffu), k1 = bf2f(kr.x >> 16), k2 = bf2f(kr.y & 0xffffu), k3 = bf2f(kr.y >> 16);
                  ke[rr][0] = k0 * __expf(be[0] - bb[0]); ke[rr][1] = k1 * __expf(be[1] - bb[1]); ke[rr][2] = k2 * __expf(be[2] - bb[2]); ke[rr][3] = k3 * __expf(be[3] - bb[3]);
                  if (OUT) { const u32x2 qr = *(const u32x2*)(GQ + (size_t)(t0 + i) * 256 + h * 64 + 4 * c4);
                      const float e0 = __expf(bb[0]), e1 = __expf(bb[1]), e2 = __expf(bb[2]), e3 = __expf(bb[3]);
                      u32x2 o; o.x = pk2(bf2f(qr.x & 0xffffu) * e0, bf2f(qr.x >> 16) * e1); o.y = pk2(bf2f(qr.y & 0xffffu) * e2, bf2f(qr.y >> 16) * e3);
                      *(LAS u32x2*)(L0 + GL_QD + i * GL_P + 8 * c4) = o;
                      u32x2 o2; o2.x = pk2(k0 * __builtin_amdgcn_rcpf(e0), k1 * __builtin_amdgcn_rcpf(e1)); o2.y = pk2(k2 * __builtin_amdgcn_rcpf(e2), k3 * __builtin_amdgcn_rcpf(e3));
                      *(LAS u32x2*)(L0 + GL_KI + i * GL_P + 8 * c4) = o2; } }
#pragma unroll
              for (int dd = 0; dd < 4; ++dd) *(LAS unsigned*)(L0 + GL_KET + (4 * c4 + dd) * GL_P + 4 * ip) = pk2(ke[0][dd], ke[1][dd]);
              const u32x4 v0 = *(const u32x4*)(GV + (size_t)(t0 + 2 * ip) * 512 + h * 128 + 8 * c4), v1 = *(const u32x4*)(GV + (size_t)(t0 + 2 * ip + 1) * 512 + h * 128 + 8 * c4);
#pragma unroll
              for (int x = 0; x < 4; ++x) { *(LAS unsigned*)(L0 + GL_VT + (8 * c4 + 2 * x) * GL_P + 4 * ip) = (v0[x] & 0xffffu) | (v1[x] << 16);
                  *(LAS unsigned*)(L0 + GL_VT + (8 * c4 + 2 * x + 1) * GL_P + 4 * ip) = (v0[x] >> 16) | (v1[x] & 0xffff0000u); } }
            __syncthreads();
            f32x4 ao[4];
            if (OUT) {
#pragma unroll
                for (int tt = 0; tt < 2; ++tt) { const int idx = w + 8 * tt, it = idx >> 2, jt = idx & 3; f32x4 a4 = (f32x4){0.f, 0.f, 0.f, 0.f};
#pragma unroll
                    for (int s2 = 0; s2 < 2; ++s2) { const pg::bf16x8 ka = *(const LAS pg::bf16x8*)(L0 + GL_KI + (16 * jt + L) * GL_P + (32 * s2 + 8 * q) * 2), qb = *(const LAS pg::bf16x8*)(L0 + GL_QD + (16 * it + L) * GL_P + (32 * s2 + 8 * q) * 2);
                        a4 = __builtin_amdgcn_mfma_f32_16x16x32_bf16(ka, qb, a4, 0, 0, 0); }
                    const int i = 16 * it + L, j0 = 16 * jt + 4 * q;
                    u32x2 o; o.x = pk2(j0 + 0 <= i ? a4[0] : 0.f, j0 + 1 <= i ? a4[1] : 0.f); o.y = pk2(j0 + 2 <= i ? a4[2] : 0.f, j0 + 3 <= i ? a4[3] : 0.f);
                    *(LAS u32x2*)(L0 + GL_ATT + i * GL_P + j0 * 2) = o; }
                __syncthreads();
#pragma unroll
                for (int it = 0; it < 4; ++it) ao[it] = (f32x4){0.f, 0.f, 0.f, 0.f};
#pragma unroll
                for (int s2 = 0; s2 < 2; ++s2) { u32x4 sb; sb.x = pk2(S[2 * s2][0], S[2 * s2][1]); sb.y = pk2(S[2 * s2][2], S[2 * s2][3]); sb.z = pk2(S[2 * s2 + 1][0], S[2 * s2 + 1][1]); sb.w = pk2(S[2 * s2 + 1][2], S[2 * s2 + 1][3]);
                    const pg::bf16x8 bS = __builtin_bit_cast(pg::bf16x8, sb);
#pragma unroll
                    for (int it = 0; it < 4; ++it) { const u32x2 x0 = *(const LAS u32x2*)(L0 + GL_QD + (16 * it + L) * GL_P + (32 * s2 + 4 * q) * 2), x1 = *(const LAS u32x2*)(L0 + GL_QD + (16 * it + L) * GL_P + (32 * s2 + 16 + 4 * q) * 2);
                        u32x4 xa; xa.x = x0.x; xa.y = x0.y; xa.z = x1.x; xa.w = x1.y;
                        ao[it] = __builtin_amdgcn_mfma_f32_16x16x32_bf16(__builtin_bit_cast(pg::bf16x8, xa), bS, ao[it], 0, 0, 0); } }
            }
#pragma unroll
            for (int t = 0; t < 4; ++t) { const f32x4 dc = *(LAS f32x4*)(L0 + GL_DEC + (16 * t + 4 * q) * 4); S[t] = S[t] * dc; }
#pragma unroll
            for (int s2 = 0; s2 < 2; ++s2) { const pg::bf16x8 bV = *(const LAS pg::bf16x8*)(L0 + GL_VT + (16 * w + L) * GL_P + (32 * s2 + 8 * q) * 2);
                if (OUT) {
#pragma unroll
                    for (int it = 0; it < 4; ++it) { const pg::bf16x8 aa = *(const LAS pg::bf16x8*)(L0 + GL_ATT + (16 * it + L) * GL_P + (32 * s2 + 8 * q) * 2);
                        ao[it] = __builtin_amdgcn_mfma_f32_16x16x32_bf16(aa, bV, ao[it], 0, 0, 0); } }
#pragma unroll
                for (int t = 0; t < 4; ++t) { const pg::bf16x8 ka = *(const LAS pg::bf16x8*)(L0 + GL_KET + (16 * t + L) * GL_P + (32 * s2 + 8 * q) * 2);
                    S[t] = __builtin_amdgcn_mfma_f32_16x16x32_bf16(ka, bV, S[t], 0, 0, 0); } }
            if (OUT) {
#pragma unroll
                for (int it = 0; it < 4; ++it)
#pragma unroll
                    for (int rg = 0; rg < 4; ++rg) *(LAS float*)(L0 + GL_OB + ((16 * it + 4 * q + rg) * 132 + 16 * w + L) * 4) = ao[it][rg];
                __syncthreads();
                { const int i = tid >> 3, c8 = tid & 7; f32x4 ov[4]; float ss = 0.f;
#pragma unroll
                  for (int x = 0; x < 4; ++x) { ov[x] = *(LAS f32x4*)(L0 + GL_OB + (i * 132 + 16 * c8 + 4 * x) * 4); ss += (ov[x][0] * ov[x][0] + ov[x][1] * ov[x][1]) + (ov[x][2] * ov[x][2] + ov[x][3] * ov[x][3]); }
                  ss += shx(ss, 1, lane); ss += shx(ss, 2, lane); ss += shx(ss, 4, lane);
                  const float rstd = 1.0f / sqrtf(ss * (1.f / 128.f) + EPS);
                  const size_t go = (size_t)(t0 + i) * 512 + h * 128 + 16 * c8;
#pragma unroll
                  for (int hh = 0; hh < 2; ++hh) { const u32x4 rr = *(const u32x4*)(GR + go + 8 * hh); const f32x4 g0 = *(const f32x4*)(gn + h * 128 + 16 * c8 + 8 * hh), g1 = *(const f32x4*)(gn + h * 128 + 16 * c8 + 8 * hh + 4);
                      const f32x4 a = ov[2 * hh], bq = ov[2 * hh + 1]; u32x4 o;
                      o.x = pk2(a[0] * rstd * g0[0] * bf2f(rr.x & 0xffffu), a[1] * rstd * g0[1] * bf2f(rr.x >> 16)); o.y = pk2(a[2] * rstd * g0[2] * bf2f(rr.y & 0xffffu), a[3] * rstd * g0[3] * bf2f(rr.y >> 16));
                      o.z = pk2(bq[0] * rstd * g1[0] * bf2f(rr.z & 0xffffu), bq[1] * rstd * g1[1] * bf2f(rr.z >> 16)); o.w = pk2(bq[2] * rstd * g1[2] * bf2f(rr.w & 0xffffu), bq[3] * rstd * g1[3] * bf2f(rr.w >> 16));
                      *(u32x4*)(GO + go + 8 * hh) = o; } }
            }
        }
        if (!OUT) {
#pragma unroll
            for (int t = 0; t < 4; ++t)
#pragma unroll
                for (int rg = 0; rg < 4; ++rg) SLOC[((size_t)unit * 64 + 16 * t + 4 * q + rg) * 128 + 16 * w + L] = S[t][rg];
            if (w == 0) GDEC[(size_t)unit * 64 + d_] = __expf(gtot);
        }
        __syncthreads();
        }
    }
}

template <bool DUAL, class RowFn, class RowFn2, class Epi>
__device__ __forceinline__ void naive_gemm(const Frame& F, int M, int N, int K, RowFn rowp, RowFn2 rowp2, const float* Bw, const float* Bw2, int ldb, Epi epi) {
    const int tx = F.tid & 31, ty = F.tid >> 5;
    const int tilesN = (N + 127) / 128, tilesM = (M + 63) / 64;
    for (int tile = F.bid; tile < tilesM * tilesN; tile += F.G) {
        const int tm = tile / tilesN, tn = tile % tilesN;
        const int r0 = tm * 64 + ty * 4, c0 = tn * 128 + tx * 4;
        if (c0 >= N || r0 >= M) continue;
        float acc[4][4], acc2[4][4];
#pragma unroll
        for (int i = 0; i < 4; ++i)
#pragma unroll
            for (int j = 0; j < 4; ++j) { acc[i][j] = 0.f; acc2[i][j] = 0.f; }
        const bf16* ar0 = rowp(r0 + 0 < M ? r0 + 0 : M - 1); const bf16* ar1 = rowp(r0 + 1 < M ? r0 + 1 : M - 1);
        const bf16* ar2 = rowp(r0 + 2 < M ? r0 + 2 : M - 1); const bf16* ar3 = rowp(r0 + 3 < M ? r0 + 3 : M - 1);
        const bf16* br0 = ar0; const bf16* br1 = ar1; const bf16* br2 = ar2; const bf16* br3 = ar3;
        if (DUAL) { br0 = rowp2(r0 + 0 < M ? r0 + 0 : M - 1); br1 = rowp2(r0 + 1 < M ? r0 + 1 : M - 1); br2 = rowp2(r0 + 2 < M ? r0 + 2 : M - 1); br3 = rowp2(r0 + 3 < M ? r0 + 3 : M - 1); }
        for (int k = 0; k < K; k += 8) {
            u32x4 av[4], aw[4];
            av[0] = *(const u32x4*)(ar0 + k); av[1] = *(const u32x4*)(ar1 + k); av[2] = *(const u32x4*)(ar2 + k); av[3] = *(const u32x4*)(ar3 + k);
            if (DUAL) { aw[0] = *(const u32x4*)(br0 + k); aw[1] = *(const u32x4*)(br1 + k); aw[2] = *(const u32x4*)(br2 + k); aw[3] = *(const u32x4*)(br3 + k); }
#pragma unroll
            for (int kk = 0; kk < 8; ++kk) {
                const f32x4 bv = *(const f32x4*)(Bw + (size_t)(k + kk) * ldb + c0);
                f32x4 bw = bv; if (DUAL) bw = *(const f32x4*)(Bw2 + (size_t)(k + kk) * ldb + c0);
#pragma unroll
                for (int i = 0; i < 4; ++i) {
                    const unsigned w = av[i][kk >> 1]; const float a = (kk & 1) ? bf2f(w >> 16) : bf2f(w & 0xffffu);
                    acc[i][0] += a * bv[0]; acc[i][1] += a * bv[1]; acc[i][2] += a * bv[2]; acc[i][3] += a * bv[3];
                    if (DUAL) { const unsigned w2 = aw[i][kk >> 1]; const float a2 = (kk & 1) ? bf2f(w2 >> 16) : bf2f(w2 & 0xffffu);
                        acc2[i][0] += a2 * bw[0]; acc2[i][1] += a2 * bw[1]; acc2[i][2] += a2 * bw[2]; acc2[i][3] += a2 * bw[3]; }
                }
            }
        }
#pragma unroll
        for (int i = 0; i < 4; ++i) if (r0 + i < M) {
#pragma unroll
            for (int j = 0; j < 4; ++j) epi(r0 + i, c0 + j, acc[i][j], acc2[i][j]);
        }
    }
}


__device__ __forceinline__ void ph_mod(const Frame& F) {
    LAS float* cond = (LAS float*)F.lds;
    for (int i = F.tid; i < BATCH * D; i += NTHREADS) cond[i] = siluf_(F.in(I_C)[i]);
    __syncthreads();
    float* mod = (float*)(F.ws() + WS_MOD);
    for (int idx = F.bid * NTHREADS + F.tid; idx < DEPTH * 6 * D; idx += F.G * NTHREADS) {
        const int l = idx / (6 * D), j = idx % (6 * D);
        float acc[BATCH];
        const float bb = F.in(I_BADA)[l * 6 * D + j];
#pragma unroll
        for (int b = 0; b < BATCH; ++b) acc[b] = bb;
        const float* w = F.in(I_WADA) + (size_t)l * D * 6 * D + j;
        for (int k = 0; k < D; ++k) { const float wv = w[(size_t)k * 6 * D];
#pragma unroll
            for (int b = 0; b < BATCH; ++b) acc[b] += cond[b * D + k] * wv; }
#pragma unroll
        for (int b = 0; b < BATCH; ++b) mod[(size_t)(l * BATCH + b) * 6 * D + j] = acc[b];
    }
    __syncthreads();
}

template <bool ROUTE, bool COMBINE>
__device__ __forceinline__ void ph_norm(const Frame& F, int l, const float* xin, const float* gain, int ch_sh, int ch_sc) {
    bf16* H = (bf16*)(F.ws() + WS_H);
    const bf16* Y0 = (const bf16*)(F.ws() + WS_Y0); const bf16* Y1 = (const bf16*)(F.ws() + WS_Y1); float* xo = F.out();
    const int gw = F.bid * NWAVES + F.wave, NGW = F.G * NWAVES;
    for (int m = gw; m < T; m += NGW) {
        const int b = m / SEQ;
        const f32x4* xr = (const f32x4*)(xin + (size_t)m * D) + F.lane;
        f32x4 v[4]; float s = 0.f;
#pragma unroll
        for (int j = 0; j < 4; ++j) { v[j] = xr[64 * j];
            if (COMBINE) { const int col = 4 * F.lane + 256 * j; const f32x4 g2 = *(const f32x4*)(mod_ptr(F, l - 1, b, 5) + col);
                const unsigned long long a = *(const unsigned long long*)(Y0 + (size_t)m * D + col), c = *(const unsigned long long*)(Y1 + (size_t)m * D + col);
                v[j].x += g2.x * (bf2f((unsigned)a & 0xffffu) + bf2f((unsigned)c & 0xffffu)); v[j].y += g2.y * (bf2f(((unsigned)a) >> 16) + bf2f(((unsigned)c) >> 16));
                v[j].z += g2.z * (bf2f((unsigned)(a >> 32) & 0xffffu) + bf2f((unsigned)(c >> 32) & 0xffffu)); v[j].w += g2.w * (bf2f((unsigned)(a >> 48)) + bf2f((unsigned)(c >> 48)));
                *(f32x4*)(xo + (size_t)m * D + col) = v[j]; }
            s += (v[j].x * v[j].x + v[j].y * v[j].y) + (v[j].z * v[j].z + v[j].w * v[j].w); }
        const float rstd = 1.0f / sqrtf(wave_sum(s, F.lane) * (1.f / D) + EPS);
        const float* sh = mod_ptr(F, l, b, ch_sh); const float* sc = mod_ptr(F, l, b, ch_sc);
        float lg[NE];
#pragma unroll
        for (int e = 0; e < NE; ++e) lg[e] = 0.f;
#pragma unroll
        for (int j = 0; j < 4; ++j) {
            const int col = 4 * F.lane + 256 * j;
            const f32x4 g = *(const f32x4*)(gain + col), s4 = *(const f32x4*)(sc + col), h4 = *(const f32x4*)(sh + col);
            f32x4 y;
#pragma unroll
            for (int q = 0; q < 4; ++q) y[q] = (v[j][q] * rstd * g[q]) * (1.f + s4[q]) + h4[q];
            unsigned long long o = (unsigned long long)(f2bf(y[0]) | (f2bf(y[1]) << 16)) | ((unsigned long long)(f2bf(y[2]) | (f2bf(y[3]) << 16)) << 32);
            *((unsigned long long*)(H + (size_t)m * D + col)) = o;
            if (ROUTE) {
#pragma unroll
                for (int q = 0; q < 4; ++q) {
                    const f32x4* wr = (const f32x4*)(F.in(I_WR) + (size_t)(col + q) * NE);
#pragma unroll
                    for (int e4 = 0; e4 < 4; ++e4) { const f32x4 w = wr[e4]; lg[e4 * 4 + 0] += y[q] * w[0]; lg[e4 * 4 + 1] += y[q] * w[1]; lg[e4 * 4 + 2] += y[q] * w[2]; lg[e4 * 4 + 3] += y[q] * w[3]; }
                }
            }
        }
        if (ROUTE) {
            float aff[NE], sel[NE];
#pragma unroll
            for (int e = 0; e < NE; ++e) { lg[e] = wave_sum(lg[e], F.lane); aff[e] = sigmoidf_(lg[e]); sel[e] = aff[e] + F.in(I_BR)[e]; }
            float best = 0.f; int bg = 0; float s0 = 0.f, s1 = 0.f, s2 = 0.f, s3 = 0.f, a0 = 0.f, a1 = 0.f, a2 = 0.f, a3 = 0.f;
#pragma unroll
            for (int g = 0; g < 4; ++g) {
                const float x0 = sel[4 * g], x1 = sel[4 * g + 1], x2 = sel[4 * g + 2], x3 = sel[4 * g + 3];
                const float mx = fmaxf(fmaxf(x0, x1), fmaxf(x2, x3));
                const float lo01 = fminf(x0, x1), hi01 = fmaxf(x0, x1), lo23 = fminf(x2, x3), hi23 = fmaxf(x2, x3);
                const float second = fmaxf(fminf(hi01, hi23), fmaxf(lo01, lo23));
                const float sc_ = mx + second;
                if (g == 0 || sc_ > best) { best = sc_; bg = g; s0 = x0; s1 = x1; s2 = x2; s3 = x3; a0 = aff[4 * g]; a1 = aff[4 * g + 1]; a2 = aff[4 * g + 2]; a3 = aff[4 * g + 3]; }
            }
            int i1 = 0; float m1 = s0; if (s1 > m1) { m1 = s1; i1 = 1; } if (s2 > m1) { m1 = s2; i1 = 2; } if (s3 > m1) { m1 = s3; i1 = 3; }
            int i2 = -1; float m2 = 0.f;
            if (i1 != 0) { m2 = s0; i2 = 0; }
            if (i1 != 1 && (i2 < 0 || s1 > m2)) { m2 = s1; i2 = 1; }
            if (i1 != 2 && (i2 < 0 || s2 > m2)) { m2 = s2; i2 = 2; }
            if (i1 != 3 && (i2 < 0 || s3 > m2)) { m2 = s3; i2 = 3; }
            const float w1 = i1 == 0 ? a0 : i1 == 1 ? a1 : i1 == 2 ? a2 : a3;
            const float w2 = i2 == 0 ? a0 : i2 == 1 ? a1 : i2 == 2 ? a2 : a3;
            const float inv = 1.f / (w1 + w2);
            if (F.lane == 0) {
                unsigned* cnt = (unsigned*)(F.ws() + WS_CTL) + CW_CNT + 64 * (NE * l);
                int* tokl = (int*)(F.ws() + WS_TOKL); float* wl = (float*)(F.ws() + WS_WL);
                const int e1 = bg * 4 + i1, e2 = bg * 4 + i2;
                const unsigned p1 = atomicAdd(&cnt[64 * e1], 1u); tokl[(size_t)e1 * ECAP + p1] = 2 * m; wl[(size_t)e1 * ECAP + p1] = w1 * inv;
                const unsigned p2 = atomicAdd(&cnt[64 * e2], 1u); tokl[(size_t)e2 * ECAP + p2] = 2 * m + 1; wl[(size_t)e2 * ECAP + p2] = w2 * inv;
            }
        }
    }
}

__device__ __forceinline__ void ph_gemm1(const Frame& F, int l) {
    const bf16* H = (const bf16*)(F.ws() + WS_H);
    bf16* GQ = (bf16*)(F.ws() + WS_GQ); bf16* GK = (bf16*)(F.ws() + WS_GK); bf16* GV = (bf16*)(F.ws() + WS_GV); float* GA = (float*)(F.ws() + WS_GA);
    bf16* GR = (bf16*)(F.ws() + WS_GR); bf16* SQ = (bf16*)(F.ws() + WS_SQ); bf16* SK = (bf16*)(F.ws() + WS_SK); bf16* SV = (bf16*)(F.ws() + WS_SV);
    bf16* MA = (bf16*)(F.ws() + WS_MA); bf16* MB = (bf16*)(F.ws() + WS_MB);
    auto rowp = [=](int m) { return H + (size_t)m * D; };
    auto epi = [=](int m, int n, float v, float) {
        if (n < C_GK) GQ[(size_t)m * 256 + n] = (bf16)f2bf(v * 0.125f);
        else if (n < C_GV) GK[(size_t)m * 256 + (n - C_GK)] = (bf16)f2bf(v);
        else if (n < C_GA) GV[(size_t)m * 512 + (n - C_GV)] = (bf16)f2bf(v);
        else if (n < C_GR) GA[(size_t)m * 16 + (n - C_GA)] = v;
        else if (n < C_SQ) GR[(size_t)m * 512 + (n - C_GR)] = (bf16)f2bf(siluf_(v));
        else if (n < C_SK) SQ[(size_t)m * 512 + (n - C_SQ)] = (bf16)f2bf(v);
        else if (n < C_SV) SK[(size_t)m * 128 + (n - C_SK)] = (bf16)f2bf(v);
        else if (n < C_MA) SV[(size_t)m * 128 + (n - C_SV)] = (bf16)f2bf(v);
        else if (n < C_MB) MA[(size_t)m * 1024 + (n - C_MA)] = (bf16)f2bf(sigmoidf_(v));
        else MB[(size_t)m * 1024 + (n - C_MB)] = (bf16)f2bf(sigmoidf_(v));
    };
    naive_gemm<false>(F, T, INW, D, rowp, rowp, F.in(I_WIN) + (size_t)l * D * INW, nullptr, INW, epi);
}

__device__ __forceinline__ void ph_headnorm(const Frame& F, int l) {
    const int NT = F.G * NTHREADS, gt = F.bid * NTHREADS + F.tid;
    const float* GA = (const float*)(F.ws() + WS_GA); float* GB = (float*)(F.ws() + WS_GB);
    const float* wa2 = F.in(I_WA2) + (size_t)l * GRANK * 256; const float* ba = F.in(I_BA) + l * 256;
    for (int item = gt; item < BATCH * NCH * GH * GDK; item += NT) {
        const int d = item & 63, ch = item >> 6, h = ch & 3, bn = ch >> 2;
        const int t0 = bn * GCH, col = h * 64 + d;
        float w[GRANK];
#pragma unroll
        for (int r = 0; r < GRANK; ++r) w[r] = wa2[r * 256 + col];
        const float bias = ba[col];
        float cum = 0.f;
        for (int i = 0; i < GCH; ++i) {
            const f32x4* a = (const f32x4*)(GA + (size_t)(t0 + i) * 16);
            float u = bias;
#pragma unroll
            for (int r4 = 0; r4 < 4; ++r4) { const f32x4 av = a[r4]; u += av[0] * w[r4 * 4] + av[1] * w[r4 * 4 + 1] + av[2] * w[r4 * 4 + 2] + av[3] * w[r4 * 4 + 3]; }
            const float ls = fminf(u, 0.f) - log1pf(__expf(-fabsf(u)));
            cum += ls * (1.f / 16.f);
            GB[(size_t)(t0 + i) * 256 + col] = cum;
        }
    }
}

__device__ __forceinline__ void ph_swa(const Frame& F, int l) {
    const bf16* SQ = (const bf16*)(F.ws() + WS_SQ); const bf16* SK = (const bf16*)(F.ws() + WS_SK); const bf16* SV = (const bf16*)(F.ws() + WS_SV);
    bf16* O = (bf16*)(F.ws() + WS_SWAO);
    const int NT = F.G * NTHREADS, gt = F.bid * NTHREADS + F.tid;
    for (int it = gt >> 2; it < T * SH; it += NT >> 2) {
        const int part = gt & 3, t = it >> 3, h = it & 7, kvh = h >> 2, sp = t % SEQ;
        float q[16], o[16];
        { const u32x4* qp = (const u32x4*)(SQ + (size_t)t * 512 + h * 64 + part * 16);
#pragma unroll
          for (int c = 0; c < 2; ++c) { const u32x4 w = qp[c];
#pragma unroll
              for (int x = 0; x < 4; ++x) { q[c * 8 + 2 * x] = bf2f(w[x] & 0xffffu); q[c * 8 + 2 * x + 1] = bf2f(w[x] >> 16); } } }
#pragma unroll
        for (int i = 0; i < 16; ++i) o[i] = 0.f;
        float mx = F.in(I_SINK)[l * SH + h], den = 1.f;
        const int j0 = sp - (WIN - 1) < 0 ? 0 : sp - (WIN - 1);
        for (int j = j0; j <= sp; ++j) {
            const size_t tk = (size_t)(t - sp + j);
            const u32x4* kp = (const u32x4*)(SK + tk * 128 + kvh * 64 + part * 16);
            const u32x4* vp = (const u32x4*)(SV + tk * 128 + kvh * 64 + part * 16);
            float s = 0.f;
#pragma unroll
            for (int c = 0; c < 2; ++c) { const u32x4 w = kp[c];
#pragma unroll
                for (int x = 0; x < 4; ++x) s += q[c * 8 + 2 * x] * bf2f(w[x] & 0xffffu) + q[c * 8 + 2 * x + 1] * bf2f(w[x] >> 16); }
            s += shx(s, 1, F.lane); s += shx(s, 2, F.lane);
            const float mn = fmaxf(mx, s), scl = __expf(mx - mn), p = __expf(s - mn);
            den = den * scl + p; mx = mn;
#pragma unroll
            for (int c = 0; c < 2; ++c) { const u32x4 w = vp[c];
#pragma unroll
                for (int x = 0; x < 4; ++x) { o[c * 8 + 2 * x] = o[c * 8 + 2 * x] * scl + p * bf2f(w[x] & 0xffffu); o[c * 8 + 2 * x + 1] = o[c * 8 + 2 * x + 1] * scl + p * bf2f(w[x] >> 16); } }
        }
        const float inv = 1.f / den;
        u32x4* op = (u32x4*)(O + (size_t)t * 512 + h * 64 + part * 16);
#pragma unroll
        for (int c = 0; c < 2; ++c) { u32x4 w;
#pragma unroll
            for (int x = 0; x < 4; ++x) w[x] = f2bf(o[c * 8 + 2 * x] * inv) | (f2bf(o[c * 8 + 2 * x + 1] * inv) << 16);
            op[c] = w; }
    }
}

__device__ __forceinline__ void ph_gla_kv(const Frame& F) {
    const bf16* GK = (const bf16*)(F.ws() + WS_GK); const bf16* GV = (const bf16*)(F.ws() + WS_GV); const float* GB = (const float*)(F.ws() + WS_GB);
    float* ST = (float*)(F.ws() + WS_STATE); float* DEC = (float*)(F.ws() + WS_DECAY);
    const size_t NT = (size_t)F.G * NTHREADS, gt = (size_t)F.bid * NTHREADS + F.tid;
    for (size_t item = gt; item < (size_t)BATCH * NCH * GH * GDK * GDV; item += NT) {
        const int e = (int)(item & 127), d = (int)((item >> 7) & 63), ch = (int)(item >> 13), h = ch & 3, bn = ch >> 2, t0 = bn * GCH;
        const float bend = GB[(size_t)(t0 + GCH - 1) * 256 + h * 64 + d];
        float acc = 0.f;
        for (int j = 0; j < GCH; ++j) {
            const float kk = bf2f(GK[(size_t)(t0 + j) * 256 + h * 64 + d]) * __expf(bend - GB[(size_t)(t0 + j) * 256 + h * 64 + d]);
            acc += kk * bf2f(GV[(size_t)(t0 + j) * 512 + h * 128 + e]);
        }
        ST[item] = acc;
        if (e == 0) DEC[ch * 64 + d] = __expf(bend);
    }
}
__device__ __forceinline__ void ph_gla_scan(const Frame& F) {
    float* ST = (float*)(F.ws() + WS_STATE); const float* DEC = (const float*)(F.ws() + WS_DECAY);
    const int NT = F.G * NTHREADS, gt = F.bid * NTHREADS + F.tid;
    for (int item = gt; item < BATCH * GH * GDK * GDV; item += NT) {
        const int e = item & 127, d = (item >> 7) & 63, h = (item >> 13) & 3, b = item >> 15;
        float S = 0.f;
        for (int n = 0; n < NCH; ++n) {
            const int ch = (b * NCH + n) * 4 + h; const size_t idx = ((size_t)ch * 64 + d) * 128 + e;
            const float kv = ST[idx]; ST[idx] = S; S = DEC[ch * 64 + d] * S + kv;
        }
    }
}
__device__ __forceinline__ void ph_gla_out(const Frame& F, int l) {
    const bf16* GQ = (const bf16*)(F.ws() + WS_GQ); const bf16* GK = (const bf16*)(F.ws() + WS_GK); const bf16* GV = (const bf16*)(F.ws() + WS_GV); const bf16* GR = (const bf16*)(F.ws() + WS_GR);
    const float* GB = (const float*)(F.ws() + WS_GB); const float* ST = (const float*)(F.ws() + WS_STATE);
    bf16* O = (bf16*)(F.ws() + WS_GLAO);
    LAS float* qd = (LAS float*)F.lds; LAS float* ki = qd + 64 * 65; LAS float* att = ki + 64 * 65; LAS float* ob = att + 64 * 65;
    const float* gn = F.in(I_GNORM) + l * 512;
    for (int ch = F.bid; ch < BATCH * NCH * GH; ch += F.G) {
        const int h = ch & 3, bn = ch >> 2, t0 = bn * GCH;
        for (int x = F.tid; x < 4096; x += NTHREADS) { const int i = x >> 6, d = x & 63; const float bb = GB[(size_t)(t0 + i) * 256 + h * 64 + d];
            qd[i * 65 + d] = bf2f(GQ[(size_t)(t0 + i) * 256 + h * 64 + d]) * __expf(bb); ki[i * 65 + d] = bf2f(GK[(size_t)(t0 + i) * 256 + h * 64 + d]) * __expf(-bb); }
        __syncthreads();
        for (int x = F.tid; x < 4096; x += NTHREADS) { const int i = x >> 6, j = x & 63; float a = 0.f;
            if (j <= i) { for (int d = 0; d < 64; ++d) a += qd[i * 65 + d] * ki[j * 65 + d]; }
            att[i * 65 + j] = a; }
        __syncthreads();
        { const int e = F.tid & 127, ig = F.tid >> 7;
          for (int ii = 0; ii < 16; ++ii) { const int i = ig * 16 + ii; float acc = 0.f;
              for (int j = 0; j <= i; ++j) acc += att[i * 65 + j] * bf2f(GV[(size_t)(t0 + j) * 512 + h * 128 + e]);
              for (int d = 0; d < 64; ++d) acc += qd[i * 65 + d] * ST[((size_t)ch * 64 + d) * 128 + e];
              ob[i * 129 + e] = acc; } }
        __syncthreads();
        for (int r = 0; r < 8; ++r) { const int i = F.wave * 8 + r; const float v0 = ob[i * 129 + F.lane], v1 = ob[i * 129 + 64 + F.lane];
            const float rstd = 1.0f / sqrtf(wave_sum(v0 * v0 + v1 * v1, F.lane) * (1.f / 128.f) + EPS);
            const size_t t = (size_t)(t0 + i);
            O[t * 512 + h * 128 + F.lane] = (bf16)f2bf(v0 * rstd * gn[h * 128 + F.lane] * bf2f(GR[t * 512 + h * 128 + F.lane]));
            O[t * 512 + h * 128 + 64 + F.lane] = (bf16)f2bf(v1 * rstd * gn[h * 128 + 64 + F.lane] * bf2f(GR[t * 512 + h * 128 + 64 + F.lane])); }
        __syncthreads();
    }
}
__device__ __forceinline__ void ph_gemm2(const Frame& F, int l) {
    const bf16* GO = (const bf16*)(F.ws() + WS_GLAO); const bf16* SO = (const bf16*)(F.ws() + WS_SWAO);
    const bf16* MA = (const bf16*)(F.ws() + WS_MA); const bf16* MB = (const bf16*)(F.ws() + WS_MB); bf16* MG = (bf16*)(F.ws() + WS_MERGED);
    auto rowp = [=](int m) { return GO + (size_t)m * 512; }; auto rowp2 = [=](int m) { return SO + (size_t)m * 512; };
    auto epi = [=](int m, int n, float a, float b) { MG[(size_t)m * D + n] = (bf16)f2bf(bf2f(MA[(size_t)m * D + n]) * a + bf2f(MB[(size_t)m * D + n]) * b); };
    naive_gemm<true>(F, T, D, 512, rowp, rowp2, F.in(I_WUG) + (size_t)l * 512 * D, F.in(I_WUS) + (size_t)l * 512 * D, D, epi);
}
__device__ __forceinline__ void ph_gemm3(const Frame& F, int l, const float* xin) {
    const bf16* MG = (const bf16*)(F.ws() + WS_MERGED); float* out = F.out(); const float* modl = (const float*)(F.ws() + WS_MOD) + (size_t)l * BATCH * 6 * D;
    auto rowp = [=](int m) { return MG + (size_t)m * D; };
    auto epi = [=](int m, int n, float a, float) { const int b = m / SEQ; out[(size_t)m * D + n] = xin[(size_t)m * D + n] + modl[((size_t)b * 6 + 2) * D + n] * a; };
    naive_gemm<false>(F, T, D, D, rowp, rowp, F.in(I_WOUT) + (size_t)l * D * D, nullptr, D, epi);
}
__device__ __forceinline__ void ph_moe_up(const Frame& F, int l) {
    const bf16* H = (const bf16*)(F.ws() + WS_H); bf16* ACT = (bf16*)(F.ws() + WS_ACT);
    const unsigned* cnt = (const unsigned*)(F.ws() + WS_CTL) + CW_CNT + 64 * (NE * l); const int* tokl = (const int*)(F.ws() + WS_TOKL);
    int seg = 0;
    for (int e = 0; e < NE; ++e) {
        const int ce = (int)cnt[64 * e]; const int* tl = tokl + (size_t)e * ECAP; bf16* act = ACT + (size_t)seg * DFF;
        auto rowp = [=](int m) { return H + (size_t)tl[m] * D; };
        auto epi = [=](int m, int n, float a, float b) { act[(size_t)m * DFF + n] = (bf16)f2bf(siluf_(a) * b); };
        naive_gemm<true>(F, ce, DFF, D, rowp, rowp, F.in(I_WGATE) + ((size_t)l * NE + e) * D * DFF, F.in(I_WUP) + ((size_t)l * NE + e) * D * DFF, DFF, epi);
        seg += (ce + 255) / 256 * 256;
    }
}
__device__ __forceinline__ void ph_moe_down(const Frame& F, int l) {
    const bf16* ACT = (const bf16*)(F.ws() + WS_ACT); float* out = F.out(); const float* modl = (const float*)(F.ws() + WS_MOD) + (size_t)l * BATCH * 6 * D;
    const unsigned* cnt = (const unsigned*)(F.ws() + WS_CTL) + CW_CNT + 64 * (NE * l); const int* tokl = (const int*)(F.ws() + WS_TOKL); const float* wl = (const float*)(F.ws() + WS_WL);
    int seg = 0;
    for (int e = 0; e < NE; ++e) {
        const int ce = (int)cnt[64 * e]; const int* tl = tokl + (size_t)e * ECAP; const float* wle = wl + (size_t)e * ECAP; const bf16* act = ACT + (size_t)seg * DFF;
        auto rowp = [=](int m) { return act + (size_t)m * DFF; };
        auto epi = [=](int m, int n, float a, float) { const int tok = tl[m]; const int b = tok / SEQ; unsafeAtomicAdd(&out[(size_t)tok * D + n], modl[((size_t)b * 6 + 5) * D + n] * wle[m] * a); };
        naive_gemm<false>(F, ce, D, DFF, rowp, rowp, F.in(I_WDOWN) + ((size_t)l * NE + e) * DFF * D, nullptr, D, epi);
        seg += (ce + 255) / 256 * 256;
    }
}

constexpr int NPH_LAYER = 9, NPHASES = 2 + DEPTH * NPH_LAYER;
__global__ void __launch_bounds__(NTHREADS, 2) fwd(Args args) {
    extern __shared__ __attribute__((aligned(16))) unsigned char lds[];
    Frame F;
    F.lds = (LAS unsigned char*)lds; F.tid = threadIdx.x; F.lane = F.tid & 63; F.wave = __builtin_amdgcn_readfirstlane(F.tid >> 6);
    F.G = gridDim.x; F.bid = blockIdx.x;
    volatile LAS unsigned* MISC = (volatile LAS unsigned*)(F.lds + MISC_OFF);
    if (F.tid < 32) MISC[F.tid] = 0u;
    if (F.tid == 0) { volatile LAS unsigned long long* tb = (volatile LAS unsigned long long*)(F.lds + PTR_OFF);
#pragma unroll
        for (int i = 0; i < 22; ++i) tb[i] = (unsigned long long)args.in[i];
        tb[22] = (unsigned long long)args.out; tb[23] = (unsigned long long)args.ws; }
    __syncthreads();
    XcdBarrier bar; bar.bar = (unsigned*)(F.ws() + WS_CTL) + CW_BAR; bar.x = 0; bar.st = nullptr;
#if !MK_PER_PHASE
    bar = xcd_barrier_post((unsigned*)(F.ws() + WS_CTL) + CW_BAR, MISC + 8);
#endif
    const int lo = args.ph_lo, hi = args.ph_hi;
#define IN(k) (lo <= (k) && (k) < hi)
#define SEAM(k) do { if (IN(k) && IN((k) + 1)) xcd_barrier(bar); } while (0)
    if (IN(0)) { ph_mod(phase_frame(F)); ph_weights(phase_frame(F)); ph_rope_table(phase_frame(F)); } SEAM(0);
    for (int l = 0; l < DEPTH; ++l) {
        const int p0 = 1 + l * NPH_LAYER;
        const float* xin = l == 0 ? F.in(I_X) : F.out();
        if (IN(p0 + 0)) { if (l == 0) ph_norm<false, false>(phase_frame(F), l, xin, F.in(I_NMIX) + l * D, 0, 1); else ph_norm<false, true>(phase_frame(F), l, xin, F.in(I_NMIX) + l * D, 0, 1); } SEAM(p0 + 0);
        if (IN(p0 + 1)) ph_gemm1_mfma(phase_frame(F), l); SEAM(p0 + 1);
        if (IN(p0 + 2)) { ph_gla_mfma<false>(phase_frame(F), l); ph_swa_mfma(phase_frame(F), l); } SEAM(p0 + 2);
        if (IN(p0 + 3)) ph_gla_mfma<true>(phase_frame(F), l); SEAM(p0 + 3);
        if (IN(p0 + 4)) ph_gemm2_mfma(phase_frame(F), l); SEAM(p0 + 4);
        if (IN(p0 + 5)) ph_gemm3_mfma(phase_frame(F), l, xin); SEAM(p0 + 5);
        if (IN(p0 + 6)) ph_norm<true, false>(phase_frame(F), l, F.out(), F.in(I_NFFN) + l * D, 3, 4); SEAM(p0 + 6);
        if (IN(p0 + 7)) ph_moe_up_mfma(phase_frame(F), l); SEAM(p0 + 7);
        if (IN(p0 + 8)) ph_moe_down_mfma(phase_frame(F), l); SEAM(p0 + 8);
    }
    if (IN(NPHASES - 1)) ph_final(phase_frame(F));
#undef IN
#undef SEAM
}

extern "C" void kernel_launch(void* const* d_in, const int* in_sizes, int n_in, void* d_out, int out_size, void* d_ws, size_t ws_size, hipStream_t stream) {
    static int grid = 0;
    if (grid == 0) {
        if (n_in != 22 || in_sizes[0] != T * D || out_size != T * D || ws_size < WS_END) { fprintf(stderr, "kernel_launch: unexpected shapes: n_in %d in0 %d out %d ws %zu (need %zu)\n", n_in, n_in > 0 ? in_sizes[0] : -1, out_size, ws_size, (size_t)WS_END); grid = -1; return; }
        int dev = 0, cus = 0, per_cu = 0;
        if (hipGetDevice(&dev) != hipSuccess || hipDeviceGetAttribute(&cus, hipDeviceAttributeMultiprocessorCount, dev) != hipSuccess) { grid = -1; return; }
        if (hipFuncSetAttribute((const void*)fwd, hipFuncAttributeMaxDynamicSharedMemorySize, LDS_BYTES) != hipSuccess) { fprintf(stderr, "kernel_launch: hipFuncSetAttribute failed\n"); grid = -1; return; }
        if (hipOccupancyMaxActiveBlocksPerMultiprocessor(&per_cu, (const void*)fwd, NTHREADS, LDS_BYTES) != hipSuccess || per_cu < 1) fprintf(stderr, "kernel_launch: occupancy query reports %d\n", per_cu);
        (void)hipGetLastError();
        grid = cus;
    }
    if (grid < 0) return;
    if (hipMemsetAsync((char*)d_ws + WS_CTL, 0, CTL_ZERO_BYTES, stream) != hipSuccess) return;
    Args a{};
    for (int i = 0; i < 22; ++i) a.in[i] = (const float*)d_in[i];
    a.out = (float*)d_out; a.ws = (unsigned char*)d_ws;
#if MK_PER_PHASE
    for (int p = 0; p < NPHASES; ++p) { a.ph_lo = p; a.ph_hi = p + 1; hipLaunchKernelGGL(fwd, dim3(grid), dim3(NTHREADS), LDS_BYTES, stream, a); }
#else
    a.ph_lo = 0; a.ph_hi = NPHASES; hipLaunchKernelGGL(fwd, dim3(grid), dim3(NTHREADS), LDS_BYTES, stream, a);
#endif
}
```

```cpp
#include <hip/hip_runtime.h>
#include <cstdio>
#include <cstdint>

#ifndef MK_REPEAT
#define MK_REPEAT 0u
#endif
#ifndef MK_PER_PHASE
#define MK_PER_PHASE 0
#endif

constexpr int D = 1024, BATCH = 8, SEQ = 8192, T = BATCH * SEQ, DEPTH = 2;
constexpr int GH = 4, GDK = 64, GDV = 128, GRANK = 16, GCH = 64, NCH = SEQ / GCH;
constexpr int SH = 8, SKV = 2, SHD = 64, WIN = 128;
constexpr int NE = 16, DFF = 512, ECAP = T;
constexpr int INW = 4368, NIN = 4608;
constexpr int C_GQ = 0, C_GK = 256, C_GV = 512, C_GA = 1024, C_GR = 1040, C_SQ = 1552, C_SK = 2064, C_SV = 2192, C_MA = 2320, C_MB = 3344;
constexpr float EPS = 1e-6f;
constexpr int NTHREADS = 512, NWAVES = 8;

constexpr size_t MiB = 1u << 20;
constexpr size_t WS_CTL = 0, CTL_ZERO_BYTES = 2 * MiB;
constexpr size_t WS_MOD = 1 * MiB;
constexpr size_t WS_TOKL = 2 * MiB;
constexpr size_t WS_WL = 6 * MiB;
constexpr size_t WS_GA = 10 * MiB;
constexpr size_t WS_DECAY = 14 * MiB;
constexpr size_t WS_WIN_T = 16 * MiB;
constexpr size_t WS_WG_T = 34 * MiB, WS_WS_T = 36 * MiB;
constexpr size_t WS_WOUT_T = 38 * MiB;
constexpr size_t WS_WGU_T = 42 * MiB;
constexpr size_t WS_WD_T = 106 * MiB;
constexpr size_t WS_H = 138 * MiB;
constexpr size_t WS_STATE = WS_H;
constexpr size_t WS_GQ = 266 * MiB, WS_GK = 298 * MiB, WS_GV = 330 * MiB;
constexpr size_t WS_MERGED = WS_GQ;
constexpr size_t WS_GR = 394 * MiB;
constexpr size_t WS_SQ = 458 * MiB;
constexpr size_t WS_SK = 522 * MiB, WS_SV = 538 * MiB;
constexpr size_t WS_MA = 554 * MiB, WS_MB = 682 * MiB;
constexpr size_t WS_ACT = WS_MA;
constexpr size_t WS_GLAO = 810 * MiB, WS_SWAO = 874 * MiB;
constexpr size_t WS_Y0 = 266 * MiB, WS_Y1 = 394 * MiB;
constexpr size_t WS_GB = 938 * MiB;
constexpr size_t WS_ROPE = 1002 * MiB;
constexpr size_t WS_END = 1006 * MiB;

constexpr int CW_BAR = 4096;
constexpr int CW_CNT = 16384;

#define GAS __attribute__((address_space(1)))
#define LAS __attribute__((address_space(3)))
typedef unsigned short bf16;
typedef float f32x4 __attribute__((ext_vector_type(4)));
typedef unsigned u32x4 __attribute__((ext_vector_type(4)));

__device__ __forceinline__ unsigned f2bf(float f) { unsigned u = __builtin_bit_cast(unsigned, f); return (u + 0x7fffu + ((u >> 16) & 1u)) >> 16; }
__device__ __forceinline__ float bf2f(unsigned h) { return __builtin_bit_cast(float, h << 16); }
__device__ __forceinline__ float sigmoidf_(float v) { return 1.f / (1.f + __expf(-v)); }
__device__ __forceinline__ float siluf_(float v) { return v / (1.f + __expf(-v)); }
__device__ __forceinline__ float shx(float v, int o, int lane) { return __builtin_bit_cast(float, __builtin_amdgcn_ds_bpermute((lane ^ o) << 2, __builtin_bit_cast(int, v))); }
__device__ __forceinline__ float wave_sum(float v, int lane) {
#pragma unroll
    for (int o = 1; o < 64; o <<= 1) v += shx(v, o, lane);
    return v;
}

#define XB_TMO      128
#define XB_XCNT(j)  (256  + 64 * (j))
#define XB_XSUB(j)  (1280 + 64 * (j))
#define XB_XGEN(j)  (2304 + 64 * (j))
#define XB_TOP      3328
#define XB_TOPGEN   3392
#define XCD_BAR_WORDS 3456
#define XB_SPIN_CAP (1u << 24)
__device__ __forceinline__ unsigned xb_ld(unsigned* p)              { return __hip_atomic_load(p, __ATOMIC_RELAXED, __HIP_MEMORY_SCOPE_AGENT); }
__device__ __forceinline__ unsigned xb_add(unsigned* p, unsigned v) { return __hip_atomic_fetch_add(p, v, __ATOMIC_RELAXED, __HIP_MEMORY_SCOPE_AGENT); }
__device__ __forceinline__ unsigned xb_xcc_id() { return (unsigned)__builtin_amdgcn_s_getreg((3 << 11) | 20) & 0xFu; }
#define XB_SPIN(cond, bar) do { unsigned _sp = 0; while (cond) { __builtin_amdgcn_s_sleep(1); \
    if ((++_sp & 255u) == 0u) { if (xb_ld(&(bar)[XB_TMO])) break; if (_sp > XB_SPIN_CAP) { atomicAdd(&(bar)[XB_TMO], 1u); break; } } } } while (0)
struct XcdBarrier { unsigned* bar; unsigned x; volatile LAS unsigned* st; };
__device__ __forceinline__ XcdBarrier xcd_barrier_post(unsigned* bar, volatile LAS unsigned* st) {
    XcdBarrier b; b.bar = bar; b.x = xb_xcc_id(); b.st = st;
    if (threadIdx.x == 0) (void)xb_add(&bar[XB_XCNT(b.x)], 1u);
    return b;
}
__device__ __forceinline__ void xcd_barrier_complete(unsigned* bar, unsigned x, unsigned& nloc, unsigned& nx) {
    const unsigned G = gridDim.x * gridDim.y * gridDim.z;
    unsigned sum, cnt, mine, sp = 0u;
    for (;;) {
        sum = 0u; cnt = 0u; mine = 0u;
#pragma unroll
        for (unsigned j = 0; j < 16; ++j) { const unsigned c = xb_ld(&bar[XB_XCNT(j)]); sum += c; cnt += (c > 0u) ? 1u : 0u; mine = (j == x) ? c : mine; }
        if (sum == G) break;
        __builtin_amdgcn_s_sleep(1);
        if ((++sp & 255u) == 0u) { if (xb_ld(&bar[XB_TMO])) break; if (sp > XB_SPIN_CAP) { atomicAdd(&bar[XB_TMO], 1u); break; } }
    }
    nloc = mine > 0u ? mine : 1u; nx = cnt > 0u ? cnt : 1u;
}
__device__ __forceinline__ void xcd_barrier(const XcdBarrier& b) {
    asm volatile("s_waitcnt vmcnt(0)" ::: "memory");
    __syncthreads();
    if (threadIdx.x == 0) {
        unsigned* bar = b.bar;
        __builtin_amdgcn_s_waitcnt(0);
        unsigned nloc = b.st[0], nx = b.st[1];
        if (nloc == 0u) { xcd_barrier_complete(bar, b.x, nloc, nx); b.st[0] = nloc; b.st[1] = nx; }
        const unsigned old = xb_add(&bar[XB_XSUB(b.x)], 1u);
        const unsigned gen = old / nloc;
        if (old + 1u == (gen + 1u) * nloc) {
            __builtin_amdgcn_fence(__ATOMIC_RELEASE, "agent");
            asm volatile("s_waitcnt vmcnt(0)" ::: "memory");
            const unsigned og = xb_add(&bar[XB_TOP], 1u);
            const unsigned tg = og / nx;
            if (og + 1u == (tg + 1u) * nx) xb_add(&bar[XB_TOPGEN], 1u);
            else XB_SPIN(xb_ld(&bar[XB_TOPGEN]) == tg, bar);
            __builtin_amdgcn_fence(__ATOMIC_ACQUIRE, "agent");
            xb_add(&bar[XB_XGEN(b.x)], 1u);
            asm volatile("s_waitcnt vmcnt(0)" ::: "memory");
        } else {
            XB_SPIN(xb_ld(&bar[XB_XGEN(b.x)]) == gen, bar);
            __builtin_amdgcn_fence(__ATOMIC_ACQUIRE, "agent");
            asm volatile("s_waitcnt vmcnt(0)" ::: "memory");
        }
    }
    __syncthreads();
}

constexpr int LDS_BYTES = 147456;
constexpr int MISC_OFF = 131072 + 320;

struct Args { const float* in[22]; float* out; unsigned char* ws; int ph_lo, ph_hi; };

constexpr int PTR_OFF = MISC_OFF + 128;
struct Frame {
    LAS unsigned char* lds;
    int tid, lane, wave, G, bid;
    __device__ __forceinline__ unsigned long long ptr(int i) const {
        const unsigned long long v = ((volatile LAS unsigned long long*)(lds + PTR_OFF))[i];
        const unsigned lo = __builtin_amdgcn_readfirstlane((unsigned)v), hi = __builtin_amdgcn_readfirstlane((unsigned)(v >> 32));
        return ((unsigned long long)hi << 32) | lo;
    }
    __device__ __forceinline__ const float* in(int i) const { return (const float*)ptr(i); }
    __device__ __forceinline__ float* out() const { return (float*)ptr(22); }
    __device__ __forceinline__ unsigned char* ws() const { return (unsigned char*)ptr(23); }
};
__device__ __forceinline__ Frame phase_frame(const Frame& F) {
    Frame P = F; unsigned l = (unsigned)(unsigned long long)P.lds;
    asm volatile("" : "+v"(P.tid), "+v"(P.lane), "+s"(P.wave), "+s"(P.G), "+s"(P.bid), "+s"(l));
    P.lds = (LAS unsigned char*)(unsigned long long)l; return P;
}
enum { I_X = 0, I_C, I_POS, I_WADA, I_BADA, I_NMIX, I_WIN, I_WA2, I_BA, I_GNORM, I_QN, I_KN, I_SINK, I_WUG, I_WUS, I_WOUT, I_NFFN, I_WR, I_BR, I_WGATE, I_WUP, I_WDOWN };

__device__ __forceinline__ const float* mod_ptr(const Frame& F, int l, int b, int chunk) { return (const float*)(F.ws() + WS_MOD) + ((size_t)(l * BATCH + b) * 6 + chunk) * D; }
namespace pg {
typedef short bf16x8 __attribute__((ext_vector_type(8)));
constexpr int BM = 256, BK = 64, HALF = 128, HTB = HALF * BK * 2, STAGE_BYTES = 8 * HTB;
__host__ __device__ __forceinline__ int lds_byte(int r, int c) { const int st = (r >> 4) * 2 + (c >> 5), rr = r & 15, cc = c & 31, ob = rr * 64 + cc * 2; return st * 1024 + (ob ^ (((ob >> 9) & 1) << 5)); }
__host__ __device__ __forceinline__ void stage_rc(int b, int& R, int& C) { const int st = b / 1024, sb = b % 1024, swz = sb ^ (((sb >> 9) & 1) << 5); R = (st >> 1) * 16 + swz / 64; C = (st & 1) * 32 + (swz % 64) / 2; }
__host__ __device__ __forceinline__ int perm32(int rho) { const int n = rho >> 4, i = rho & 15; return 8 * (i >> 2) + 4 * n + (i & 3); }
struct Unit { const char* A; const char* B; int pm, pn, e, j, valid, keep; };
__device__ __forceinline__ unsigned cvt_pk_bf16(float lo, float hi) { unsigned r; asm volatile("v_cvt_pk_bf16_f32 %0, %1, %2" : "=v"(r) : "v"(lo), "v"(hi)); return r; }

template <class Epi, class Sched>
__device__ __forceinline__ void gemm_phase(LAS unsigned char* lds, const int tid, const int K, const Sched& S, const Epi& E) {
    const int wid = __builtin_amdgcn_readfirstlane(tid >> 6), lane = tid & 63, wr = wid >> 2, wc = wid & 3, fr = lane & 15, fq = lane >> 4;
    const int nt = K / BK;
    int RA[2], CA[2]; unsigned voffB[2];
#pragma unroll
    for (int i = 0; i < 2; ++i) { int R, C; stage_rc(tid * 16 + i * 8192, R, C); const int Rb = (R & ~31) + perm32(R & 31); RA[i] = R; CA[i] = C * 2; voffB[i] = (unsigned)(Rb * K + C) * 2u; }
    const size_t kstep = (size_t)(BK * 2);
    const size_t hstep = (size_t)HALF * K * 2;
    const unsigned ldsw = (unsigned)wid * 1024u;
    const int aoff = lds_byte(wr * 64 + fr, fq * 8), boff = lds_byte(wc * 32 + fr, fq * 8);
#define PG_SA(b, h) (((b) * 2 + (h)) * HTB)
#define PG_SB(b, h) ((4 + (b) * 2 + (h)) * HTB)
#define PG_STAGEB(bufoff, gbase) do { _Pragma("unroll") for (int _i = 0; _i < 2; ++_i) \
        __builtin_amdgcn_global_load_lds((const unsigned*)((const char*)(gbase) + voffB[_i]), (LAS unsigned*)(lds + (bufoff) + ldsw + _i * 8192), 16, 0, 0); } while (0)
#define PG_STAGEA(bufoff, gbase, o0, o1) do { \
        __builtin_amdgcn_global_load_lds((const unsigned*)((const char*)(gbase) + (o0)), (LAS unsigned*)(lds + (bufoff) + ldsw), 16, 0, 0); \
        __builtin_amdgcn_global_load_lds((const unsigned*)((const char*)(gbase) + (o1)), (LAS unsigned*)(lds + (bufoff) + ldsw + 8192), 16, 0, 0); } while (0)
#define PG_LDA(dst, b, h) do { _Pragma("unroll") for (int m = 0; m < 4; ++m) _Pragma("unroll") for (int k = 0; k < 2; ++k) dst[m][k] = *(const LAS bf16x8*)(lds + PG_SA(b, h) + aoff + m * 2048 + k * 1024); } while (0)
#define PG_LDB(dst, b, h) do { _Pragma("unroll") for (int n = 0; n < 2; ++n) _Pragma("unroll") for (int k = 0; k < 2; ++k) dst[n][k] = *(const LAS bf16x8*)(lds + PG_SB(b, h) + boff + n * 2048 + k * 1024); } while (0)
#define PG_MMA(ai, bj, At, Bt) do { __builtin_amdgcn_s_setprio(1); _Pragma("unroll") for (int m = 0; m < 4; ++m) _Pragma("unroll") for (int n = 0; n < 2; ++n) _Pragma("unroll") for (int k = 0; k < 2; ++k) \
        acc[ai][bj][m][n] = __builtin_amdgcn_mfma_f32_16x16x32_bf16(Bt[n][k], At[m][k], acc[ai][bj][m][n], 0, 0, 0); __builtin_amdgcn_s_setprio(0); } while (0)
#define PG_WAIT_V(n) asm volatile("s_waitcnt vmcnt(" #n ")" ::: "memory")
#define PG_WAIT_L(n) asm volatile("s_waitcnt lgkmcnt(" #n ")" ::: "memory")
#define PG_BAR __builtin_amdgcn_s_barrier()
#define PG_SCHED __builtin_amdgcn_sched_barrier(0)
    Unit cur, nxt; int ui = 0;
    if (!S.next(0, cur)) return;
    f32x4 acc[2][2][4][2];
#pragma unroll
    for (int a = 0; a < 2; ++a)
#pragma unroll
        for (int b = 0; b < 2; ++b)
#pragma unroll
            for (int m = 0; m < 4; ++m)
#pragma unroll
                for (int n = 0; n < 2; ++n) acc[a][b][m][n] = (f32x4){0.f, 0.f, 0.f, 0.f};
    bf16x8 At[4][2], B0[2][2], B1[2][2];
    unsigned vA0, vA1, vA2, vA3, vN0, vN1, vN2, vN3;
    vA0 = S.rowoff(cur, RA[0]) + CA[0]; vA1 = S.rowoff(cur, RA[1]) + CA[1]; vA2 = S.rowoff(cur, HALF + RA[0]) + CA[0]; vA3 = S.rowoff(cur, HALF + RA[1]) + CA[1];
    const char* cA = cur.A; const char* cB = cur.B;
    PG_STAGEB(PG_SB(0, 0), cB); PG_STAGEB(PG_SB(0, 1), cB + hstep); PG_STAGEA(PG_SA(0, 0), cA, vA0, vA1); PG_STAGEA(PG_SA(0, 1), cA, vA2, vA3);
    if (wr == 1) PG_BAR;
    PG_WAIT_V(2); PG_BAR;
    PG_STAGEB(PG_SB(1, 0), cB + kstep); PG_STAGEA(PG_SA(1, 0), cA + kstep, vA0, vA1); PG_STAGEB(PG_SB(1, 1), cB + hstep + kstep);
    PG_WAIT_V(6); PG_BAR;
    for (;;) {
        const bool has_next = S.next(ui + 1, nxt);
        const char* nA = has_next ? nxt.A : cA; const char* nB = has_next ? nxt.B : cB;
        if (has_next) { vN0 = S.rowoff(nxt, RA[0]) + CA[0]; vN1 = S.rowoff(nxt, RA[1]) + CA[1]; vN2 = S.rowoff(nxt, HALF + RA[0]) + CA[0]; vN3 = S.rowoff(nxt, HALF + RA[1]) + CA[1]; }
        else { vN0 = vA0; vN1 = vA1; vN2 = vA2; vN3 = vA3; }
        for (int t = 0; t < nt; t += 2) {
            const bool last = (t == nt - 2);
            const char* a1 = cA + (size_t)(t + 1) * kstep;
            const char* a2 = last ? nA : cA + (size_t)(t + 2) * kstep; const char* b2 = last ? nB : cB + (size_t)(t + 2) * kstep;
            const char* a3 = a2 + kstep; const char* b3 = b2 + kstep;
            const unsigned w0 = last ? vN0 : vA0, w1 = last ? vN1 : vA1, w2 = last ? vN2 : vA2, w3 = last ? vN3 : vA3;
            PG_LDB(B0, 0, 0); PG_LDB(B1, 0, 1); PG_SCHED; PG_LDA(At, 0, 0); PG_STAGEA(PG_SA(1, 1), a1, vA2, vA3);
            PG_WAIT_V(8); PG_WAIT_L(0); PG_BAR; PG_MMA(0, 0, At, B0); PG_MMA(0, 1, At, B1); PG_BAR; PG_SCHED;
            PG_LDA(At, 0, 1); PG_STAGEB(PG_SB(0, 0), b2); PG_STAGEB(PG_SB(0, 1), b2 + hstep); PG_STAGEA(PG_SA(0, 0), a2, w0, w1);
            PG_WAIT_V(8); PG_WAIT_L(0); PG_BAR; PG_MMA(1, 0, At, B0); PG_MMA(1, 1, At, B1); PG_BAR; PG_SCHED;
            PG_LDB(B0, 1, 0); PG_LDB(B1, 1, 1); PG_SCHED; PG_LDA(At, 1, 0); PG_STAGEA(PG_SA(0, 1), a2, w2, w3);
            PG_WAIT_V(8); PG_WAIT_L(0); PG_BAR; PG_MMA(0, 0, At, B0); PG_MMA(0, 1, At, B1); PG_BAR; PG_SCHED;
            PG_LDA(At, 1, 1); PG_STAGEB(PG_SB(1, 0), b3); PG_STAGEB(PG_SB(1, 1), b3 + hstep); PG_STAGEA(PG_SA(1, 0), a3, w0, w1);
            PG_WAIT_V(8); PG_WAIT_L(0); PG_BAR; PG_MMA(1, 0, At, B0); PG_MMA(1, 1, At, B1); PG_BAR; PG_SCHED;
        }
        if (wr == 0) PG_BAR;
        E(acc, cur, wr, wc, fr, fq);
        if (!has_next) break;
        if (!cur.keep) {
#pragma unroll
            for (int a = 0; a < 2; ++a)
#pragma unroll
                for (int b = 0; b < 2; ++b)
#pragma unroll
                    for (int m = 0; m < 4; ++m)
#pragma unroll
                        for (int n = 0; n < 2; ++n) acc[a][b][m][n] = (f32x4){0.f, 0.f, 0.f, 0.f};
        }
        cur = nxt; cA = nA; cB = nB; vA0 = vN0; vA1 = vN1; vA2 = vN2; vA3 = vN3; ++ui;
        if (wr == 1) PG_BAR;
    }
    PG_WAIT_V(0);
    PG_BAR;
#undef PG_SA
#undef PG_SB
#undef PG_STAGEA
#undef PG_STAGEB
#undef PG_LDA
#undef PG_LDB
#undef PG_MMA
#undef PG_WAIT_V
#undef PG_WAIT_L
#undef PG_BAR
#undef PG_SCHED
}
struct DenseOrder {
    const char* A; const char* B; int K, nM, nN, nwg, G, c;
    __device__ __forceinline__ void init(const void* A_, const void* B_, int M, int N, int K_, int G_, int c_) { A = (const char*)A_; B = (const char*)B_; K = K_; nM = M / BM; nN = N / BM; nwg = nM * nN; G = G_; c = c_; }
    __device__ __forceinline__ bool tile(int i, int& pm, int& pn) const {
        const long L = (long)i * G + c; if (L >= nwg) return false;
        int wgid = (int)L; { const int q = nwg / 8, r = nwg % 8, xcd = wgid % 8, off = wgid / 8; wgid = (xcd < r ? xcd * (q + 1) : r * (q + 1) + (xcd - r) * q) + off; }
        const int nig = 8 * nN, gid = wgid / nig, fm = gid * 8, gsz = (nM - fm) < 8 ? (nM - fm) : 8;
        pm = fm + ((wgid % nig) % gsz); pn = (wgid % nig) / gsz; return true;
    }
    __device__ __forceinline__ bool next(int i, Unit& u) const {
        int pm, pn; if (!tile(i, pm, pn)) return false;
        u.pm = pm; u.pn = pn; u.e = 0; u.j = 0; u.valid = 256; u.keep = 0;
        u.A = A + (size_t)pm * BM * K * 2; u.B = B + (size_t)pn * BM * K * 2; return true;
    }
    __device__ __forceinline__ unsigned rowoff(const Unit&, int r) const { return (unsigned)(r * K * 2); }
};
}

__device__ __forceinline__ unsigned pk2(float lo, float hi) { return f2bf(lo) | (f2bf(hi) << 16); }
__device__ __forceinline__ void tr_item(const float* W, int ldw, int src_c0, int k0, bf16* WT0, int K, LAS float* scr, int lane) {
#pragma unroll 8
    for (int i = 0; i < 32; ++i) { const int kk = 2 * i + (lane >> 5); scr[kk * 33 + (lane & 31)] = W[(size_t)(k0 + kk) * ldw + src_c0 + (lane & 31)]; }
    asm volatile("s_waitcnt lgkmcnt(0)" ::: "memory");
    const int c = lane & 7;
#pragma unroll
    for (int j = 0; j < 4; ++j) { const int n = (lane >> 3) + 8 * j; const LAS float* sp = scr + (8 * c) * 33 + n;
        u32x4 o; o.x = pk2(sp[0 * 33], sp[1 * 33]); o.y = pk2(sp[2 * 33], sp[3 * 33]); o.z = pk2(sp[4 * 33], sp[5 * 33]); o.w = pk2(sp[6 * 33], sp[7 * 33]);
        *(u32x4*)(WT0 + (size_t)n * K + 8 * c) = o; }
    asm volatile("s_waitcnt lgkmcnt(0)" ::: "memory");
}
__device__ __forceinline__ int win_src_col(int d) {
    return d < 256 ? C_GQ + d : d < 512 ? C_GK + (d - 256) : d < 1024 ? C_GV + (d - 512) : d < 1536 ? C_GR + (d - 1024) : d < 2048 ? C_SQ + (d - 1536) : d < 2176 ? C_SK + (d - 2048)
         : d < 2304 ? C_SV + (d - 2176) : d < 3328 ? C_MA + (d - 2304) : C_MB + (d - 3328);
}
__device__ __forceinline__ void ph_weights(const Frame& F) {
    LAS float* scr = (LAS float*)(F.lds + F.wave * 16384);
    const int gw = F.bid * NWAVES + F.wave, NGW = F.G * NWAVES;
    unsigned char* ws = F.ws();
    constexpr int IA = 16 * 136, IB1 = 8 * 32, IB3 = 16 * 32, IC = 16 * 32, ID = 8 * 32;
    constexpr int NA = DEPTH * IA, NB = DEPTH * (2 * IB1 + IB3), NC = DEPTH * NE * IC, ND = DEPTH * NE * ID;
    for (int it = gw; it < NA + NB + NC + ND; it += NGW) {
        int r = it;
        if (r < NA) { const int l = r / IA, q = r % IA, kb = q / 136, nb = q % 136;
            tr_item(F.in(I_WIN) + (size_t)l * D * INW, INW, win_src_col(32 * nb), 64 * kb, (bf16*)(ws + WS_WIN_T) + ((size_t)l * NIN + 32 * nb) * D + 64 * kb, D, scr, F.lane); continue; }
        r -= NA;
        if (r < NB) { const int l = r / (2 * IB1 + IB3); int q = r % (2 * IB1 + IB3);
            if (q < IB1) { const int kb = q / 32, nb = q % 32; tr_item(F.in(I_WUG) + (size_t)l * 512 * D, D, 32 * nb, 64 * kb, (bf16*)(ws + WS_WG_T) + ((size_t)l * D + 32 * nb) * 512 + 64 * kb, 512, scr, F.lane); continue; }
            q -= IB1;
            if (q < IB1) { const int kb = q / 32, nb = q % 32; tr_item(F.in(I_WUS) + (size_t)l * 512 * D, D, 32 * nb, 64 * kb, (bf16*)(ws + WS_WS_T) + ((size_t)l * D + 32 * nb) * 512 + 64 * kb, 512, scr, F.lane); continue; }
            q -= IB1;
            { const int kb = q / 32, nb = q % 32; tr_item(F.in(I_WOUT) + (size_t)l * D * D, D, 32 * nb, 64 * kb, (bf16*)(ws + WS_WOUT_T) + ((size_t)l * D + 32 * nb) * D + 64 * kb, D, scr, F.lane); continue; } }
        r -= NB;
        if (r < NC) { const int le = r / IC, q = r % IC, kb = q / 32, nb = q % 32, drow = 32 * nb, pn = drow >> 8, up = (drow >> 7) & 1, f0 = drow & 127;
            tr_item((up ? F.in(I_WUP) : F.in(I_WGATE)) + (size_t)le * D * DFF, DFF, 128 * pn + f0, 64 * kb, (bf16*)(ws + WS_WGU_T) + ((size_t)le * 1024 + drow) * D + 64 * kb, D, scr, F.lane); continue; }
        r -= NC;
        { const int le = r / ID, q = r % ID, kb = q / 32, nb = q % 32;
            tr_item(F.in(I_WDOWN) + (size_t)le * DFF * D, D, 32 * nb, 64 * kb, (bf16*)(ws + WS_WD_T) + ((size_t)le * D + 32 * nb) * DFF + 64 * kb, DFF, scr, F.lane); }
    }
    for (int idx = F.bid * NTHREADS + F.tid; idx < DEPTH * 256 * (D / 8); idx += F.G * NTHREADS) {
        const int l = idx / (256 * (D / 8)), q = idx % (256 * (D / 8)), rr = q / (D / 8), k0 = (q % (D / 8)) * 8;
        u32x4 o = (u32x4){0u, 0u, 0u, 0u};
        if (rr < GRANK) { const float* w = F.in(I_WIN) + (size_t)l * D * INW + C_GA + rr;
            o.x = pk2(w[(size_t)(k0 + 0) * INW], w[(size_t)(k0 + 1) * INW]); o.y = pk2(w[(size_t)(k0 + 2) * INW], w[(size_t)(k0 + 3) * INW]);
            o.z = pk2(w[(size_t)(k0 + 4) * INW], w[(size_t)(k0 + 5) * INW]); o.w = pk2(w[(size_t)(k0 + 6) * INW], w[(size_t)(k0 + 7) * INW]); }
        *(u32x4*)((bf16*)(ws + WS_WIN_T) + ((size_t)l * NIN + 4352 + rr) * D + k0) = o;
    }
    __syncthreads();
}

struct EpiG3 {
    const float* xin; float* out; const float* modl;
    __device__ __forceinline__ void operator()(f32x4 (&acc)[2][2][4][2], const pg::Unit& u, int wr, int wc, int fr, int fq) const {
        const float* g = modl + ((size_t)(u.pm >> 5) * 6 + 2) * D; const int col0 = u.pn * 256 + wc * 32 + fq * 8;
        f32x4 gv[2][2];
#pragma unroll
        for (int bj = 0; bj < 2; ++bj)
#pragma unroll
            for (int n = 0; n < 2; ++n) gv[bj][n] = *(const f32x4*)(g + col0 + bj * 128 + n * 4);
#pragma unroll
        for (int ai = 0; ai < 2; ++ai)
#pragma unroll
            for (int m = 0; m < 4; ++m) { const size_t ro = (size_t)(u.pm * 256 + ai * 128 + wr * 64 + m * 16 + fr) * D + col0;
#pragma unroll
                for (int bj = 0; bj < 2; ++bj)
#pragma unroll
                    for (int n = 0; n < 2; ++n) { const f32x4 xv = *(const f32x4*)(xin + ro + bj * 128 + n * 4); *(f32x4*)(out + ro + bj * 128 + n * 4) = xv + gv[bj][n] * acc[ai][bj][m][n]; } }
    }
};
__device__ __forceinline__ void ph_gemm3_mfma(const Frame& F, int l, const float* xin) {
    unsigned char* ws = F.ws();
    pg::DenseOrder S; S.init(ws + WS_MERGED, ws + WS_WOUT_T + (size_t)l * D * D * 2, T, D, D, F.G, F.bid);
    EpiG3 E{xin, F.out(), (const float*)(ws + WS_MOD) + (size_t)l * BATCH * 6 * D};
    pg::gemm_phase(F.lds, F.tid, D, S, E);
}

struct EpiG1 {
    unsigned char* ws;
    __device__ __forceinline__ void operator()(f32x4 (&acc)[2][2][4][2], const pg::Unit& u, int wr, int wc, int fr, int fq) const {
        const int pn = u.pn, row0 = u.pm * 256 + wr * 64 + fr, c8 = wc * 32 + fq * 8;
        if (pn == 17) {
            if (wc == 0 && fq < 2) { float* GA = (float*)(ws + WS_GA);
#pragma unroll
                for (int ai = 0; ai < 2; ++ai)
#pragma unroll
                    for (int m = 0; m < 4; ++m) { float* p = GA + (size_t)(row0 + ai * 128 + m * 16) * 16 + fq * 8; *(f32x4*)p = acc[ai][0][m][0]; *(f32x4*)(p + 4) = acc[ai][0][m][1]; } }
            return;
        }
        bf16* b0; bf16* b1; int ld, op = 0;
        if (pn == 0)      { b0 = (bf16*)(ws + WS_GQ); ld = 256; b1 = b0 + 128; op = 1; }
        else if (pn == 1) { b0 = (bf16*)(ws + WS_GK); ld = 256; b1 = b0 + 128; }
        else if (pn < 4)  { b0 = (bf16*)(ws + WS_GV) + (pn - 2) * 256; ld = 512; b1 = b0 + 128; }
        else if (pn < 6)  { b0 = (bf16*)(ws + WS_GR) + (pn - 4) * 256; ld = 512; b1 = b0 + 128; op = 2; }
        else if (pn < 8)  { b0 = (bf16*)(ws + WS_SQ) + (pn - 6) * 256; ld = 512; b1 = b0 + 128; }
        else if (pn == 8) { b0 = (bf16*)(ws + WS_SK); b1 = (bf16*)(ws + WS_SV); ld = 128; }
        else if (pn < 13) { b0 = (bf16*)(ws + WS_MA) + (pn - 9) * 256; ld = 1024; b1 = b0 + 128; op = 3; }
        else              { b0 = (bf16*)(ws + WS_MB) + (pn - 13) * 256; ld = 1024; b1 = b0 + 128; op = 3; }
#pragma unroll
        for (int ai = 0; ai < 2; ++ai)
#pragma unroll
            for (int m = 0; m < 4; ++m) { const size_t ro = (size_t)(row0 + ai * 128 + m * 16) * ld + c8;
#pragma unroll
                for (int bj = 0; bj < 2; ++bj) { f32x4 v0 = acc[ai][bj][m][0], v1 = acc[ai][bj][m][1];
                    if (op == 1) { v0 = v0 * 0.125f; v1 = v1 * 0.125f; }
                    else if (op == 2) {
#pragma unroll
                        for (int q = 0; q < 4; ++q) { v0[q] = v0[q] * __builtin_amdgcn_rcpf(1.f + __expf(-v0[q])); v1[q] = v1[q] * __builtin_amdgcn_rcpf(1.f + __expf(-v1[q])); } }
                    else if (op == 3) {
#pragma unroll
                        for (int q = 0; q < 4; ++q) { v0[q] = __builtin_amdgcn_rcpf(1.f + __expf(-v0[q])); v1[q] = __builtin_amdgcn_rcpf(1.f + __expf(-v1[q])); } }
                    u32x4 w; w.x = pg::cvt_pk_bf16(v0[0], v0[1]); w.y = pg::cvt_pk_bf16(v0[2], v0[3]); w.z = pg::cvt_pk_bf16(v1[0], v1[1]); w.w = pg::cvt_pk_bf16(v1[2], v1[3]);
                    *(u32x4*)((bj ? b1 : b0) + ro) = w; } }
    }
};
struct EpiNull { __device__ __forceinline__ void operator()(f32x4 (&acc)[2][2][4][2], const pg::Unit& u, int, int, int, int) const { if (u.pm < 0) asm volatile("" :: "v"(acc[0][0][0][0][0])); } };
__device__ __forceinline__ void ph_gemm1_null(const Frame& F, int l) {
    unsigned char* ws = F.ws();
    pg::DenseOrder S; S.init(ws + WS_H, ws + WS_WIN_T + (size_t)l * NIN * D * 2, T, NIN, D, F.G, F.bid);
    EpiNull E{};
    pg::gemm_phase(F.lds, F.tid, D, S, E);
}
__device__ __forceinline__ void ph_gemm1_mfma(const Frame& F, int l) {
    unsigned char* ws = F.ws();
    pg::DenseOrder S; S.init(ws + WS_H, ws + WS_WIN_T + (size_t)l * NIN * D * 2, T, NIN, D, F.G, F.bid);
    EpiG1 E{ws};
    pg::gemm_phase(F.lds, F.tid, D, S, E);
}
struct G2Order {
    pg::DenseOrder d; const char* A2; const char* B2;
    __device__ __forceinline__ bool next(int i, pg::Unit& u) const {
        int pm, pn; if (!d.tile(i >> 1, pm, pn)) return false;
        const int seg = i & 1; u.pm = pm; u.pn = pn; u.e = seg; u.j = 0; u.valid = 256; u.keep = !seg;
        u.A = (seg ? A2 : d.A) + (size_t)pm * 256 * d.K * 2; u.B = (seg ? B2 : d.B) + (size_t)pn * 256 * d.K * 2; return true;
    }
    __device__ __forceinline__ unsigned rowoff(const pg::Unit&, int r) const { return (unsigned)(r * d.K * 2); }
};
struct EpiG2 {
    const bf16* MA; const bf16* MB; bf16* MG;
    __device__ __forceinline__ void operator()(f32x4 (&acc)[2][2][4][2], const pg::Unit& u, int wr, int wc, int fr, int fq) const {
        const int row0 = u.pm * 256 + wr * 64 + fr, col0 = u.pn * 256 + wc * 32 + fq * 8;
#pragma unroll
        for (int ai = 0; ai < 2; ++ai)
#pragma unroll
            for (int m = 0; m < 4; ++m) { const size_t ro = (size_t)(row0 + ai * 128 + m * 16) * D + col0;
#pragma unroll
                for (int bj = 0; bj < 2; ++bj) {
                    const u32x4 bw = *(const u32x4*)(MB + ro + bj * 128);
                    float sb[8];
#pragma unroll
                    for (int q = 0; q < 4; ++q) { sb[2 * q] = bf2f(bw[q] & 0xffffu); sb[2 * q + 1] = bf2f(bw[q] >> 16); }
                    if (u.e == 0) {
                        const u32x4 aw = *(const u32x4*)(MA + ro + bj * 128);
#pragma unroll
                        for (int q = 0; q < 4; ++q) { const float a0 = bf2f(aw[q] & 0xffffu), a1 = bf2f(aw[q] >> 16);
                            const float r0 = a0 * __builtin_amdgcn_rcpf(fmaxf(sb[2 * q], 1e-20f)), r1 = a1 * __builtin_amdgcn_rcpf(fmaxf(sb[2 * q + 1], 1e-20f));
                            if (q < 2) { acc[ai][bj][m][0][2 * q] *= r0; acc[ai][bj][m][0][2 * q + 1] *= r1; } else { acc[ai][bj][m][1][2 * q - 4] *= r0; acc[ai][bj][m][1][2 * q - 3] *= r1; } }
                    } else {
                        const f32x4 v0 = acc[ai][bj][m][0], v1 = acc[ai][bj][m][1];
                        u32x4 w; w.x = pg::cvt_pk_bf16(v0[0] * sb[0], v0[1] * sb[1]); w.y = pg::cvt_pk_bf16(v0[2] * sb[2], v0[3] * sb[3]);
                        w.z = pg::cvt_pk_bf16(v1[0] * sb[4], v1[1] * sb[5]); w.w = pg::cvt_pk_bf16(v1[2] * sb[6], v1[3] * sb[7]);
                        *(u32x4*)(MG + ro + bj * 128) = w; } } }
    }
};
__device__ __forceinline__ void ph_gemm2_mfma(const Frame& F, int l) {
    unsigned char* ws = F.ws();
    G2Order S; S.d.init(ws + WS_GLAO, ws + WS_WG_T + (size_t)l * D * 512 * 2, T, D, 512, F.G, F.bid); S.A2 = (const char*)(ws + WS_SWAO); S.B2 = (const char*)(ws + WS_WS_T + (size_t)l * D * 512 * 2);
    EpiG2 E{(const bf16*)(ws + WS_MA), (const bf16*)(ws + WS_MB), (bf16*)(ws + WS_MERGED)};
    pg::gemm_phase(F.lds, F.tid, 512, S, E);
}

constexpr int MOE_TAB = 131072 + 1024;
__device__ __forceinline__ void moe_table(const Frame& F, int l) {
    volatile LAS int* tb = (volatile LAS int*)(F.lds + MOE_TAB);
    if (F.tid == 0) { const unsigned* cnt = (const unsigned*)(F.ws() + WS_CTL) + CW_CNT + 64 * (NE * l); int run = 0;
        for (int e = 0; e < NE; ++e) { const int ce = (int)__hip_atomic_load(cnt + 64 * e, __ATOMIC_RELAXED, __HIP_MEMORY_SCOPE_AGENT); tb[e] = run; tb[32 + e] = ce; run += (ce + 255) >> 8; }
        tb[16] = run; }
    __syncthreads();
}
template <bool GATHER>
struct MoeOrder {
    LAS unsigned char* lds; const char* Abase; const char* Bbase; const int* tokl; int K, G, c;
    __device__ __forceinline__ bool next(int i, pg::Unit& u) const {
        volatile LAS int* tb = (volatile LAS int*)(lds + MOE_TAB);
        const int L = i * G + c, ti = L >> 2, pn = L & 3;
        if (ti >= tb[16]) return false;
        int e = 0;
#pragma unroll
        for (int k = 1; k < NE; ++k) e += (ti >= tb[k]) ? 1 : 0;
        e = __builtin_amdgcn_readfirstlane(e);
        const int j = ti - __builtin_amdgcn_readfirstlane(tb[e]), ce = __builtin_amdgcn_readfirstlane(tb[32 + e]);
        u.pm = ti; u.pn = pn; u.e = e; u.j = j; u.valid = (ce - 256 * j) < 256 ? (ce - 256 * j) : 256; u.keep = 0;
        u.A = GATHER ? Abase : Abase + (size_t)ti * 256 * K * 2;
        u.B = Bbase + ((size_t)e * 1024 + pn * 256) * K * 2; return true;
    }
    __device__ __forceinline__ unsigned rowoff(const pg::Unit& u, int r) const {
        if (!GATHER) return (unsigned)(r * K * 2);
        int tk = 0; if (r < u.valid) tk = tokl[(size_t)u.e * ECAP + 256 * u.j + r] >> 1;
        return (unsigned)tk * (unsigned)(K * 2);
    }
};
struct EpiMU {
    bf16* ACT;
    __device__ __forceinline__ void operator()(f32x4 (&acc)[2][2][4][2], const pg::Unit& u, int wr, int wc, int fr, int fq) const {
#pragma unroll
        for (int ai = 0; ai < 2; ++ai)
#pragma unroll
            for (int m = 0; m < 4; ++m) { bf16* p = ACT + (size_t)(u.pm * 256 + ai * 128 + wr * 64 + m * 16 + fr) * DFF + u.pn * 128 + wc * 32 + fq * 8;
                float o[8];
#pragma unroll
                for (int n = 0; n < 2; ++n)
#pragma unroll
                    for (int q = 0; q < 4; ++q) { const float g = acc[ai][0][m][n][q]; o[n * 4 + q] = g * __builtin_amdgcn_rcpf(1.f + __expf(-g)) * acc[ai][1][m][n][q]; }
                u32x4 w; w.x = pg::cvt_pk_bf16(o[0], o[1]); w.y = pg::cvt_pk_bf16(o[2], o[3]); w.z = pg::cvt_pk_bf16(o[4], o[5]); w.w = pg::cvt_pk_bf16(o[6], o[7]);
                *(u32x4*)p = w; }
    }
};
struct EpiMD {
    bf16* Y0; const int* tokl; const float* wl;
    __device__ __forceinline__ void operator()(f32x4 (&acc)[2][2][4][2], const pg::Unit& u, int wr, int wc, int fr, int fq) const {
        const size_t lb = (size_t)u.e * ECAP + 256 * u.j; const int c8 = u.pn * 256 + wc * 32 + fq * 8;
#pragma unroll
        for (int ai = 0; ai < 2; ++ai)
#pragma unroll
            for (int m = 0; m < 4; ++m) { const int r = ai * 128 + wr * 64 + m * 16 + fr;
                if (r < u.valid) { const int ent = tokl[lb + r]; const float w = wl[lb + r];
                    bf16* p = Y0 + (size_t)(ent & 1) * ((WS_Y1 - WS_Y0) / 2) + (size_t)(ent >> 1) * D + c8;
#pragma unroll
                    for (int bj = 0; bj < 2; ++bj) { const f32x4 v0 = acc[ai][bj][m][0] * w, v1 = acc[ai][bj][m][1] * w;
                        u32x4 o; o.x = pg::cvt_pk_bf16(v0[0], v0[1]); o.y = pg::cvt_pk_bf16(v0[2], v0[3]); o.z = pg::cvt_pk_bf16(v1[0], v1[1]); o.w = pg::cvt_pk_bf16(v1[2], v1[3]);
                        *(u32x4*)(p + bj * 128) = o; } } }
    }
};
__device__ __forceinline__ int vcu_of(const Frame& F) { return (F.G % 8 == 0) ? (F.bid % 8) * (F.G / 8) + F.bid / 8 : F.bid; }
__device__ __forceinline__ void ph_moe_up_mfma(const Frame& F, int l) {
    unsigned char* ws = F.ws(); moe_table(F, l);
    MoeOrder<true> S{F.lds, (const char*)(ws + WS_H), (const char*)(ws + WS_WGU_T + (size_t)l * NE * 1024 * D * 2), (const int*)(ws + WS_TOKL), D, F.G, vcu_of(F)};
    EpiMU E{(bf16*)(ws + WS_ACT)};
    pg::gemm_phase(F.lds, F.tid, D, S, E);
}
__device__ __forceinline__ void ph_moe_down_mfma(const Frame& F, int l) {
    unsigned char* ws = F.ws(); moe_table(F, l);
    MoeOrder<false> S{F.lds, (const char*)(ws + WS_ACT), (const char*)(ws + WS_WD_T + (size_t)l * NE * 1024 * DFF * 2), (const int*)(ws + WS_TOKL), DFF, F.G, vcu_of(F)};
    EpiMD E{(bf16*)(ws + WS_Y0), (const int*)(ws + WS_TOKL), (const float*)(ws + WS_WL)};
    pg::gemm_phase(F.lds, F.tid, DFF, S, E);
}
__device__ __forceinline__ void ph_rope_table(const Frame& F) {
    const int* pos = (const int*)F.in(I_POS); float* RT = (float*)(F.ws() + WS_ROPE);
    for (int idx = F.bid * NTHREADS + F.tid; idx < T * 8; idx += F.G * NTHREADS) {
        const int t = idx >> 3, i = idx & 7;
        const float invf = (float)exp2(-(double)i * (1.0 / 8.0) * 18.931568569324174);
        const float ang = (float)pos[t] * invf;
        const double rev = (double)ang * 0.15915494309189535; const float fr = (float)(rev - floor(rev));
        RT[(size_t)t * 16 + i] = __builtin_amdgcn_cosf(fr); RT[(size_t)t * 16 + 8 + i] = __builtin_amdgcn_sinf(fr);
    }
}
typedef float f32x16 __attribute__((ext_vector_type(16)));
constexpr int SWA_KP = 144, SWA_VP = 520, SWA_VT_OFF = 256 * SWA_KP;
__device__ __forceinline__ void ph_swa_mfma(const Frame& F, int l) {
    unsigned char* ws = F.ws();
    const bf16* SQ = (const bf16*)(ws + WS_SQ); const bf16* SK = (const bf16*)(ws + WS_SK); const bf16* SV = (const bf16*)(ws + WS_SV); bf16* O = (bf16*)(ws + WS_SWAO);
    const float* RT = (const float*)(ws + WS_ROPE);
    const float* qn = F.in(I_QN) + l * SHD; const float* kn = F.in(I_KN) + l * SHD; const float* sinks = F.in(I_SINK) + l * SH;
    LAS unsigned char* Kb = F.lds; LAS unsigned char* Vt = F.lds + SWA_VT_OFF;
    const int tid = F.tid, lane = F.lane, w = F.wave, r = lane & 31, h = lane >> 5;
    constexpr float QSCALE = 0.125f * 1.4426950408889634f;
    for (int unit = F.bid; unit < BATCH * SKV * (SEQ / WIN); unit += F.G) {
        const int n = unit & 63, kvh = (unit >> 6) & 1, b = unit >> 7;
        const int tq0 = b * SEQ + n * WIN, tk0 = tq0 - WIN;
        __syncthreads();
#pragma unroll
        for (int it = 0; it < 4; ++it) {
            const int key = (tid >> 3) + 64 * it, c = tid & 7; const bool valid = (n > 0) || (key >= WIN); const int tok = valid ? tk0 + key : tq0;
            const u32x4 raw = *(const u32x4*)(SK + (size_t)tok * 128 + kvh * 64 + 8 * c);
            float v[8];
#pragma unroll
            for (int q = 0; q < 4; ++q) { v[2 * q] = bf2f(raw[q] & 0xffffu); v[2 * q + 1] = bf2f(raw[q] >> 16); }
            float ss = 0.f;
#pragma unroll
            for (int j = 0; j < 8; ++j) ss += v[j] * v[j];
            ss += shx(ss, 1, lane); ss += shx(ss, 2, lane); ss += shx(ss, 4, lane);
            const float rstd = 1.0f / sqrtf(ss * (1.f / 64.f) + EPS);
            const f32x4 g0 = *(const f32x4*)(kn + 8 * c), g1 = *(const f32x4*)(kn + 8 * c + 4);
#pragma unroll
            for (int j = 0; j < 4; ++j) { v[j] = v[j] * rstd * g0[j]; v[4 + j] = v[4 + j] * rstd * g1[j]; }
            float pr[8];
#pragma unroll
            for (int j = 0; j < 8; ++j) pr[j] = shx(v[j], 1, lane);
            if (c < 2) {
                const f32x4 c0 = *(const f32x4*)(RT + (size_t)tok * 16), c1 = *(const f32x4*)(RT + (size_t)tok * 16 + 4), s0 = *(const f32x4*)(RT + (size_t)tok * 16 + 8), s1 = *(const f32x4*)(RT + (size_t)tok * 16 + 12);
                const float sg = c == 0 ? -1.f : 1.f;
#pragma unroll
                for (int j = 0; j < 4; ++j) { v[j] = v[j] * c0[j] + sg * pr[j] * s0[j]; v[4 + j] = v[4 + j] * c1[j] + sg * pr[4 + j] * s1[j]; }
            }
            u32x4 o; o.x = pk2(v[0], v[1]); o.y = pk2(v[2], v[3]); o.z = pk2(v[4], v[5]); o.w = pk2(v[6], v[7]);
            if (!valid) o = (u32x4){0u, 0u, 0u, 0u};
            *(LAS u32x4*)(Kb + key * SWA_KP + 16 * c) = o;
        }
#pragma unroll
        for (int it = 0; it < 2; ++it) {
            const int kp = (tid >> 3) + 64 * it, c = tid & 7, key = 2 * kp; const bool valid = (n > 0) || (key >= WIN); const int tok = valid ? tk0 + key : tq0;
            u32x4 r0 = *(const u32x4*)(SV + (size_t)tok * 128 + kvh * 64 + 8 * c), r1 = *(const u32x4*)(SV + (size_t)(tok + 1) * 128 + kvh * 64 + 8 * c);
            if (!valid) { r0 = (u32x4){0u, 0u, 0u, 0u}; r1 = r0; }
#pragma unroll
            for (int q = 0; q < 4; ++q) {
                *(LAS unsigned*)(Vt + (8 * c + 2 * q) * SWA_VP + 4 * kp) = (r0[q] & 0xffffu) | (r1[q] << 16);
                *(LAS unsigned*)(Vt + (8 * c + 2 * q + 1) * SWA_VP + 4 * kp) = (r0[q] >> 16) | (r1[q] & 0xffff0000u);
            }
        }
        __syncthreads();
        const int g = w >> 1, hq = kvh * 4 + g; const float sink2 = sinks[hq] * 1.4426950408889634f;
#pragma unroll 1
        for (int qt = 0; qt < 2; ++qt) {
            const int p0 = 64 * (w & 1) + 32 * qt; const size_t tq = (size_t)(tq0 + p0 + r);
            float qv[4][8]; float ss = 0.f;
#pragma unroll
            for (int s4 = 0; s4 < 4; ++s4) { const u32x4 raw = *(const u32x4*)(SQ + tq * 512 + hq * 64 + 16 * s4 + 8 * h);
#pragma unroll
                for (int q = 0; q < 4; ++q) { qv[s4][2 * q] = bf2f(raw[q] & 0xffffu); qv[s4][2 * q + 1] = bf2f(raw[q] >> 16); } }
#pragma unroll
            for (int s4 = 0; s4 < 4; ++s4)
#pragma unroll
                for (int j = 0; j < 8; ++j) ss += qv[s4][j] * qv[s4][j];
            ss += shx(ss, 32, lane);
            const float rstd = 1.0f / sqrtf(ss * (1.f / 64.f) + EPS);
#pragma unroll
            for (int s4 = 0; s4 < 4; ++s4) { const f32x4 g0 = *(const f32x4*)(qn + 16 * s4 + 8 * h), g1 = *(const f32x4*)(qn + 16 * s4 + 8 * h + 4);
#pragma unroll
                for (int j = 0; j < 4; ++j) { qv[s4][j] = qv[s4][j] * rstd * g0[j]; qv[s4][4 + j] = qv[s4][4 + j] * rstd * g1[j]; } }
            { float pr[8];
#pragma unroll
              for (int j = 0; j < 8; ++j) pr[j] = shx(qv[0][j], 32, lane);
              const f32x4 c0 = *(const f32x4*)(RT + tq * 16), c1 = *(const f32x4*)(RT + tq * 16 + 4), s0 = *(const f32x4*)(RT + tq * 16 + 8), s1 = *(const f32x4*)(RT + tq * 16 + 12);
              const float sg = h == 0 ? -1.f : 1.f;
#pragma unroll
              for (int j = 0; j < 4; ++j) { qv[0][j] = qv[0][j] * c0[j] + sg * pr[j] * s0[j]; qv[0][4 + j] = qv[0][4 + j] * c1[j] + sg * pr[4 + j] * s1[j]; } }
            pg::bf16x8 qf[4];
#pragma unroll
            for (int s4 = 0; s4 < 4; ++s4) { u32x4 t; t.x = pk2(qv[s4][0] * QSCALE, qv[s4][1] * QSCALE); t.y = pk2(qv[s4][2] * QSCALE, qv[s4][3] * QSCALE); t.z = pk2(qv[s4][4] * QSCALE, qv[s4][5] * QSCALE); t.w = pk2(qv[s4][6] * QSCALE, qv[s4][7] * QSCALE);
                qf[s4] = __builtin_bit_cast(pg::bf16x8, t); }
            f32x16 sc[5];
#pragma unroll
            for (int kt = 0; kt < 5; ++kt) {
                f32x16 a16;
#pragma unroll
                for (int i = 0; i < 16; ++i) a16[i] = 0.f;
#pragma unroll
                for (int s4 = 0; s4 < 4; ++s4) { const pg::bf16x8 ka = *(const LAS pg::bf16x8*)(Kb + (p0 + 32 * kt + r) * SWA_KP + (16 * s4 + 8 * h) * 2);
                    a16 = __builtin_amdgcn_mfma_f32_32x32x16_bf16(ka, qf[s4], a16, 0, 0, 0); }
                sc[kt] = a16;
            }
            const int kt_lo = (n == 0) ? 4 - (p0 >> 5) : 0;
            float mx = sink2;
#pragma unroll
            for (int kt = 0; kt < 5; ++kt)
#pragma unroll
                for (int i = 0; i < 16; ++i) { const int kk = (i & 3) + 8 * (i >> 2) + 4 * h;
                    bool ok = kt >= kt_lo; if (kt == 0) ok = ok && (kk > r); if (kt == 4) ok = ok && (kk <= r);
                    const float sv = ok ? sc[kt][i] : -1e30f; sc[kt][i] = sv; mx = fmaxf(mx, sv); }
            mx = fmaxf(mx, shx(mx, 32, lane));
            float den = 0.f;
#pragma unroll
            for (int kt = 0; kt < 5; ++kt)
#pragma unroll
                for (int i = 0; i < 16; ++i) { const float p = __builtin_amdgcn_exp2f(sc[kt][i] - mx); sc[kt][i] = p; den += p; }
            den += shx(den, 32, lane); den += __builtin_amdgcn_exp2f(sink2 - mx);
            const float inv = 1.f / den;
            f32x16 o0, o1;
#pragma unroll
            for (int i = 0; i < 16; ++i) { o0[i] = 0.f; o1[i] = 0.f; }
#pragma unroll
            for (int kt = 0; kt < 5; ++kt)
#pragma unroll
                for (int s2 = 0; s2 < 2; ++s2) {
                    u32x4 t; t.x = pk2(sc[kt][8 * s2 + 0], sc[kt][8 * s2 + 1]); t.y = pk2(sc[kt][8 * s2 + 2], sc[kt][8 * s2 + 3]); t.z = pk2(sc[kt][8 * s2 + 4], sc[kt][8 * s2 + 5]); t.w = pk2(sc[kt][8 * s2 + 6], sc[kt][8 * s2 + 7]);
                    const pg::bf16x8 pf = __builtin_bit_cast(pg::bf16x8, t);
                    const int kb0 = p0 + 32 * kt + 16 * s2 + 4 * h;
                    typedef unsigned u32x2 __attribute__((ext_vector_type(2)));
                    const u32x2 a0 = *(const LAS u32x2*)(Vt + r * SWA_VP + kb0 * 2), a1 = *(const LAS u32x2*)(Vt + r * SWA_VP + (kb0 + 8) * 2);
                    const u32x2 b0 = *(const LAS u32x2*)(Vt + (32 + r) * SWA_VP + kb0 * 2), b1 = *(const LAS u32x2*)(Vt + (32 + r) * SWA_VP + (kb0 + 8) * 2);
                    u32x4 va; va.x = a0.x; va.y = a0.y; va.z = a1.x; va.w = a1.y; u32x4 vb; vb.x = b0.x; vb.y = b0.y; vb.z = b1.x; vb.w = b1.y;
                    o0 = __builtin_amdgcn_mfma_f32_32x32x16_bf16(__builtin_bit_cast(pg::bf16x8, va), pf, o0, 0, 0, 0);
                    o1 = __builtin_amdgcn_mfma_f32_32x32x16_bf16(__builtin_bit_cast(pg::bf16x8, vb), pf, o1, 0, 0, 0);
                }
            bf16* op = O + tq * 512 + hq * 64 + 4 * h;
#pragma unroll
            for (int i4 = 0; i4 < 4; ++i4) {
                const unsigned long long w0 = (unsigned long long)pk2(o0[4 * i4] * inv, o0[4 * i4 + 1] * inv) | ((unsigned long long)pk2(o0[4 * i4 + 2] * inv, o0[4 * i4 + 3] * inv) << 32);
                const unsigned long long w1 = (unsigned long long)pk2(o1[4 * i4] * inv, o1[4 * i4 + 1] * inv) | ((unsigned long long)pk2(o1[4 * i4 + 2] * inv, o1[4 * i4 + 3] * inv) << 32);
                *(unsigned long long*)(op + 8 * i4) = w0; *(unsigned long long*)(op + 32 + 8 * i4) = w1;
            }
        }
    }
    __syncthreads();
}

constexpr int GLA_GRP = 8, GLA_NG = NCH / GLA_GRP, GLA_UNITS = BATCH * GH * GLA_NG;
constexpr int GL_LA = 0, GL_SEG = 16384, GL_BEND = 18432, GL_DEC = 18688, GL_QD = 19456, GL_KI = 28672, GL_ATT = 37888, GL_KET = 47104, GL_VT = 56320, GL_OB = 75776, GL_P = 144;
typedef unsigned u32x2 __attribute__((ext_vector_type(2)));
template <bool OUT>
__device__ __forceinline__ void ph_gla_mfma(const Frame& F, int l) {
    unsigned char* ws = F.ws();
    const bf16* GQ = (const bf16*)(ws + WS_GQ); const bf16* GK = (const bf16*)(ws + WS_GK); const bf16* GV = (const bf16*)(ws + WS_GV); const bf16* GR = (const bf16*)(ws + WS_GR);
    const float* GA = (const float*)(ws + WS_GA); float* SLOC = (float*)(ws + WS_STATE); float* GDEC = (float*)(ws + WS_DECAY); bf16* GO = (bf16*)(ws + WS_GLAO);
    const float* wa2 = F.in(I_WA2) + (size_t)l * GRANK * 256; const float* ba = F.in(I_BA) + l * 256; const float* gn = F.in(I_GNORM) + l * 512;
    LAS unsigned char* L0 = F.lds;
    const int tid = F.tid, lane = F.lane, w = F.wave, L = lane & 15, q = lane >> 4;
    for (int ui = 0; ui < 2; ++ui) {
        int unit = ui == 0 ? F.bid : GLA_UNITS / 2 + (F.bid & ~15) + (15 - (F.bid & 15));
        if (F.G != GLA_UNITS / 2) { unit = F.bid + ui * F.G; }
        for (; unit < GLA_UNITS; unit += (F.G != GLA_UNITS / 2) ? 2 * F.G : GLA_UNITS) {
        const int g = unit & 15, h = (unit >> 4) & 3, b = unit >> 6;
        const int d_ = tid & 63;
        float w2r[GRANK];
#pragma unroll
        for (int r = 0; r < GRANK; ++r) w2r[r] = wa2[r * 256 + h * 64 + d_];
        const float ba_d = ba[h * 64 + d_];
        f32x4 S[4];
#pragma unroll
        for (int t = 0; t < 4; ++t) S[t] = (f32x4){0.f, 0.f, 0.f, 0.f};
        if (OUT) {
            for (int gp = 0; gp < g; ++gp) { const int up = unit - g + gp;
#pragma unroll
                for (int t = 0; t < 4; ++t) { const f32x4 dc = *(const f32x4*)(GDEC + (size_t)up * 64 + 16 * t + 4 * q);
#pragma unroll
                    for (int rg = 0; rg < 4; ++rg) S[t][rg] = dc[rg] * S[t][rg] + SLOC[((size_t)up * 64 + 16 * t + 4 * q + rg) * 128 + 16 * w + L]; } }
        }
        float gtot = 0.f;
#pragma unroll 1
        for (int c = 0; c < GLA_GRP; ++c) {
            const int t0 = b * SEQ + (g * GLA_GRP + c) * GCH;
            float p[8];
            { float run = 0.f;
#pragma unroll
              for (int ii = 0; ii < 8; ++ii) { const float* ar = GA + (size_t)(t0 + 8 * w + ii) * 16; float u = ba_d;
#pragma unroll
                  for (int r = 0; r < GRANK; ++r) u += ar[r] * w2r[r];
                  const float ls = fminf(u, 0.f) - log1pf(__expf(-fabsf(u)));
                  run += ls * (1.f / 16.f); p[ii] = run; }
              *(LAS float*)(L0 + GL_SEG + (w * 64 + d_) * 4) = run; }
            __syncthreads();
            { float off = 0.f, tot = 0.f;
#pragma unroll
              for (int sg = 0; sg < 8; ++sg) { const float v = *(LAS float*)(L0 + GL_SEG + (sg * 64 + d_) * 4); off += (sg < w) ? v : 0.f; tot += v; }
#pragma unroll
              for (int ii = 0; ii < 8; ++ii) *(LAS float*)(L0 + GL_LA + ((8 * w + ii) * 64 + d_) * 4) = off + p[ii];
              if (w == 0) { *(LAS float*)(L0 + GL_BEND + d_ * 4) = tot; *(LAS float*)(L0 + GL_DEC + d_ * 4) = __expf(tot); gtot += tot; } }
            __syncthreads();
            { const int ip = tid >> 4, c4 = tid & 15; const f32x4 be = *(LAS f32x4*)(L0 + GL_BEND + 16 * c4);
              float ke[2][4];
#pragma unroll
              for (int rr = 0; rr < 2; ++rr) { const int i = 2 * ip + rr; const f32x4 bb = *(LAS f32x4*)(L0 + GL_LA + (i * 64 + 4 * c4) * 4);
                  const u32x2 kr = *(const u32x2*)(GK + (size_t)(t0 + i) * 256 + h * 64 + 4 * c4);
                  const float k0 = bf2f(kr.x & 0xffffu), k1 = bf2f(kr.x >> 16), k2 = bf2f(kr.y & 0xffffu), k3 = bf2f(kr.y >> 16);
                  ke[rr][0] = k0 * __expf(be[0] - bb[0]); ke[rr][1] = k1 * __expf(be[1] - bb[1]); ke[rr][2] = k2 * __expf(be[2] - bb[2]); ke[rr][3] = k3 * __expf(be[3] - bb[3]);
                  if (OUT) { const u32x2 qr = *(const u32x2*)(GQ + (size_t)(t0 + i) * 256 + h * 64 + 4 * c4);
                      const float e0 = __expf(bb[0]), e1 = __expf(bb[1]), e2 = __expf(bb[2]), e3 = __expf(bb[3]);
                      u32x2 o; o.x = pk2(bf2f(qr.x & 0xffffu) * e0, bf2f(qr.x >> 16) * e1); o.y = pk2(bf2f(qr.y & 0xffffu) * e2, bf2f(qr.y >> 16) * e3);
                      *(LAS u32x2*)(L0 + GL_QD + i * GL_P + 8 * c4) = o;
                      u32x2 o2; o2.x = pk2(k0 * __builtin_amdgcn_rcpf(e0), k1 * __builtin_amdgcn_rcpf(e1)); o2.y = pk2(k2 * __builtin_amdgcn_rcpf(e2), k3 * __builtin_amdgcn_rcpf(e3));
                      *(LAS u32x2*)(L0 + GL_KI + i * GL_P + 8 * c4) = o2; } }
#pragma unroll
              for (int dd = 0; dd < 4; ++dd) *(LAS unsigned*)(L0 + GL_KET + (4 * c4 + dd) * GL_P + 4 * ip) = pk2(ke[0][dd], ke[1][dd]);
              const u32x4 v0 = *(const u32x4*)(GV + (size_t)(t0 + 2 * ip) * 512 + h * 128 + 8 * c4), v1 = *(const u32x4*)(GV + (size_t)(t0 + 2 * ip + 1) * 512 + h * 128 + 8 * c4);
#pragma unroll
              for (int x = 0; x < 4; ++x) { *(LAS unsigned*)(L0 + GL_VT + (8 * c4 + 2 * x) * GL_P + 4 * ip) = (v0[x] & 0xffffu) | (v1[x] << 16);
                  *(LAS unsigned*)(L0 + GL_VT + (8 * c4 + 2 * x + 1) * GL_P + 4 * ip) = (v0[x] >> 16) | (v1[x] & 0xffff0000u); } }
            __syncthreads();
            f32x4 ao[4];
            if (OUT) {
#pragma unroll
                for (int tt = 0; tt < 2; ++tt) { const int idx = w + 8 * tt, it = idx >> 2, jt = idx & 3; f32x4 a4 = (f32x4){0.f, 0.f, 0.f, 0.f};
#pragma unroll
                    for (int s2 = 0; s2 < 2; ++s2) { const pg::bf16x8 ka = *(const LAS pg::bf16x8*)(L0 + GL_KI + (16 * jt + L) * GL_P + (32 * s2 + 8 * q) * 2), qb = *(const LAS pg::bf16x8*)(L0 + GL_QD + (16 * it + L) * GL_P + (32 * s2 + 8 * q) * 2);
                        a4 = __builtin_amdgcn_mfma_f32_16x16x32_bf16(ka, qb, a4, 0, 0, 0); }
                    const int i = 16 * it + L, j0 = 16 * jt + 4 * q;
                    u32x2 o; o.x = pk2(j0 + 0 <= i ? a4[0] : 0.f, j0 + 1 <= i ? a4[1] : 0.f); o.y = pk2(j0 + 2 <= i ? a4[2] : 0.f, j0 + 3 <= i ? a4[3] : 0.f);
                    *(LAS u32x2*)(L0 + GL_ATT + i * GL_P + j0 * 2) = o; }
                __syncthreads();
#pragma unroll
                for (int it = 0; it < 4; ++it) ao[it] = (f32x4){0.f, 0.f, 0.f, 0.f};
#pragma unroll
                for (int s2 = 0; s2 < 2; ++s2) { u32x4 sb; sb.x = pk2(S[2 * s2][0], S[2 * s2][1]); sb.y = pk2(S[2 * s2][2], S[2 * s2][3]); sb.z = pk2(S[2 * s2 + 1][0], S[2 * s2 + 1][1]); sb.w = pk2(S[2 * s2 + 1][2], S[2 * s2 + 1][3]);
                    const pg::bf16x8 bS = __builtin_bit_cast(pg::bf16x8, sb);
#pragma unroll
                    for (int it = 0; it < 4; ++it) { const u32x2 x0 = *(const LAS u32x2*)(L0 + GL_QD + (16 * it + L) * GL_P + (32 * s2 + 4 * q) * 2), x1 = *(const LAS u32x2*)(L0 + GL_QD + (16 * it + L) * GL_P + (32 * s2 + 16 + 4 * q) * 2);
                        u32x4 xa; xa.x = x0.x; xa.y = x0.y; xa.z = x1.x; xa.w = x1.y;
                        ao[it] = __builtin_amdgcn_mfma_f32_16x16x32_bf16(__builtin_bit_cast(pg::bf16x8, xa), bS, ao[it], 0, 0, 0); } }
            }
#pragma unroll
            for (int t = 0; t < 4; ++t) { const f32x4 dc = *(LAS f32x4*)(L0 + GL_DEC + (16 * t + 4 * q) * 4); S[t] = S[t] * dc; }
#pragma unroll
            for (int s2 = 0; s2 < 2; ++s2) { const pg::bf16x8 bV = *(const LAS pg::bf16x8*)(L0 + GL_VT + (16 * w + L) * GL_P + (32 * s2 + 8 * q) * 2);
                if (OUT) {
#pragma unroll
                    for (int it = 0; it < 4; ++it) { const pg::bf16x8 aa = *(const LAS pg::bf16x8*)(L0 + GL_ATT + (16 * it + L) * GL_P + (32 * s2 + 8 * q) * 2);
                        ao[it] = __builtin_amdgcn_mfma_f32_16x16x32_bf16(aa, bV, ao[it], 0, 0, 0); } }
#pragma unroll
                for (int t = 0; t < 4; ++t) { const pg::bf16x8 ka = *(const LAS pg::bf16x8*)(L0 + GL_KET + (16 * t + L) * GL_P + (32 * s2 + 8 * q) * 2);
                    S[t] = __builtin_amdgcn_mfma_f32_16x16x32_bf16(ka, bV, S[t], 0, 0, 0); } }
            if (OUT) {
#pragma unroll
                for (int it = 0; it < 4; ++it)
#pragma unroll
                    for (int rg = 0; rg < 4; ++rg) *(LAS float*)(L0 + GL_OB + ((16 * it + 4 * q + rg) * 132 + 16 * w + L) * 4) = ao[it][rg];
                __syncthreads();
                { const int i = tid >> 3, c8 = tid & 7; f32x4 ov[4]; float ss = 0.f;
#pragma unroll
                  for (int x = 0; x < 4; ++x) { ov[x] = *(LAS f32x4*)(L0 + GL_OB + (i * 132 + 16 * c8 + 4 * x) * 4); ss += (ov[x][0] * ov[x][0] + ov[x][1] * ov[x][1]) + (ov[x][2] * ov[x][2] + ov[x][3] * ov[x][3]); }
                  ss += shx(ss, 1, lane); ss += shx(ss, 2, lane); ss += shx(ss, 4, lane);
                  const float rstd = 1.0f / sqrtf(ss * (1.f / 128.f) + EPS);
                  const size_t go = (size_t)(t0 + i) * 512 + h * 128 + 16 * c8;
#pragma unroll
                  for (int hh = 0; hh < 2; ++hh) { const u32x4 rr = *(const u32x4*)(GR + go + 8 * hh); const f32x4 g0 = *(const f32x4*)(gn + h * 128 + 16 * c8 + 8 * hh), g1 = *(const f32x4*)(gn + h * 128 + 16 * c8 + 8 * hh + 4);
                      const f32x4 a = ov[2 * hh], bq = ov[2 * hh + 1]; u32x4 o;
                      o.x = pk2(a[0] * rstd * g0[0] * bf2f(rr.x & 0xffffu), a[1] * rstd * g0[1] * bf2f(rr.x >> 16)); o.y = pk2(a[2] * rstd * g0[2] * bf2f(rr.y & 0xffffu), a[3] * rstd * g0[3] * bf2f(rr.y >> 16));
                      o.z = pk2(bq[0] * rstd * g1[0] * bf2f(rr.z & 0xffffu), bq[1] * rstd * g1[1] * bf2f(rr.z >> 16)); o.w = pk2(bq[2] * rstd * g1[2] * bf2f(rr.w & 0xffffu), bq[3] * rstd * g1[3] * bf2f(rr.w >> 16));
                      *(u32x4*)(GO + go + 8 * hh) = o; } }
            }
        }
        if (!OUT) {
#pragma unroll
            for (int t = 0; t < 4; ++t)
#pragma unroll
                for (int rg = 0; rg < 4; ++rg) SLOC[((size_t)unit * 64 + 16 * t + 4 * q + rg) * 128 + 16 * w + L] = S[t][rg];
            if (w == 0) GDEC[(size_t)unit * 64 + d_] = __expf(gtot);
        }
        __syncthreads();
        }
    }
}


__device__ __forceinline__ void ph_mod(const Frame& F) {
    LAS float* cond = (LAS float*)F.lds;
    LAS float* part = cond + BATCH * D;
    for (int i = F.tid; i < BATCH * D; i += NTHREADS) cond[i] = siluf_(F.in(I_C)[i]);
    __syncthreads();
    float* mod = (float*)(F.ws() + WS_MOD);
    for (int item = F.bid; item < DEPTH * 96; item += F.G) {
        const int l = item / 96, j = (item % 96) * 64 + F.lane, k0 = F.wave * 128;
        float acc[BATCH];
#pragma unroll
        for (int b = 0; b < BATCH; ++b) acc[b] = 0.f;
        const float* w = F.in(I_WADA) + ((size_t)l * D + k0) * 6 * D + j;
#pragma unroll 8
        for (int k = 0; k < 128; ++k) { const float wv = w[(size_t)k * 6 * D];
#pragma unroll
            for (int b = 0; b < BATCH; ++b) acc[b] += cond[b * D + k0 + k] * wv; }
#pragma unroll
        for (int b = 0; b < BATCH; ++b) part[(F.wave * BATCH + b) * 64 + F.lane] = acc[b];
        __syncthreads();
        { const int b = F.wave; float sum = F.in(I_BADA)[l * 6 * D + j];
#pragma unroll
          for (int ww = 0; ww < NWAVES; ++ww) sum += part[(ww * BATCH + b) * 64 + F.lane];
          mod[(size_t)(l * BATCH + b) * 6 * D + j] = sum; }
        __syncthreads();
    }
}

template <bool ROUTE, bool COMBINE, bool NORM>
__device__ __forceinline__ void ph_rows(const Frame& F, int l, int lc, const float* xin, const float* gain, int ch_sh, int ch_sc) {
    bf16* H = (bf16*)(F.ws() + WS_H);
    const bf16* Y0 = (const bf16*)(F.ws() + WS_Y0); const bf16* Y1 = (const bf16*)(F.ws() + WS_Y1); float* xo = F.out();
    const int lane = F.lane;
    const int NGW = F.G * NWAVES;
    for (int blk = F.bid * NWAVES + F.wave; blk < T / 32; blk += NGW) {
        const int m0 = blk * 32, b = m0 / SEQ;
        f32x4 ga[4], sh4[4], g2v[4];
#pragma unroll
        for (int j = 0; j < 4; ++j) { const int col = 4 * lane + 256 * j;
            if (NORM) { const f32x4 g = *(const f32x4*)(gain + col), s4 = *(const f32x4*)(mod_ptr(F, l, b, ch_sc) + col); ga[j] = g * (s4 + 1.f); sh4[j] = *(const f32x4*)(mod_ptr(F, l, b, ch_sh) + col); }
            if (COMBINE) g2v[j] = *(const f32x4*)(mod_ptr(F, lc, b, 5) + col); }
#pragma unroll 1
        for (int r0 = 0; r0 < 32; r0 += 4) {
            f32x4 v[4][4];
#pragma unroll
            for (int rr = 0; rr < 4; ++rr)
#pragma unroll
                for (int j = 0; j < 4; ++j) v[rr][j] = *(const f32x4*)(xin + (size_t)(m0 + r0 + rr) * D + 4 * lane + 256 * j);
            if (COMBINE) {
#pragma unroll
                for (int rr = 0; rr < 4; ++rr)
#pragma unroll
                    for (int j = 0; j < 4; ++j) { const size_t o = (size_t)(m0 + r0 + rr) * D + 4 * lane + 256 * j;
                        const unsigned long long a = *(const unsigned long long*)(Y0 + o), c = *(const unsigned long long*)(Y1 + o);
                        v[rr][j].x += g2v[j].x * (bf2f((unsigned)a & 0xffffu) + bf2f((unsigned)c & 0xffffu)); v[rr][j].y += g2v[j].y * (bf2f(((unsigned)a) >> 16) + bf2f(((unsigned)c) >> 16));
                        v[rr][j].z += g2v[j].z * (bf2f((unsigned)(a >> 32) & 0xffffu) + bf2f((unsigned)(c >> 32) & 0xffffu)); v[rr][j].w += g2v[j].w * (bf2f((unsigned)(a >> 48)) + bf2f((unsigned)(c >> 48)));
                        *(f32x4*)(xo + o) = v[rr][j]; }
            }
            if (NORM) {
                float ss[4];
#pragma unroll
                for (int rr = 0; rr < 4; ++rr) { float s = 0.f;
#pragma unroll
                    for (int j = 0; j < 4; ++j) s += (v[rr][j].x * v[rr][j].x + v[rr][j].y * v[rr][j].y) + (v[rr][j].z * v[rr][j].z + v[rr][j].w * v[rr][j].w);
                    ss[rr] = s; }
#pragma unroll
                for (int o = 1; o < 64; o <<= 1) {
#pragma unroll
                    for (int rr = 0; rr < 4; ++rr) ss[rr] += shx(ss[rr], o, lane); }
#pragma unroll
                for (int rr = 0; rr < 4; ++rr) { const float rstd = 1.0f / sqrtf(ss[rr] * (1.f / D) + EPS);
#pragma unroll
                    for (int j = 0; j < 4; ++j) { v[rr][j] = v[rr][j] * rstd * ga[j] + sh4[j];
                        const unsigned long long o = (unsigned long long)(f2bf(v[rr][j].x) | (f2bf(v[rr][j].y) << 16)) | ((unsigned long long)(f2bf(v[rr][j].z) | (f2bf(v[rr][j].w) << 16)) << 32);
                        *((unsigned long long*)(H + (size_t)(m0 + r0 + rr) * D + 4 * lane + 256 * j)) = o; } }
            }
            if (ROUTE) {
                float lg[64];
#pragma unroll
                for (int i = 0; i < 64; ++i) lg[i] = 0.f;
#pragma unroll
                for (int j = 0; j < 4; ++j)
#pragma unroll
                    for (int qq = 0; qq < 4; ++qq) { const f32x4* wr = (const f32x4*)(F.in(I_WR) + (size_t)(4 * lane + 256 * j + qq) * NE);
                        const f32x4 w0 = wr[0], w1 = wr[1], w2 = wr[2], w3 = wr[3];
#pragma unroll
                        for (int rr = 0; rr < 4; ++rr) { const float y = v[rr][j][qq];
#pragma unroll
                            for (int e = 0; e < 4; ++e) { lg[rr * 16 + e] += y * w0[e]; lg[rr * 16 + 4 + e] += y * w1[e]; lg[rr * 16 + 8 + e] += y * w2[e]; lg[rr * 16 + 12 + e] += y * w3[e]; } }
                        if (qq & 1) asm volatile("" ::: "memory"); }
#pragma unroll
                for (int st = 0; st < 6; ++st) { const int M = 32 >> st, N2 = 32 >> st; const bool up = (lane & M) != 0;
#pragma unroll
                    for (int i = 0; i < N2; ++i) { const float snd = up ? lg[i] : lg[N2 + i], kp = up ? lg[N2 + i] : lg[i]; lg[i] = kp + shx(snd, M, lane); } }
                const float mylog = lg[0];
                float aff[NE], sel[NE];
#pragma unroll
                for (int e = 0; e < NE; ++e) { const float lgt = __builtin_bit_cast(float, __builtin_amdgcn_ds_bpermute(((lane & 48) + e) << 2, __builtin_bit_cast(int, mylog))); aff[e] = sigmoidf_(lgt); sel[e] = aff[e] + F.in(I_BR)[e]; }
                float best = 0.f; int bg = 0; float s0 = 0.f, s1 = 0.f, s2 = 0.f, s3 = 0.f, a0 = 0.f, a1 = 0.f, a2 = 0.f, a3 = 0.f;
#pragma unroll
                for (int g = 0; g < 4; ++g) {
                    const float x0 = sel[4 * g], x1 = sel[4 * g + 1], x2 = sel[4 * g + 2], x3 = sel[4 * g + 3];
                    const float lo01 = fminf(x0, x1), hi01 = fmaxf(x0, x1), lo23 = fminf(x2, x3), hi23 = fmaxf(x2, x3);
                    const float sc_ = fmaxf(hi01, hi23) + fmaxf(fminf(hi01, hi23), fmaxf(lo01, lo23));
                    if (g == 0 || sc_ > best) { best = sc_; bg = g; s0 = x0; s1 = x1; s2 = x2; s3 = x3; a0 = aff[4 * g]; a1 = aff[4 * g + 1]; a2 = aff[4 * g + 2]; a3 = aff[4 * g + 3]; }
                }
                int i1 = 0; float m1 = s0; if (s1 > m1) { m1 = s1; i1 = 1; } if (s2 > m1) { m1 = s2; i1 = 2; } if (s3 > m1) { m1 = s3; i1 = 3; }
                int i2 = -1; float m2 = 0.f;
                if (i1 != 0) { m2 = s0; i2 = 0; }
                if (i1 != 1 && (i2 < 0 || s1 > m2)) { m2 = s1; i2 = 1; }
                if (i1 != 2 && (i2 < 0 || s2 > m2)) { m2 = s2; i2 = 2; }
                if (i1 != 3 && (i2 < 0 || s3 > m2)) { m2 = s3; i2 = 3; }
                const float w1 = i1 == 0 ? a0 : i1 == 1 ? a1 : i1 == 2 ? a2 : a3;
                const float w2 = i2 == 0 ? a0 : i2 == 1 ? a1 : i2 == 2 ? a2 : a3;
                const float inv = 1.f / (w1 + w2);
                if ((lane & 15) == 0) {
                    const int m = m0 + r0 + (lane >> 4);
                    unsigned* cnt = (unsigned*)(F.ws() + WS_CTL) + CW_CNT + 64 * (NE * l);
                    int* tokl = (int*)(F.ws() + WS_TOKL); float* wl = (float*)(F.ws() + WS_WL);
                    const int e1 = bg * 4 + i1, e2 = bg * 4 + i2;
                    const unsigned p1 = atomicAdd(&cnt[64 * e1], 1u); tokl[(size_t)e1 * ECAP + p1] = 2 * m; wl[(size_t)e1 * ECAP + p1] = w1 * inv;
                    const unsigned p2 = atomicAdd(&cnt[64 * e2], 1u); tokl[(size_t)e2 * ECAP + p2] = 2 * m + 1; wl[(size_t)e2 * ECAP + p2] = w2 * inv;
                }
            }
        }
    }
}

constexpr int NPH_LAYER = 9, NPHASES = 2 + DEPTH * NPH_LAYER;
__global__ void __launch_bounds__(NTHREADS, 2) fwd(Args args) {
    extern __shared__ __attribute__((aligned(16))) unsigned char lds[];
    Frame F;
    F.lds = (LAS unsigned char*)lds; F.tid = threadIdx.x; F.lane = F.tid & 63; F.wave = __builtin_amdgcn_readfirstlane(F.tid >> 6);
    F.G = gridDim.x; F.bid = blockIdx.x;
    volatile LAS unsigned* MISC = (volatile LAS unsigned*)(F.lds + MISC_OFF);
    if (F.tid < 32) MISC[F.tid] = 0u;
    if (F.tid == 0) { volatile LAS unsigned long long* tb = (volatile LAS unsigned long long*)(F.lds + PTR_OFF);
#pragma unroll
        for (int i = 0; i < 22; ++i) tb[i] = (unsigned long long)args.in[i];
        tb[22] = (unsigned long long)args.out; tb[23] = (unsigned long long)args.ws; }
    __syncthreads();
    XcdBarrier bar; bar.bar = (unsigned*)(F.ws() + WS_CTL) + CW_BAR; bar.x = 0; bar.st = nullptr;
#if !MK_PER_PHASE
    bar = xcd_barrier_post((unsigned*)(F.ws() + WS_CTL) + CW_BAR, MISC + 8);
#endif
    const int lo = args.ph_lo, hi = args.ph_hi;
#define IN(k) (lo <= (k) && (k) < hi)
#define SEAM(k) do { if (IN(k) && IN((k) + 1)) xcd_barrier(bar); } while (0)
#define REP(k) for (int rep_ = 0; rep_ < (((MK_REPEAT >> (k)) & 1u) ? 2 : 1); ++rep_)
    if (IN(0)) { REP(0) { ph_mod(phase_frame(F)); } REP(1) { ph_weights(phase_frame(F)); ph_rope_table(phase_frame(F)); } } SEAM(0);
    for (int l = 0; l < DEPTH; ++l) {
        const int p0 = 1 + l * NPH_LAYER;
        const float* xin = l == 0 ? F.in(I_X) : F.out();
        if (IN(p0 + 0)) { if (l == 0) { REP(2) ph_rows<false, false, true>(phase_frame(F), l, 0, xin, F.in(I_NMIX) + l * D, 0, 1); } else ph_rows<false, true, true>(phase_frame(F), l, l - 1, xin, F.in(I_NMIX) + l * D, 0, 1); } SEAM(p0 + 0);
        if (IN(p0 + 1)) { if ((MK_REPEAT >> 12) & 1u) ph_gemm1_null(phase_frame(F), l); REP(3) ph_gemm1_mfma(phase_frame(F), l); } SEAM(p0 + 1);
        if (IN(p0 + 2)) { REP(4) ph_gla_mfma<false>(phase_frame(F), l); REP(5) ph_swa_mfma(phase_frame(F), l); } SEAM(p0 + 2);
        if (IN(p0 + 3)) REP(6) ph_gla_mfma<true>(phase_frame(F), l); SEAM(p0 + 3);
        if (IN(p0 + 4)) REP(7) ph_gemm2_mfma(phase_frame(F), l); SEAM(p0 + 4);
        if (IN(p0 + 5)) { if (l == 0) { REP(8) ph_gemm3_mfma(phase_frame(F), l, xin); } else ph_gemm3_mfma(phase_frame(F), l, xin); } SEAM(p0 + 5);
        if (IN(p0 + 6)) { if ((MK_REPEAT >> 13) & 1u) ph_rows<false, false, true>(phase_frame(F), l, 0, F.out(), F.in(I_NFFN) + l * D, 3, 4); ph_rows<true, false, true>(phase_frame(F), l, 0, F.out(), F.in(I_NFFN) + l * D, 3, 4); } SEAM(p0 + 6);
        if (IN(p0 + 7)) REP(9) ph_moe_up_mfma(phase_frame(F), l); SEAM(p0 + 7);
        if (IN(p0 + 8)) REP(10) ph_moe_down_mfma(phase_frame(F), l); SEAM(p0 + 8);
    }
    if (IN(NPHASES - 1)) { if ((MK_REPEAT >> 11) & 1u) { for (int xb = 0; xb < 16; ++xb) xcd_barrier(bar); } ph_rows<false, true, false>(phase_frame(F), 0, DEPTH - 1, F.out(), nullptr, 0, 0); }
#undef REP
#undef IN
#undef SEAM
}

extern "C" void kernel_launch(void* const* d_in, const int* in_sizes, int n_in, void* d_out, int out_size, void* d_ws, size_t ws_size, hipStream_t stream) {
    static int grid = 0;
    if (grid == 0) {
        if (n_in != 22 || in_sizes[0] != T * D || out_size != T * D || ws_size < WS_END) { fprintf(stderr, "kernel_launch: unexpected shapes: n_in %d in0 %d out %d ws %zu (need %zu)\n", n_in, n_in > 0 ? in_sizes[0] : -1, out_size, ws_size, (size_t)WS_END); grid = -1; return; }
        int dev = 0, cus = 0, per_cu = 0;
        if (hipGetDevice(&dev) != hipSuccess || hipDeviceGetAttribute(&cus, hipDeviceAttributeMultiprocessorCount, dev) != hipSuccess) { grid = -1; return; }
        if (hipFuncSetAttribute((const void*)fwd, hipFuncAttributeMaxDynamicSharedMemorySize, LDS_BYTES) != hipSuccess) { fprintf(stderr, "kernel_launch: hipFuncSetAttribute failed\n"); grid = -1; return; }
        if (hipOccupancyMaxActiveBlocksPerMultiprocessor(&per_cu, (const void*)fwd, NTHREADS, LDS_BYTES) != hipSuccess || per_cu < 1) fprintf(stderr, "kernel_launch: occupancy query reports %d\n", per_cu);
        (void)hipGetLastError();
        grid = cus;
    }
    if (grid < 0) return;
    if (hipMemsetAsync((char*)d_ws + WS_CTL, 0, CTL_ZERO_BYTES, stream) != hipSuccess) return;
    Args a{};
    for (int i = 0; i < 22; ++i) a.in[i] = (const float*)d_in[i];
    a.out = (float*)d_out; a.ws = (unsigned char*)d_ws;
#if MK_PER_PHASE
    for (int p = 0; p < NPHASES; ++p) { a.ph_lo = p; a.ph_hi = p + 1; hipLaunchKernelGGL(fwd, dim3(grid), dim3(NTHREADS), LDS_BYTES, stream, a); }
#else
    a.ph_lo = 0; a.ph_hi = NPHASES; hipLaunchKernelGGL(fwd, dim3(grid), dim3(NTHREADS), LDS_BYTES, stream, a);
#endif
}
```

```cpp
#include <hip/hip_runtime.h>
#include <cstdio>
#include <cstdint>

#ifndef MK_REPEAT
#define MK_REPEAT 0u
#endif
#ifndef MK_FP8_MOE
#define MK_FP8_MOE 3u
#endif
#ifndef MK_PER_PHASE
#define MK_PER_PHASE 0
#endif

constexpr int D = 1024, BATCH = 8, SEQ = 8192, T = BATCH * SEQ, DEPTH = 2;
constexpr int GH = 4, GDK = 64, GDV = 128, GRANK = 16, GCH = 64, NCH = SEQ / GCH;
constexpr int SH = 8, SKV = 2, SHD = 64, WIN = 128;
constexpr int NE = 16, DFF = 512, ECAP = T;
constexpr int INW = 4368, NIN = 768, NGATE = 3840;
constexpr int C_GQ = 0, C_GK = 256, C_GV = 512, C_GA = 1024, C_GR = 1040, C_SQ = 1552, C_SK = 2064, C_SV = 2192, C_MA = 2320, C_MB = 3344;
constexpr float EPS = 1e-6f;
constexpr int NTHREADS = 512, NWAVES = 8;

constexpr size_t MiB = 1u << 20;
constexpr size_t WS_CTL = 0, CTL_ZERO_BYTES = 2 * MiB;
constexpr size_t WS_MOD = 1 * MiB;
constexpr size_t WS_TOKL = 2 * MiB;
constexpr size_t WS_WL = 6 * MiB;
constexpr size_t WS_GA = 10 * MiB;
constexpr size_t WS_DECAY = 14 * MiB;
constexpr size_t WS_WRT = 15 * MiB;
constexpr size_t WS_TINFO = 6 * MiB;
constexpr size_t WS_WIN_T = 16 * MiB;
constexpr size_t WS_WG_T = 34 * MiB, WS_WS_T = 36 * MiB;
constexpr size_t WS_WOUT_T = 38 * MiB;
constexpr size_t WS_WGU_T = 42 * MiB;
constexpr size_t WS_WD_T = 106 * MiB;
constexpr size_t WS_H = 138 * MiB;
constexpr size_t WS_STATE = WS_H;
constexpr size_t WS_GQ = 266 * MiB, WS_GK = 298 * MiB, WS_GV = 330 * MiB;
constexpr size_t WS_MERGED = WS_GQ;
constexpr size_t WS_GR = 394 * MiB;
constexpr size_t WS_SQ = 458 * MiB;
constexpr size_t WS_SK = 522 * MiB, WS_SV = 538 * MiB;
constexpr size_t WS_MA = 554 * MiB, WS_MB = 682 * MiB;
constexpr size_t WS_ACT = WS_MA;
constexpr size_t WS_GLAO = 810 * MiB, WS_SWAO = 154 * MiB;
constexpr size_t WS_XB = 874 * MiB;
constexpr size_t WS_ACT8 = 554 * MiB;
constexpr size_t WS_H8 = 620 * MiB;
constexpr size_t WS_H8N = 810 * MiB;
constexpr size_t WS_YS = 266 * MiB;
constexpr size_t WS_Y0 = 266 * MiB, WS_Y1 = 394 * MiB;
constexpr size_t WS_LAH = 218 * MiB;
constexpr size_t WS_ROPE = 1002 * MiB;
constexpr size_t WS_END = 1006 * MiB;

constexpr int CW_BAR = 4096;
constexpr int CW_CNT = 16384;

#define GAS __attribute__((address_space(1)))
#define LAS __attribute__((address_space(3)))
typedef unsigned short bf16;
typedef float f32x4 __attribute__((ext_vector_type(4)));
typedef unsigned u32x4 __attribute__((ext_vector_type(4)));

__device__ __forceinline__ unsigned f2bf(float f) { unsigned u = __builtin_bit_cast(unsigned, f); return (u + 0x7fffu + ((u >> 16) & 1u)) >> 16; }
__device__ __forceinline__ float bf2f(unsigned h) { return __builtin_bit_cast(float, h << 16); }
__device__ __forceinline__ float sigmoidf_(float v) { return 1.f / (1.f + __expf(-v)); }
__device__ __forceinline__ float siluf_(float v) { return v / (1.f + __expf(-v)); }
__device__ __forceinline__ float shx(float v, int o, int lane) { return __builtin_bit_cast(float, __builtin_amdgcn_ds_bpermute((lane ^ o) << 2, __builtin_bit_cast(int, v))); }
__device__ __forceinline__ float wave_sum(float v, int lane) {
#pragma unroll
    for (int o = 1; o < 64; o <<= 1) v += shx(v, o, lane);
    return v;
}

#define XB_TMO      128
#define XB_XCNT(j)  (256  + 64 * (j))
#define XB_XSUB(j)  (1280 + 64 * (j))
#define XB_XGEN(j)  (2304 + 64 * (j))
#define XB_TOP      3328
#define XB_TOPGEN   3392
#define XCD_BAR_WORDS 3456
#define XB_SPIN_CAP (1u << 24)
__device__ __forceinline__ unsigned xb_ld(unsigned* p)              { return __hip_atomic_load(p, __ATOMIC_RELAXED, __HIP_MEMORY_SCOPE_AGENT); }
__device__ __forceinline__ unsigned xb_add(unsigned* p, unsigned v) { return __hip_atomic_fetch_add(p, v, __ATOMIC_RELAXED, __HIP_MEMORY_SCOPE_AGENT); }
__device__ __forceinline__ unsigned xb_xcc_id() { return (unsigned)__builtin_amdgcn_s_getreg((3 << 11) | 20) & 0xFu; }
#define XB_SPIN(cond, bar) do { unsigned _sp = 0; while (cond) { __builtin_amdgcn_s_sleep(1); \
    if ((++_sp & 255u) == 0u) { if (xb_ld(&(bar)[XB_TMO])) break; if (_sp > XB_SPIN_CAP) { atomicAdd(&(bar)[XB_TMO], 1u); break; } } } } while (0)
struct XcdBarrier { unsigned* bar; unsigned x; volatile LAS unsigned* st; unsigned wave; };
__device__ __forceinline__ bool xb_thread0(unsigned wave) { unsigned z = 0u; asm volatile("" : "+v"(z)); return wave == 0u && __builtin_amdgcn_mbcnt_hi(~0u, __builtin_amdgcn_mbcnt_lo(~0u, z)) == 0u; }
__device__ __forceinline__ XcdBarrier xcd_barrier_post(unsigned* bar, volatile LAS unsigned* st, unsigned wave) {
    XcdBarrier b; b.bar = bar; b.x = xb_xcc_id(); b.st = st; b.wave = wave;
    if (xb_thread0(wave)) (void)xb_add(&bar[XB_XCNT(b.x)], 1u);
    return b;
}
__device__ __forceinline__ void xcd_barrier_complete(unsigned* bar, unsigned x, unsigned& nloc, unsigned& nx) {
    const unsigned G = gridDim.x * gridDim.y * gridDim.z;
    unsigned sum, cnt, mine, sp = 0u;
    for (;;) {
        sum = 0u; cnt = 0u; mine = 0u;
#pragma unroll
        for (unsigned j = 0; j < 16; ++j) { const unsigned c = xb_ld(&bar[XB_XCNT(j)]); sum += c; cnt += (c > 0u) ? 1u : 0u; mine = (j == x) ? c : mine; }
        if (sum == G) break;
        __builtin_amdgcn_s_sleep(1);
        if ((++sp & 255u) == 0u) { if (xb_ld(&bar[XB_TMO])) break; if (sp > XB_SPIN_CAP) { atomicAdd(&bar[XB_TMO], 1u); break; } }
    }
    nloc = mine > 0u ? mine : 1u; nx = cnt > 0u ? cnt : 1u;
}
__device__ __forceinline__ void xcd_barrier(const XcdBarrier& b) {
    asm volatile("s_waitcnt vmcnt(0)" ::: "memory");
    __syncthreads();
    if (xb_thread0(b.wave)) {
        unsigned* bar = b.bar;
        __builtin_amdgcn_s_waitcnt(0);
        unsigned nloc = b.st[0], nx = b.st[1];
        if (nloc == 0u) { xcd_barrier_complete(bar, b.x, nloc, nx); b.st[0] = nloc; b.st[1] = nx; }
        const unsigned old = xb_add(&bar[XB_XSUB(b.x)], 1u);
        const unsigned gen = old / nloc;
        if (old + 1u == (gen + 1u) * nloc) {
            __builtin_amdgcn_fence(__ATOMIC_RELEASE, "agent");
            asm volatile("s_waitcnt vmcnt(0)" ::: "memory");
            const unsigned og = xb_add(&bar[XB_TOP], 1u);
            const unsigned tg = og / nx;
            if (og + 1u == (tg + 1u) * nx) xb_add(&bar[XB_TOPGEN], 1u);
            else XB_SPIN(xb_ld(&bar[XB_TOPGEN]) == tg, bar);
            __builtin_amdgcn_fence(__ATOMIC_ACQUIRE, "agent");
            xb_add(&bar[XB_XGEN(b.x)], 1u);
            asm volatile("s_waitcnt vmcnt(0)" ::: "memory");
        } else {
            XB_SPIN(xb_ld(&bar[XB_XGEN(b.x)]) == gen, bar);
            __builtin_amdgcn_fence(__ATOMIC_ACQUIRE, "agent");
            asm volatile("s_waitcnt vmcnt(0)" ::: "memory");
        }
    }
    __syncthreads();
}

constexpr int LDS_BYTES = 147456;
constexpr int MISC_OFF = 131072 + 320;

struct Args { const float* in[22]; float* out; unsigned char* ws; int ph_lo, ph_hi; };

constexpr int PTR_OFF = MISC_OFF + 128;
struct Frame {
    LAS unsigned char* lds;
    int tid, lane, wave, G, bid;
    __device__ __forceinline__ unsigned long long ptr(int i) const {
        const unsigned long long v = ((volatile LAS unsigned long long*)(lds + PTR_OFF))[i];
        const unsigned lo = __builtin_amdgcn_readfirstlane((unsigned)v), hi = __builtin_amdgcn_readfirstlane((unsigned)(v >> 32));
        return ((unsigned long long)hi << 32) | lo;
    }
    __device__ __forceinline__ const float* in(int i) const { return (const float*)(const GAS float*)ptr(i); }
    __device__ __forceinline__ float* out() const { return (float*)(GAS float*)ptr(22); }
    __device__ __forceinline__ unsigned char* ws() const { return (unsigned char*)(GAS unsigned char*)ptr(23); }
};
__device__ __forceinline__ Frame phase_frame(const Frame& F) {
    Frame P = F; unsigned l = (unsigned)(unsigned long long)P.lds;
    asm volatile("" : "+s"(P.wave), "+s"(P.G), "+s"(P.bid), "+s"(l));
    unsigned z_ = 0u; asm volatile("" : "+v"(z_));
    P.lane = (int)__builtin_amdgcn_mbcnt_hi(~0u, __builtin_amdgcn_mbcnt_lo(~0u, z_));
    P.tid = P.wave * 64 + P.lane;
    asm volatile("" : "+v"(P.tid), "+v"(P.lane));
    P.lds = (LAS unsigned char*)(unsigned long long)l; return P;
}
enum { I_X = 0, I_C, I_POS, I_WADA, I_BADA, I_NMIX, I_WIN, I_WA2, I_BA, I_GNORM, I_QN, I_KN, I_SINK, I_WUG, I_WUS, I_WOUT, I_NFFN, I_WR, I_BR, I_WGATE, I_WUP, I_WDOWN };

__device__ __forceinline__ const float* mod_ptr(const Frame& F, int l, int b, int chunk) { return (const float*)(F.ws() + WS_MOD) + ((size_t)(l * BATCH + b) * 6 + chunk) * D; }
namespace pg {
typedef short bf16x8 __attribute__((ext_vector_type(8)));
constexpr int BM = 256, BK = 64, HALF = 128, HTB = HALF * BK * 2, STAGE_BYTES = 8 * HTB;
__host__ __device__ __forceinline__ int lds_byte(int r, int c) { const int st = (r >> 4) * 2 + (c >> 5), rr = r & 15, cc = c & 31, ob = rr * 64 + cc * 2; return st * 1024 + (ob ^ (((ob >> 9) & 1) << 5)); }
__host__ __device__ __forceinline__ void stage_rc(int b, int& R, int& C) { const int st = b / 1024, sb = b % 1024, swz = sb ^ (((sb >> 9) & 1) << 5); R = (st >> 1) * 16 + swz / 64; C = (st & 1) * 32 + (swz % 64) / 2; }
__host__ __device__ __forceinline__ int perm32(int rho) { const int n = rho >> 4, i = rho & 15; return 8 * (i >> 2) + 4 * n + (i & 3); }
typedef int i32x4 __attribute__((ext_vector_type(4)));
typedef int i32x8 __attribute__((ext_vector_type(8)));
__device__ __forceinline__ i32x8 pg_cat(bf16x8 lo, bf16x8 hi) { const i32x4 a = __builtin_bit_cast(i32x4, lo), b = __builtin_bit_cast(i32x4, hi); return __builtin_shufflevector(a, b, 0, 1, 2, 3, 4, 5, 6, 7); }
struct Unit { const char* A; const char* B; int pm, pn, e, j, valid, keep; };
__device__ __forceinline__ unsigned cvt_pk_bf16(float lo, float hi) { unsigned r; asm volatile("v_cvt_pk_bf16_f32 %0, %1, %2" : "=v"(r) : "v"(lo), "v"(hi)); return r; }

template <bool GATHER, bool FP8, class Epi, class Sched>
__device__ __forceinline__ void gemm_phase(LAS unsigned char* lds, const int tid, const int K, const Sched& S, const Epi& E) {
    const int wid = __builtin_amdgcn_readfirstlane(tid >> 6), lane = tid & 63, wr = wid >> 2, wc = wid & 3, fr = lane & 15, fq = lane >> 4;
    const int nt = K / BK;
    int RA[2], CA[2]; unsigned voffB[2];
#pragma unroll
    for (int i = 0; i < 2; ++i) { int R, C; stage_rc(tid * 16 + i * 8192, R, C); const int Rb = (R & ~31) + perm32(R & 31); RA[i] = R; CA[i] = C * 2; voffB[i] = (unsigned)(Rb * K + C) * 2u; }
    const size_t kstep = (size_t)(BK * 2);
    const size_t hstep = (size_t)HALF * K * 2;
    const unsigned ldsw = (unsigned)wid * 1024u;
    const int aoff = lds_byte(wr * 64 + fr, fq * 8), boff = lds_byte(wc * 32 + fr, fq * 8);
#define PG_SA(b, h) (((b) * 2 + (h)) * HTB)
#define PG_SB(b, h) ((4 + (b) * 2 + (h)) * HTB)
#define PG_STAGEB(bufoff, gbase) do { _Pragma("unroll") for (int _i = 0; _i < 2; ++_i) { unsigned _o = voffB[_i]; asm volatile("" : "+v"(_o)); \
        __builtin_amdgcn_global_load_lds((const unsigned*)((const char*)(gbase) + _o), (LAS unsigned*)(lds + (bufoff) + ldsw + _i * 8192), 16, 0, 0); } } while (0)
#define PG_STAGEA(bufoff, gbase, o0, o1) do { unsigned _o0 = (o0), _o1 = (o1); asm volatile("" : "+v"(_o0), "+v"(_o1)); \
        __builtin_amdgcn_global_load_lds((const unsigned*)((const char*)(gbase) + _o0), (LAS unsigned*)(lds + (bufoff) + ldsw), 16, 0, 0); \
        __builtin_amdgcn_global_load_lds((const unsigned*)((const char*)(gbase) + _o1), (LAS unsigned*)(lds + (bufoff) + ldsw + 8192), 16, 0, 0); } while (0)
#define PG_LDA(dst, b, h) do { _Pragma("unroll") for (int m = 0; m < 4; ++m) { const i32x4 lo_ = *(const LAS i32x4*)(lds + PG_SA(b, h) + aoff + m * 2048), hi_ = *(const LAS i32x4*)(lds + PG_SA(b, h) + aoff + m * 2048 + 1024); \
        dst[m] = __builtin_shufflevector(lo_, hi_, 0, 1, 2, 3, 4, 5, 6, 7); } } while (0)
#define PG_LDB(dst, b, h) do { _Pragma("unroll") for (int n = 0; n < 2; ++n) { const i32x4 lo_ = *(const LAS i32x4*)(lds + PG_SB(b, h) + boff + n * 2048), hi_ = *(const LAS i32x4*)(lds + PG_SB(b, h) + boff + n * 2048 + 1024); \
        dst[n] = __builtin_shufflevector(lo_, hi_, 0, 1, 2, 3, 4, 5, 6, 7); } } while (0)
#define PG_HALF(v, k) __builtin_bit_cast(bf16x8, (k) ? __builtin_shufflevector(v, v, 4, 5, 6, 7) : __builtin_shufflevector(v, v, 0, 1, 2, 3))
#define PG_MMA(ai, bj, At, Bt) do { __builtin_amdgcn_s_setprio(1); _Pragma("unroll") for (int m = 0; m < 4; ++m) _Pragma("unroll") for (int n = 0; n < 2; ++n) { \
        if (FP8) { acc[ai][bj][m][n] = __builtin_amdgcn_mfma_scale_f32_16x16x128_f8f6f4(Bt[n], At[m], acc[ai][bj][m][n], 0, 0, 0, 0, 0, 0); } \
        else { _Pragma("unroll") for (int k = 0; k < 2; ++k) acc[ai][bj][m][n] = __builtin_amdgcn_mfma_f32_16x16x32_bf16(PG_HALF(Bt[n], k), PG_HALF(At[m], k), acc[ai][bj][m][n], 0, 0, 0); } } \
        __builtin_amdgcn_s_setprio(0); } while (0)
#define PG_WAIT_V(n) asm volatile("s_waitcnt vmcnt(" #n ")" ::: "memory")
#define PG_WAIT_L(n) asm volatile("s_waitcnt lgkmcnt(" #n ")" ::: "memory")
#define PG_BAR __builtin_amdgcn_s_barrier()
#define PG_SCHED __builtin_amdgcn_sched_barrier(0)
    Unit cur, nxt; int ui = 0;
    if (!S.next(0, cur)) return;
    f32x4 acc[2][2][4][2];
#pragma unroll
    for (int a = 0; a < 2; ++a)
#pragma unroll
        for (int b = 0; b < 2; ++b)
#pragma unroll
            for (int m = 0; m < 4; ++m)
#pragma unroll
                for (int n = 0; n < 2; ++n) acc[a][b][m][n] = (f32x4){0.f, 0.f, 0.f, 0.f};
    i32x8 At[4], B0[2], B1[2];
    unsigned vA0, vA1, vA2, vA3, vN0, vN1, vN2, vN3;
    if (GATHER) { vA0 = S.rowoff(cur, RA[0]) + CA[0]; vA1 = S.rowoff(cur, RA[1]) + CA[1]; vA2 = S.rowoff(cur, HALF + RA[0]) + CA[0]; vA3 = S.rowoff(cur, HALF + RA[1]) + CA[1]; }
    else { vA0 = (unsigned)(RA[0] * K * 2 + CA[0]); vA1 = (unsigned)(RA[1] * K * 2 + CA[1]); vA2 = vA0; vA3 = vA1; }
    vN0 = vA0; vN1 = vA1; vN2 = vA2; vN3 = vA3;
    const size_t ah = GATHER ? (size_t)0 : hstep;
    const char* cA = cur.A; const char* cB = cur.B;
    PG_STAGEB(PG_SB(0, 0), cB); PG_STAGEB(PG_SB(0, 1), cB + hstep); PG_STAGEA(PG_SA(0, 0), cA, vA0, vA1); PG_STAGEA(PG_SA(0, 1), cA + ah, vA2, vA3);
    if (wr == 1) PG_BAR;
    PG_WAIT_V(2); PG_BAR;
    PG_STAGEB(PG_SB(1, 0), cB + kstep); PG_STAGEA(PG_SA(1, 0), cA + kstep, vA0, vA1); PG_STAGEB(PG_SB(1, 1), cB + hstep + kstep);
    PG_WAIT_V(6); PG_BAR;
    for (;;) {
        const bool has_next = S.next(ui + 1, nxt);
        const char* nA = has_next ? nxt.A : cA; const char* nB = has_next ? nxt.B : cB;
        if (GATHER) { if (has_next) { int t2 = tid; asm volatile("" : "+v"(t2)); int R0, C0, R1, C1; stage_rc(t2 * 16, R0, C0); stage_rc(t2 * 16 + 8192, R1, C1);
                vN0 = S.rowoff(nxt, R0) + 2 * C0; vN1 = S.rowoff(nxt, R1) + 2 * C1; vN2 = S.rowoff(nxt, HALF + R0) + 2 * C0; vN3 = S.rowoff(nxt, HALF + R1) + 2 * C1; }
            else { vN0 = vA0; vN1 = vA1; vN2 = vA2; vN3 = vA3; } }
#pragma unroll 1
        for (int t = 0; t < nt; t += 2) {
            const bool last = (t == nt - 2);
            const char* a1 = cA + (size_t)(t + 1) * kstep;
            const char* a2 = last ? nA : cA + (size_t)(t + 2) * kstep; const char* b2 = last ? nB : cB + (size_t)(t + 2) * kstep;
            const char* a3 = a2 + kstep; const char* b3 = b2 + kstep;
            PG_LDB(B0, 0, 0); PG_LDB(B1, 0, 1); PG_SCHED; PG_LDA(At, 0, 0); PG_STAGEA(PG_SA(1, 1), a1 + ah, vA2, vA3);
            if (GATHER && last) { vA0 = vN0; vA1 = vN1; vA2 = vN2; vA3 = vN3; }
            PG_WAIT_V(8); PG_WAIT_L(0); PG_BAR; PG_MMA(0, 0, At, B0); PG_MMA(0, 1, At, B1); PG_BAR; PG_SCHED;
            PG_LDA(At, 0, 1); PG_STAGEB(PG_SB(0, 0), b2); PG_STAGEB(PG_SB(0, 1), b2 + hstep); PG_STAGEA(PG_SA(0, 0), a2, vA0, vA1);
            PG_WAIT_V(8); PG_WAIT_L(0); PG_BAR; PG_MMA(1, 0, At, B0); PG_MMA(1, 1, At, B1); PG_BAR; PG_SCHED;
            PG_LDB(B0, 1, 0); PG_LDB(B1, 1, 1); PG_SCHED; PG_LDA(At, 1, 0); PG_STAGEA(PG_SA(0, 1), a2 + ah, vA2, vA3);
            PG_WAIT_V(8); PG_WAIT_L(0); PG_BAR; PG_MMA(0, 0, At, B0); PG_MMA(0, 1, At, B1); PG_BAR; PG_SCHED;
            PG_LDA(At, 1, 1); PG_STAGEB(PG_SB(1, 0), b3); PG_STAGEB(PG_SB(1, 1), b3 + hstep); PG_STAGEA(PG_SA(1, 0), a3, vA0, vA1);
            PG_WAIT_V(8); PG_WAIT_L(0); PG_BAR; PG_MMA(1, 0, At, B0); PG_MMA(1, 1, At, B1); PG_BAR; PG_SCHED;
        }
        if (wr == 0) PG_BAR;
        { unsigned z_ = 0u; asm volatile("" : "+v"(z_)); const int le_ = (int)__builtin_amdgcn_mbcnt_hi(~0u, __builtin_amdgcn_mbcnt_lo(~0u, z_));
          E(acc, cur, wr, wc, le_ & 15, le_ >> 4); }
        if (!has_next) break;
        if (!cur.keep) {
#pragma unroll
            for (int a = 0; a < 2; ++a)
#pragma unroll
                for (int b = 0; b < 2; ++b)
#pragma unroll
                    for (int m = 0; m < 4; ++m)
#pragma unroll
                        for (int n = 0; n < 2; ++n) acc[a][b][m][n] = (f32x4){0.f, 0.f, 0.f, 0.f};
        }
        cur = nxt; cA = nA; cB = nB; if (GATHER) { vA0 = vN0; vA1 = vN1; vA2 = vN2; vA3 = vN3; } ++ui;
        if (wr == 1) PG_BAR;
    }
    PG_WAIT_V(0);
    PG_BAR;
#undef PG_SA
#undef PG_SB
#undef PG_STAGEA
#undef PG_STAGEB
#undef PG_LDA
#undef PG_LDB
#undef PG_HALF
#undef PG_MMA
#undef PG_WAIT_V
#undef PG_WAIT_L
#undef PG_BAR
#undef PG_SCHED
}
struct DenseOrder {
    const char* A; const char* B; int K, nM, nN, nwg, G, c;
    __device__ __forceinline__ void init(const void* A_, const void* B_, int M, int N, int K_, int G_, int c_) { A = (const char*)A_; B = (const char*)B_; K = K_; nM = M / BM; nN = N / BM; nwg = nM * nN; G = G_; c = c_; }
    __device__ __forceinline__ bool tile(int i, int& pm, int& pn) const {
        const long L = (long)i * G + c; if (L >= nwg) return false;
        int wgid = (int)L; { const int q = nwg / 8, r = nwg % 8, xcd = wgid % 8, off = wgid / 8; wgid = (xcd < r ? xcd * (q + 1) : r * (q + 1) + (xcd - r) * q) + off; }
        const int nig = 8 * nN, gid = wgid / nig, fm = gid * 8, gsz = (nM - fm) < 8 ? (nM - fm) : 8;
        pm = fm + ((wgid % nig) % gsz); pn = (wgid % nig) / gsz; return true;
    }
    __device__ __forceinline__ bool next(int i, Unit& u) const {
        int pm, pn; if (!tile(i, pm, pn)) return false;
        u.pm = pm; u.pn = pn; u.e = 0; u.j = 0; u.valid = 256; u.keep = 0;
        u.A = A + (size_t)pm * BM * K * 2; u.B = B + (size_t)pn * BM * K * 2; return true;
    }
    __device__ __forceinline__ unsigned rowoff(const Unit&, int r) const { return (unsigned)(r * K * 2); }
};
template <int NM, int NN>
struct DenseOrderT {
    const char* A; const char* B; int K, G, c;
    __device__ __forceinline__ void init(const void* A_, const void* B_, int K_, int G_, int c_) { A = (const char*)A_; B = (const char*)B_; K = K_; G = G_; c = c_; }
    __device__ __forceinline__ bool tile(int i, int& pm, int& pn) const {
        constexpr int nwg = NM * NN; static_assert(nwg % 8 == 0 && NM % 8 == 0, "whole XCD chunks and whole 8-panel groups");
        const int L = i * G + c; if (L >= nwg) return false;
        const int wgid = (L % 8) * (nwg / 8) + L / 8;
        constexpr int nig = 8 * NN; const int gid = wgid / nig, rem = wgid % nig;
        pm = gid * 8 + (rem % 8); pn = rem / 8; return true;
    }
    __device__ __forceinline__ bool next(int i, Unit& u) const {
        int pm, pn; if (!tile(i, pm, pn)) return false;
        u.pm = pm; u.pn = pn; u.e = 0; u.j = 0; u.valid = 256; u.keep = 0;
        u.A = A + (size_t)pm * BM * K * 2; u.B = B + (size_t)pn * BM * K * 2; return true;
    }
    __device__ __forceinline__ unsigned rowoff(const Unit&, int r) const { return (unsigned)(r * K * 2); }
};
}

__device__ __forceinline__ unsigned pk2(float lo, float hi) { unsigned r; asm("v_cvt_pk_bf16_f32 %0, %1, %2" : "=v"(r) : "v"(lo), "v"(hi)); return r; }
__device__ __forceinline__ unsigned pk_fp8x4(float a, float b, float c, float d) {
    a = __builtin_amdgcn_fmed3f(a, -448.f, 448.f); b = __builtin_amdgcn_fmed3f(b, -448.f, 448.f); c = __builtin_amdgcn_fmed3f(c, -448.f, 448.f); d = __builtin_amdgcn_fmed3f(d, -448.f, 448.f);
    int p = __builtin_amdgcn_cvt_pk_fp8_f32(a, b, 0, false); p = __builtin_amdgcn_cvt_pk_fp8_f32(c, d, p, true); return (unsigned)p; }
static_assert(MK_FP8_MOE == 3u, "the fp8 gate weights of GEMM1 sit in the half of each layer's WGU_T slot that only an fp8 expert layer leaves free");
constexpr float F8_H = 8.f, F8_WGU = 128.f, F8_ACT = 4.f, F8_WD = 64.f;
__device__ __forceinline__ void tr_item8(const float* W, int ldw, int src_c0, int k0, unsigned char* WT0, int K, float scale, LAS float* scr, int lane) {
    float tv[32];
#pragma unroll
    for (int i = 0; i < 32; ++i) tv[i] = W[(size_t)(k0 + 2 * i + (lane >> 5)) * ldw + src_c0 + (lane & 31)];
#pragma unroll
    for (int i = 0; i < 32; ++i) scr[(2 * i + (lane >> 5)) * 33 + (lane & 31)] = tv[i] * scale;
    asm volatile("s_waitcnt lgkmcnt(0)" ::: "memory");
    const int c = lane & 7;
#pragma unroll
    for (int j = 0; j < 4; ++j) { const int n = (lane >> 3) + 8 * j; const LAS float* sp = scr + (8 * c) * 33 + n;
        typedef unsigned u32x2_ __attribute__((ext_vector_type(2)));
        u32x2_ o; o.x = pk_fp8x4(sp[0 * 33], sp[1 * 33], sp[2 * 33], sp[3 * 33]); o.y = pk_fp8x4(sp[4 * 33], sp[5 * 33], sp[6 * 33], sp[7 * 33]);
        *(u32x2_*)(WT0 + (size_t)n * K + 8 * c) = o; }
    asm volatile("s_waitcnt lgkmcnt(0)" ::: "memory");
}
__device__ __forceinline__ void tr_item(const float* W, int ldw, int src_c0, int k0, bf16* WT0, int K, LAS float* scr, int lane) {
    float tv[32];
#pragma unroll
    for (int i = 0; i < 32; ++i) tv[i] = W[(size_t)(k0 + 2 * i + (lane >> 5)) * ldw + src_c0 + (lane & 31)];
#pragma unroll
    for (int i = 0; i < 32; ++i) scr[(2 * i + (lane >> 5)) * 33 + (lane & 31)] = tv[i];
    asm volatile("s_waitcnt lgkmcnt(0)" ::: "memory");
    const int c = lane & 7;
#pragma unroll
    for (int j = 0; j < 4; ++j) { const int n = (lane >> 3) + 8 * j; const LAS float* sp = scr + (8 * c) * 33 + n;
        u32x4 o; o.x = pk2(sp[0 * 33], sp[1 * 33]); o.y = pk2(sp[2 * 33], sp[3 * 33]); o.z = pk2(sp[4 * 33], sp[5 * 33]); o.w = pk2(sp[6 * 33], sp[7 * 33]);
        *(u32x4*)(WT0 + (size_t)n * K + 8 * c) = o; }
    asm volatile("s_waitcnt lgkmcnt(0)" ::: "memory");
}
__device__ __forceinline__ int win_src_col(int d) { return C_GR + d; }
__device__ __forceinline__ int gate_src_col(int v) {
    if (v < 1792) return v < 256 ? C_GQ + v : v < 512 ? C_GK + (v - 256) : v < 1024 ? C_GV + (v - 512) : v < 1536 ? C_SQ + (v - 1024) : v < 1664 ? C_SK + (v - 1536) : C_SV + (v - 1664);
    const int g = v - 1792; return ((g >> 7) & 1 ? C_MB : C_MA) + 128 * (g >> 8) + (g & 127);
}
__device__ __forceinline__ void ph_weights(const Frame& F) {
    LAS float* scr = (LAS float*)(F.lds + F.wave * 16384);
    const int gw = F.bid * NWAVES + F.wave, NGW = F.G * NWAVES;
    unsigned char* ws = F.ws();
    constexpr int IA = 16 * 16, IG = 16 * 120, IB1 = 8 * 32, IB3 = 16 * 32, IC = 16 * 32, ID = 8 * 32;
    constexpr int NG = DEPTH * IG, NA = DEPTH * IA, NB = DEPTH * (2 * IB1 + IB3), NC = DEPTH * NE * IC, ND = DEPTH * NE * ID;
    for (int it = gw; it < NG + NA + NB + NC + ND; it += NGW) {
        int r = it;
        if (r < NG) { const int l = r / IG, q = r % IG, kb = q / 120, nb = q % 120;
            tr_item8(F.in(I_WIN) + (size_t)l * D * INW, INW, gate_src_col(32 * nb), 64 * kb, ws + WS_WGU_T + (size_t)l * NE * 1024 * D * 2 + 16 * MiB + (size_t)(32 * nb) * D + 64 * kb, D, F8_WGU, scr, F.lane); continue; }
        r -= NG;
        if (r < NA) { const int l = r / IA, q = r % IA, kb = q / 16, nb = q % 16;
            tr_item(F.in(I_WIN) + (size_t)l * D * INW, INW, win_src_col(32 * nb), 64 * kb, (bf16*)(ws + WS_WIN_T) + ((size_t)l * NIN + 32 * nb) * D + 64 * kb, D, scr, F.lane); continue; }
        r -= NA;
        if (r < NB) { const int l = r / (2 * IB1 + IB3); int q = r % (2 * IB1 + IB3);
            if (q < IB1) { const int kb = q / 32, nb = q % 32; tr_item(F.in(I_WUG) + (size_t)l * 512 * D, D, 32 * nb, 64 * kb, (bf16*)(ws + WS_WG_T) + ((size_t)l * D + 32 * nb) * 512 + 64 * kb, 512, scr, F.lane); continue; }
            q -= IB1;
            if (q < IB1) { const int kb = q / 32, nb = q % 32; tr_item(F.in(I_WUS) + (size_t)l * 512 * D, D, 32 * nb, 64 * kb, (bf16*)(ws + WS_WS_T) + ((size_t)l * D + 32 * nb) * 512 + 64 * kb, 512, scr, F.lane); continue; }
            q -= IB1;
            { const int kb = q / 32, nb = q % 32; tr_item(F.in(I_WOUT) + (size_t)l * D * D, D, 32 * nb, 64 * kb, (bf16*)(ws + WS_WOUT_T) + ((size_t)l * D + 32 * nb) * D + 64 * kb, D, scr, F.lane); continue; } }
        r -= NB;
        if (r < NC) { const int le = r / IC, q = r % IC, kb = q / 32, nb = q % 32, drow = 32 * nb, pn = drow >> 8, up = (drow >> 7) & 1, f0 = drow & 127;
            if ((MK_FP8_MOE >> (le / NE)) & 1u) { tr_item8((up ? F.in(I_WUP) : F.in(I_WGATE)) + (size_t)le * D * DFF, DFF, 128 * pn + f0, 64 * kb,
                    ws + WS_WGU_T + (size_t)(le / NE) * NE * 1024 * D * 2 + ((size_t)(le % NE) * 1024 + drow) * D + 64 * kb, D, F8_WGU, scr, F.lane); continue; }
            tr_item((up ? F.in(I_WUP) : F.in(I_WGATE)) + (size_t)le * D * DFF, DFF, 128 * pn + f0, 64 * kb, (bf16*)(ws + WS_WGU_T) + ((size_t)le * 1024 + drow) * D + 64 * kb, D, scr, F.lane); continue; }
        r -= NC;
        { const int le = r / ID, q = r % ID, kb = q / 32, nb = q % 32;
            if ((MK_FP8_MOE >> (le / NE)) & 1u) { tr_item8(F.in(I_WDOWN) + (size_t)le * DFF * D, D, 32 * nb, 64 * kb,
                    ws + WS_WD_T + (size_t)(le / NE) * NE * 1024 * DFF * 2 + ((size_t)(le % NE) * D + 32 * nb) * DFF + 64 * kb, DFF, F8_WD, scr, F.lane); continue; }
            tr_item(F.in(I_WDOWN) + (size_t)le * DFF * D, D, 32 * nb, 64 * kb, (bf16*)(ws + WS_WD_T) + ((size_t)le * D + 32 * nb) * DFF + 64 * kb, DFF, scr, F.lane); }
    }
    for (int idx = F.bid * NTHREADS + F.tid; idx < DEPTH * 256 * (D / 8); idx += F.G * NTHREADS) {
        const int l = idx / (256 * (D / 8)), q = idx % (256 * (D / 8)), rr = q / (D / 8), k0 = (q % (D / 8)) * 8;
        u32x4 o = (u32x4){0u, 0u, 0u, 0u};
        if (rr < GRANK) { const float* w = F.in(I_WIN) + (size_t)l * D * INW + C_GA + rr;
            o.x = pk2(w[(size_t)(k0 + 0) * INW], w[(size_t)(k0 + 1) * INW]); o.y = pk2(w[(size_t)(k0 + 2) * INW], w[(size_t)(k0 + 3) * INW]);
            o.z = pk2(w[(size_t)(k0 + 4) * INW], w[(size_t)(k0 + 5) * INW]); o.w = pk2(w[(size_t)(k0 + 6) * INW], w[(size_t)(k0 + 7) * INW]); }
        *(u32x4*)((bf16*)(ws + WS_WIN_T) + ((size_t)l * NIN + 512 + rr) * D + k0) = o;
    }
    __syncthreads();
}

__device__ __forceinline__ void phase_stagger(const Frame& F, unsigned ticks) {
    if (F.bid & 1) { const unsigned long long t0 = __builtin_amdgcn_s_memrealtime(); while (__builtin_amdgcn_s_memrealtime() - t0 < ticks) __builtin_amdgcn_s_sleep(16); }
}
template <bool XBF>
struct EpiG3 {
    const float* xin; bf16* xb; const float* modl;
    __device__ __forceinline__ void operator()(f32x4 (&acc)[2][2][4][2], const pg::Unit& u, int wr, int wc, int fr, int fq) const {
        const float* g = modl + ((size_t)(u.pm >> 5) * 6 + 2) * D; const int col0 = u.pn * 256 + wc * 32 + fq * 8;
        f32x4 gv[2][2];
#pragma unroll
        for (int bj = 0; bj < 2; ++bj)
#pragma unroll
            for (int n = 0; n < 2; ++n) gv[bj][n] = *(const f32x4*)(g + col0 + bj * 128 + n * 4);
#pragma unroll
        for (int ai = 0; ai < 2; ++ai) {
            f32x4 xv[4][2][2]; u32x4 xh[4][2];
#pragma unroll
            for (int m = 0; m < 4; ++m) { const size_t ro = (size_t)(u.pm * 256 + ai * 128 + wr * 64 + m * 16 + fr) * D + col0;
#pragma unroll
                for (int bj = 0; bj < 2; ++bj) { if (XBF) xh[m][bj] = *(const u32x4*)(xb + ro + bj * 128);
                    else { xv[m][bj][0] = *(const f32x4*)(xin + ro + bj * 128); xv[m][bj][1] = *(const f32x4*)(xin + ro + bj * 128 + 4); } } }
            asm volatile("" ::: "memory");
#pragma unroll
            for (int m = 0; m < 4; ++m) { const size_t ro = (size_t)(u.pm * 256 + ai * 128 + wr * 64 + m * 16 + fr) * D + col0;
#pragma unroll
                for (int bj = 0; bj < 2; ++bj) { f32x4 x0, x1;
                    if (XBF) { const u32x4 h = xh[m][bj]; x0 = (f32x4){bf2f(h.x & 0xffffu), bf2f(h.x >> 16), bf2f(h.y & 0xffffu), bf2f(h.y >> 16)}; x1 = (f32x4){bf2f(h.z & 0xffffu), bf2f(h.z >> 16), bf2f(h.w & 0xffffu), bf2f(h.w >> 16)}; }
                    else { x0 = xv[m][bj][0]; x1 = xv[m][bj][1]; }
                    x0 = x0 + gv[bj][0] * acc[ai][bj][m][0]; x1 = x1 + gv[bj][1] * acc[ai][bj][m][1];
                    u32x4 o; o.x = pg::cvt_pk_bf16(x0[0], x0[1]); o.y = pg::cvt_pk_bf16(x0[2], x0[3]); o.z = pg::cvt_pk_bf16(x1[0], x1[1]); o.w = pg::cvt_pk_bf16(x1[2], x1[3]);
                    *(u32x4*)(xb + ro + bj * 128) = o; } }
        }
    }
};
template <bool XBF>
__device__ __forceinline__ void ph_gemm3_mfma(const Frame& F, int l) {
    unsigned char* ws = F.ws();
    pg::DenseOrderT<T / 256, D / 256> S; S.init(ws + WS_MERGED, ws + WS_WOUT_T + (size_t)l * D * D * 2, D, F.G, F.bid);
    EpiG3<XBF> E{F.in(I_X), (bf16*)(ws + WS_XB), (const float*)(ws + WS_MOD) + (size_t)l * BATCH * 6 * D};
    pg::gemm_phase<false, false>(F.lds, F.tid, D, S, E);
}

struct EpiG1 {
    unsigned char* ws;
    __device__ __forceinline__ void operator()(f32x4 (&acc)[2][2][4][2], const pg::Unit& u, int wr, int wc, int fr, int fq) const {
        const int pn = u.pn, row0 = u.pm * 256 + wr * 64 + fr, c8 = wc * 32 + fq * 8;
        if (pn == 2) {
            if (wc == 0 && fq < 2) { float* GA = (float*)(ws + WS_GA);
#pragma unroll
                for (int ai = 0; ai < 2; ++ai)
#pragma unroll
                    for (int m = 0; m < 4; ++m) { float* p = GA + (size_t)(row0 + ai * 128 + m * 16) * 16 + fq * 8; *(f32x4*)p = acc[ai][0][m][0]; *(f32x4*)(p + 4) = acc[ai][0][m][1]; } }
            return;
        }
        bf16* b0 = (bf16*)(ws + WS_GR) + pn * 256;
#pragma unroll
        for (int ai = 0; ai < 2; ++ai)
#pragma unroll
            for (int m = 0; m < 4; ++m) { const size_t ro = (size_t)(row0 + ai * 128 + m * 16) * 512 + c8;
#pragma unroll
                for (int bj = 0; bj < 2; ++bj) { f32x4 v0 = acc[ai][bj][m][0], v1 = acc[ai][bj][m][1];
#pragma unroll
                    for (int q = 0; q < 4; ++q) { v0[q] = v0[q] * __builtin_amdgcn_rcpf(1.f + __expf(-v0[q])); v1[q] = v1[q] * __builtin_amdgcn_rcpf(1.f + __expf(-v1[q])); }
                    u32x4 w; w.x = pg::cvt_pk_bf16(v0[0], v0[1]); w.y = pg::cvt_pk_bf16(v0[2], v0[3]); w.z = pg::cvt_pk_bf16(v1[0], v1[1]); w.w = pg::cvt_pk_bf16(v1[2], v1[3]);
                    *(u32x4*)(b0 + bj * 128 + ro) = w; } }
    }
};
struct EpiG1G {
    unsigned char* ws;
    __device__ __forceinline__ void operator()(f32x4 (&acc)[2][2][4][2], const pg::Unit& u, int wr, int wc, int fr, int fq) const {
        const int row0 = u.pm * 256 + wr * 64 + fr, c8 = wc * 32 + fq * 8; constexpr float ninv = -1.f / (F8_H * F8_WGU);
        if (u.pn < 7) {
            const int pn = u.pn; bf16* b0; bf16* b1; int ld; float sc = 1.f / (F8_H * F8_WGU);
            if (pn == 0)      { b0 = (bf16*)(ws + WS_GQ); ld = 256; b1 = b0 + 128; sc *= 0.125f; }
            else if (pn == 1) { b0 = (bf16*)(ws + WS_GK); ld = 256; b1 = b0 + 128; }
            else if (pn < 4)  { b0 = (bf16*)(ws + WS_GV) + (pn - 2) * 256; ld = 512; b1 = b0 + 128; }
            else if (pn < 6)  { b0 = (bf16*)(ws + WS_SQ) + (pn - 4) * 256; ld = 512; b1 = b0 + 128; }
            else              { b0 = (bf16*)(ws + WS_SK); b1 = (bf16*)(ws + WS_SV); ld = 128; }
#pragma unroll
            for (int ai = 0; ai < 2; ++ai)
#pragma unroll
                for (int m = 0; m < 4; ++m) { const size_t ro = (size_t)(row0 + ai * 128 + m * 16) * ld + c8;
#pragma unroll
                    for (int bj = 0; bj < 2; ++bj) { const f32x4 v0 = acc[ai][bj][m][0] * sc, v1 = acc[ai][bj][m][1] * sc;
                        u32x4 w; w.x = pg::cvt_pk_bf16(v0[0], v0[1]); w.y = pg::cvt_pk_bf16(v0[2], v0[3]); w.z = pg::cvt_pk_bf16(v1[0], v1[1]); w.w = pg::cvt_pk_bf16(v1[2], v1[3]);
                        *(u32x4*)((bj ? b1 : b0) + ro) = w; } }
            return;
        }
        bf16* RA = (bf16*)(ws + WS_MA) + (u.pn - 7) * 128 + c8; bf16* SBp = (bf16*)(ws + WS_MB) + (u.pn - 7) * 128 + c8;
#pragma unroll
        for (int ai = 0; ai < 2; ++ai)
#pragma unroll
            for (int m = 0; m < 4; ++m) { const size_t ro = (size_t)(row0 + ai * 128 + m * 16) * D; float rt[8], sb[8];
#pragma unroll
                for (int n = 0; n < 2; ++n)
#pragma unroll
                    for (int q = 0; q < 4; ++q) { const float pa = 1.f + __builtin_amdgcn_exp2f(acc[ai][0][m][n][q] * (ninv * 1.4426950408889634f)), pb = 1.f + __builtin_amdgcn_exp2f(acc[ai][1][m][n][q] * (ninv * 1.4426950408889634f));
                        const float iu = __builtin_amdgcn_rcpf(pa * pb);
                        sb[4 * n + q] = pa * iu; rt[4 * n + q] = pb * pb * iu; }
                u32x4 w; w.x = pg::cvt_pk_bf16(rt[0], rt[1]); w.y = pg::cvt_pk_bf16(rt[2], rt[3]); w.z = pg::cvt_pk_bf16(rt[4], rt[5]); w.w = pg::cvt_pk_bf16(rt[6], rt[7]);
                *(u32x4*)(RA + ro) = w;
                w.x = pg::cvt_pk_bf16(sb[0], sb[1]); w.y = pg::cvt_pk_bf16(sb[2], sb[3]); w.z = pg::cvt_pk_bf16(sb[4], sb[5]); w.w = pg::cvt_pk_bf16(sb[6], sb[7]);
                *(u32x4*)(SBp + ro) = w; }
    }
};
__device__ __forceinline__ void ph_gemm1_gates(const Frame& F, int l) {
    unsigned char* ws = F.ws();
    pg::DenseOrderT<T / 256, NGATE / 256> S; S.init(ws + WS_H8N, ws + WS_WGU_T + (size_t)l * NE * 1024 * D * 2 + 16 * MiB, D / 2, F.G, F.bid);
    EpiG1G E{ws};
    pg::gemm_phase<false, true>(F.lds, F.tid, D / 2, S, E);
}
__device__ __forceinline__ void ph_gemm1_mfma(const Frame& F, int l) {
    unsigned char* ws = F.ws();
    pg::DenseOrderT<T / 256, NIN / 256> S; S.init(ws + WS_H, ws + WS_WIN_T + (size_t)l * NIN * D * 2, D, F.G, F.bid);
    EpiG1 E{ws};
    pg::gemm_phase<false, false>(F.lds, F.tid, D, S, E);
}
struct G2Order {
    pg::DenseOrder d; const char* A2; const char* B2;
    __device__ __forceinline__ bool next(int i, pg::Unit& u) const {
        int pm, pn; if (!d.tile(i >> 1, pm, pn)) return false;
        const int seg = i & 1; u.pm = pm; u.pn = pn; u.e = seg; u.j = 0; u.valid = 256; u.keep = !seg;
        u.A = (seg ? A2 : d.A) + (size_t)pm * 256 * d.K * 2; u.B = (seg ? B2 : d.B) + (size_t)pn * 256 * d.K * 2; return true;
    }
    __device__ __forceinline__ unsigned rowoff(const pg::Unit&, int r) const { return (unsigned)(r * d.K * 2); }
};
struct EpiG2 {
    const bf16* MA; const bf16* MB; bf16* MG;
    __device__ __forceinline__ void operator()(f32x4 (&acc)[2][2][4][2], const pg::Unit& u, int wr, int wc, int fr, int fq) const {
        const int row0 = u.pm * 256 + wr * 64 + fr, col0 = u.pn * 256 + wc * 32 + fq * 8;
        if (u.e == 0) {
#pragma unroll
            for (int ai = 0; ai < 2; ++ai) {
                u32x4 aw[4][2];
#pragma unroll
                for (int m = 0; m < 4; ++m) { const size_t ro = (size_t)(row0 + ai * 128 + m * 16) * D + col0;
#pragma unroll
                    for (int bj = 0; bj < 2; ++bj) aw[m][bj] = *(const u32x4*)(MA + ro + bj * 128); }
                asm volatile("" ::: "memory");
#pragma unroll
                for (int m = 0; m < 4; ++m)
#pragma unroll
                    for (int bj = 0; bj < 2; ++bj)
#pragma unroll
                        for (int q = 0; q < 4; ++q) { acc[ai][bj][m][q >> 1][2 * (q & 1)] *= bf2f(aw[m][bj][q] & 0xffffu); acc[ai][bj][m][q >> 1][2 * (q & 1) + 1] *= bf2f(aw[m][bj][q] >> 16); }
            }
        } else {
#pragma unroll
            for (int ai = 0; ai < 2; ++ai) {
                u32x4 bw[4][2];
#pragma unroll
                for (int m = 0; m < 4; ++m) { const size_t ro = (size_t)(row0 + ai * 128 + m * 16) * D + col0;
#pragma unroll
                    for (int bj = 0; bj < 2; ++bj) bw[m][bj] = *(const u32x4*)(MB + ro + bj * 128); }
                asm volatile("" ::: "memory");
#pragma unroll
                for (int m = 0; m < 4; ++m) { const size_t ro = (size_t)(row0 + ai * 128 + m * 16) * D + col0;
#pragma unroll
                    for (int bj = 0; bj < 2; ++bj) { const f32x4 v0 = acc[ai][bj][m][0], v1 = acc[ai][bj][m][1]; const u32x4 b = bw[m][bj]; u32x4 w;
                        w.x = pg::cvt_pk_bf16(v0[0] * bf2f(b.x & 0xffffu), v0[1] * bf2f(b.x >> 16)); w.y = pg::cvt_pk_bf16(v0[2] * bf2f(b.y & 0xffffu), v0[3] * bf2f(b.y >> 16));
                        w.z = pg::cvt_pk_bf16(v1[0] * bf2f(b.z & 0xffffu), v1[1] * bf2f(b.z >> 16)); w.w = pg::cvt_pk_bf16(v1[2] * bf2f(b.w & 0xffffu), v1[3] * bf2f(b.w >> 16));
                        *(u32x4*)(MG + ro + bj * 128) = w; } }
            }
        }
    }
};
__device__ __forceinline__ void ph_gemm2_mfma(const Frame& F, int l) {
    unsigned char* ws = F.ws();
    G2Order S; S.d.init(ws + WS_GLAO, ws + WS_WG_T + (size_t)l * D * 512 * 2, T, D, 512, F.G, F.bid); S.A2 = (const char*)(ws + WS_SWAO); S.B2 = (const char*)(ws + WS_WS_T + (size_t)l * D * 512 * 2);
    EpiG2 E{(const bf16*)(ws + WS_MA), (const bf16*)(ws + WS_MB), (bf16*)(ws + WS_MERGED)};
    pg::gemm_phase<false, false>(F.lds, F.tid, 512, S, E);
}

constexpr int MOE_TAB = 131072 + 1024;
__device__ __forceinline__ void moe_table(const Frame& F, int l) {
    volatile LAS int* tb = (volatile LAS int*)(F.lds + MOE_TAB);
    if (F.tid < 64) {
        const unsigned* cnt = (const unsigned*)(F.ws() + WS_CTL) + CW_CNT + 64 * (NE * l);
        const int ce = F.tid < NE ? (int)__hip_atomic_load(cnt + 64 * F.tid, __ATOMIC_RELAXED, __HIP_MEMORY_SCOPE_AGENT) : 0;
        int inc = (ce + 255) >> 8;
#pragma unroll
        for (int o = 1; o < 16; o <<= 1) { const int t = __builtin_amdgcn_ds_bpermute(((F.lane - o) & 63) << 2, inc); if ((F.lane & 15) >= o && F.lane < 16) inc += t; }
        if (F.tid < NE) { tb[F.tid + 1] = inc; tb[32 + F.tid] = ce; }
        if (F.tid == 0) tb[0] = 0;
    }
    __syncthreads();
}
template <bool GATHER>
struct MoeOrder {
    LAS unsigned char* lds; const char* Abase; const char* Bbase; const int* tokl; int K, G, c;
    __device__ __forceinline__ bool next(int i, pg::Unit& u) const {
        volatile LAS int* tb = (volatile LAS int*)(lds + MOE_TAB);
        const int L = i * G + c, ti = L >> 2, pn = L & 3;
        if (ti >= tb[16]) return false;
        int e = 0;
#pragma unroll
        for (int k = 1; k < NE; ++k) e += (ti >= tb[k]) ? 1 : 0;
        e = __builtin_amdgcn_readfirstlane(e);
        const int j = ti - __builtin_amdgcn_readfirstlane(tb[e]), ce = __builtin_amdgcn_readfirstlane(tb[32 + e]);
        u.pm = ti; u.pn = pn; u.e = e; u.j = j; u.valid = (ce - 256 * j) < 256 ? (ce - 256 * j) : 256; u.keep = 0;
        u.A = GATHER ? Abase : Abase + (size_t)ti * 256 * K * 2;
        u.B = Bbase + ((size_t)e * 1024 + pn * 256) * K * 2; return true;
    }
    __device__ __forceinline__ unsigned rowoff(const pg::Unit& u, int r) const {
        if (!GATHER) return (unsigned)(r * K * 2);
        int tk = 0; if (r < u.valid) tk = tokl[(size_t)u.e * ECAP + 256 * u.j + r];
        return (unsigned)tk * (unsigned)(K * 2);
    }
};
struct EpiMU {
    bf16* ACT;
    __device__ __forceinline__ void operator()(f32x4 (&acc)[2][2][4][2], const pg::Unit& u, int wr, int wc, int fr, int fq) const {
#pragma unroll
        for (int ai = 0; ai < 2; ++ai)
#pragma unroll
            for (int m = 0; m < 4; ++m) { bf16* p = ACT + (size_t)(u.pm * 256 + ai * 128 + wr * 64 + m * 16 + fr) * DFF + u.pn * 128 + wc * 32 + fq * 8;
                float o[8];
#pragma unroll
                for (int n = 0; n < 2; ++n)
#pragma unroll
                    for (int q = 0; q < 4; ++q) { const float g = acc[ai][0][m][n][q]; o[n * 4 + q] = g * __builtin_amdgcn_rcpf(1.f + __expf(-g)) * acc[ai][1][m][n][q]; }
                u32x4 w; w.x = pg::cvt_pk_bf16(o[0], o[1]); w.y = pg::cvt_pk_bf16(o[2], o[3]); w.z = pg::cvt_pk_bf16(o[4], o[5]); w.w = pg::cvt_pk_bf16(o[6], o[7]);
                *(u32x4*)p = w; }
    }
};
struct EpiMD {
    bf16* YS;
    __device__ __forceinline__ void operator()(f32x4 (&acc)[2][2][4][2], const pg::Unit& u, int wr, int wc, int fr, int fq) const {
#pragma unroll
        for (int ai = 0; ai < 2; ++ai)
#pragma unroll
            for (int m = 0; m < 4; ++m) { bf16* p = YS + (size_t)(u.pm * 256 + ai * 128 + wr * 64 + m * 16 + fr) * D + u.pn * 256 + wc * 32 + fq * 8;
#pragma unroll
                for (int bj = 0; bj < 2; ++bj) { const f32x4 v0 = acc[ai][bj][m][0], v1 = acc[ai][bj][m][1];
                    u32x4 o; o.x = pg::cvt_pk_bf16(v0[0], v0[1]); o.y = pg::cvt_pk_bf16(v0[2], v0[3]); o.z = pg::cvt_pk_bf16(v1[0], v1[1]); o.w = pg::cvt_pk_bf16(v1[2], v1[3]);
                    *(u32x4*)(p + bj * 128) = o; } }
    }
};
struct EpiMU8 {
    unsigned char* ACT8;
    __device__ __forceinline__ void operator()(f32x4 (&acc)[2][2][4][2], const pg::Unit& u, int wr, int wc, int fr, int fq) const {
        constexpr float inv = 1.f / (F8_H * F8_WGU);
#pragma unroll
        for (int ai = 0; ai < 2; ++ai)
#pragma unroll
            for (int m = 0; m < 4; ++m) { unsigned char* p = ACT8 + (size_t)(u.pm * 256 + ai * 128 + wr * 64 + m * 16 + fr) * DFF + u.pn * 128 + wc * 32 + fq * 8;
                float o[8];
#pragma unroll
                for (int n = 0; n < 2; ++n)
#pragma unroll
                    for (int q = 0; q < 4; ++q) { const float a0 = acc[ai][0][m][n][q], a1 = acc[ai][1][m][n][q];
                        o[n * 4 + q] = a0 * a1 * (F8_ACT * inv * inv) * __builtin_amdgcn_rcpf(1.f + __builtin_amdgcn_exp2f(a0 * (-inv * 1.4426950408889634f))); }
                typedef unsigned u32x2_ __attribute__((ext_vector_type(2)));
                u32x2_ w; w.x = pk_fp8x4(o[0], o[1], o[2], o[3]); w.y = pk_fp8x4(o[4], o[5], o[6], o[7]);
                *(u32x2_*)p = w; }
    }
};
struct EpiMD8 {
    bf16* YS;
    __device__ __forceinline__ void operator()(f32x4 (&acc)[2][2][4][2], const pg::Unit& u, int wr, int wc, int fr, int fq) const {
#pragma unroll
        for (int ai = 0; ai < 2; ++ai)
#pragma unroll
            for (int m = 0; m < 4; ++m) { bf16* p = YS + (size_t)(u.pm * 256 + ai * 128 + wr * 64 + m * 16 + fr) * D + u.pn * 256 + wc * 32 + fq * 8;
#pragma unroll
                for (int bj = 0; bj < 2; ++bj) { const f32x4 v0 = acc[ai][bj][m][0], v1 = acc[ai][bj][m][1];
                    u32x4 o; o.x = pg::cvt_pk_bf16(v0[0], v0[1]); o.y = pg::cvt_pk_bf16(v0[2], v0[3]); o.z = pg::cvt_pk_bf16(v1[0], v1[1]); o.w = pg::cvt_pk_bf16(v1[2], v1[3]);
                    *(u32x4*)(p + bj * 128) = o; } }
    }
};
__device__ __forceinline__ int vcu_of(const Frame& F) { return (F.G % 8 == 0) ? (F.bid % 8) * (F.G / 8) + F.bid / 8 : F.bid; }
__device__ __forceinline__ void ph_moe_up_mfma(const Frame& F, int l) {
    unsigned char* ws = F.ws(); moe_table(F, l);
    MoeOrder<true> S{F.lds, (const char*)(ws + WS_H), (const char*)(ws + WS_WGU_T + (size_t)l * NE * 1024 * D * 2), (const int*)(ws + WS_TOKL), D, F.G, vcu_of(F)};
    EpiMU E{(bf16*)(ws + WS_ACT)};
    pg::gemm_phase<true, false>(F.lds, F.tid, D, S, E);
}
__device__ __forceinline__ void ph_moe_up_fp8(const Frame& F, int l) {
    unsigned char* ws = F.ws(); moe_table(F, l);
    MoeOrder<true> S{F.lds, (const char*)(ws + WS_H8), (const char*)(ws + WS_WGU_T + (size_t)l * NE * 1024 * D * 2), (const int*)(ws + WS_TOKL), D / 2, F.G, vcu_of(F)};
    EpiMU8 E{ws + WS_ACT8};
    pg::gemm_phase<true, true>(F.lds, F.tid, D / 2, S, E);
}
__device__ __forceinline__ void ph_moe_down_fp8(const Frame& F, int l) {
    unsigned char* ws = F.ws(); moe_table(F, l);
    MoeOrder<false> S{F.lds, (const char*)(ws + WS_ACT8), (const char*)(ws + WS_WD_T + (size_t)l * NE * 1024 * DFF * 2), (const int*)(ws + WS_TOKL), DFF / 2, F.G, vcu_of(F)};
    EpiMD8 E{(bf16*)(ws + WS_YS)};
    pg::gemm_phase<false, true>(F.lds, F.tid, DFF / 2, S, E);
}
__device__ __forceinline__ void ph_moe_down_mfma(const Frame& F, int l) {
    unsigned char* ws = F.ws(); moe_table(F, l);
    MoeOrder<false> S{F.lds, (const char*)(ws + WS_ACT), (const char*)(ws + WS_WD_T + (size_t)l * NE * 1024 * DFF * 2), (const int*)(ws + WS_TOKL), DFF, F.G, vcu_of(F)};
    EpiMD E{(bf16*)(ws + WS_YS)};
    pg::gemm_phase<false, false>(F.lds, F.tid, DFF, S, E);
}
__device__ __forceinline__ void ph_rope_table(const Frame& F) {
    const int* pos = (const int*)F.in(I_POS); float* RT = (float*)(F.ws() + WS_ROPE);
    for (int idx = F.bid * NTHREADS + F.tid; idx < T * 8; idx += F.G * NTHREADS) {
        const int t = idx >> 3, i = idx & 7;
        const float invf = (float)exp2(-(double)i * (1.0 / 8.0) * 18.931568569324174);
        const float ang = (float)pos[t] * invf;
        const double rev = (double)ang * 0.15915494309189535; const float fr = (float)(rev - floor(rev));
        RT[(size_t)t * 16 + i] = __builtin_amdgcn_cosf(fr); RT[(size_t)t * 16 + 8 + i] = __builtin_amdgcn_sinf(fr);
    }
    bf16* WRT = (bf16*)(F.ws() + WS_WRT);
    for (int idx = F.bid * NTHREADS + F.tid; idx < NE * D; idx += F.G * NTHREADS) { const int e = idx >> 10, k = idx & 1023; const float w = F.in(I_WR)[(size_t)k * NE + e];
        const unsigned hi = f2bf(w); WRT[idx] = (bf16)hi; WRT[NE * D + idx] = (bf16)f2bf(w - bf2f(hi)); }
}
typedef float f32x16 __attribute__((ext_vector_type(16)));
constexpr int SWA_KP = 144, SWA_VP = 520, SWA_VT_OFF = 256 * SWA_KP;
__device__ __forceinline__ void ph_swa_mfma(const Frame& F, int l) {
    unsigned char* ws = F.ws();
    const bf16* SQ = (const bf16*)(ws + WS_SQ); const bf16* SK = (const bf16*)(ws + WS_SK); const bf16* SV = (const bf16*)(ws + WS_SV); bf16* O = (bf16*)(ws + WS_SWAO);
    const float* RT = (const float*)(ws + WS_ROPE);
    const float* qn = F.in(I_QN) + l * SHD; const float* kn = F.in(I_KN) + l * SHD; const float* sinks = F.in(I_SINK) + l * SH;
    LAS unsigned char* Kb = F.lds; LAS unsigned char* Vt = F.lds + SWA_VT_OFF;
    const int tid = F.tid, lane = F.lane, w = F.wave, r = lane & 31, h = lane >> 5;
    constexpr float QSCALE = 0.125f * 1.4426950408889634f;
    for (int unit = F.bid; unit < BATCH * SKV * (SEQ / WIN); unit += F.G) {
        const int n = unit & 63, kvh = (unit >> 6) & 1, b = unit >> 7;
        const int tq0 = b * SEQ + n * WIN, tk0 = tq0 - WIN;
        __syncthreads();
#pragma unroll
        for (int it = 0; it < 4; ++it) {
            const int key = (tid >> 3) + 64 * it, c = tid & 7; const bool valid = (n > 0) || (key >= WIN); const int tok = valid ? tk0 + key : tq0;
            const u32x4 raw = *(const u32x4*)(SK + (size_t)tok * 128 + kvh * 64 + 8 * c);
            float v[8];
#pragma unroll
            for (int q = 0; q < 4; ++q) { v[2 * q] = bf2f(raw[q] & 0xffffu); v[2 * q + 1] = bf2f(raw[q] >> 16); }
            float ss = 0.f;
#pragma unroll
            for (int j = 0; j < 8; ++j) ss += v[j] * v[j];
            ss += shx(ss, 1, lane); ss += shx(ss, 2, lane); ss += shx(ss, 4, lane);
            const float rstd = 1.0f / sqrtf(ss * (1.f / 64.f) + EPS);
            const f32x4 g0 = *(const f32x4*)(kn + 8 * c), g1 = *(const f32x4*)(kn + 8 * c + 4);
#pragma unroll
            for (int j = 0; j < 4; ++j) { v[j] = v[j] * rstd * g0[j]; v[4 + j] = v[4 + j] * rstd * g1[j]; }
            float pr[8];
#pragma unroll
            for (int j = 0; j < 8; ++j) pr[j] = shx(v[j], 1, lane);
            if (c < 2) {
                const f32x4 c0 = *(const f32x4*)(RT + (size_t)tok * 16), c1 = *(const f32x4*)(RT + (size_t)tok * 16 + 4), s0 = *(const f32x4*)(RT + (size_t)tok * 16 + 8), s1 = *(const f32x4*)(RT + (size_t)tok * 16 + 12);
                const float sg = c == 0 ? -1.f : 1.f;
#pragma unroll
                for (int j = 0; j < 4; ++j) { v[j] = v[j] * c0[j] + sg * pr[j] * s0[j]; v[4 + j] = v[4 + j] * c1[j] + sg * pr[4 + j] * s1[j]; }
            }
            u32x4 o; o.x = pk2(v[0], v[1]); o.y = pk2(v[2], v[3]); o.z = pk2(v[4], v[5]); o.w = pk2(v[6], v[7]);
            if (!valid) o = (u32x4){0u, 0u, 0u, 0u};
            *(LAS u32x4*)(Kb + key * SWA_KP + 16 * c) = o;
        }
#pragma unroll
        for (int it = 0; it < 2; ++it) {
            const int kp = (tid >> 3) + 64 * it, c = tid & 7, key = 2 * kp; const bool valid = (n > 0) || (key >= WIN); const int tok = valid ? tk0 + key : tq0;
            u32x4 r0 = *(const u32x4*)(SV + (size_t)tok * 128 + kvh * 64 + 8 * c), r1 = *(const u32x4*)(SV + (size_t)(tok + 1) * 128 + kvh * 64 + 8 * c);
            if (!valid) { r0 = (u32x4){0u, 0u, 0u, 0u}; r1 = r0; }
#pragma unroll
            for (int q = 0; q < 4; ++q) {
                *(LAS unsigned*)(Vt + (8 * c + 2 * q) * SWA_VP + 4 * kp) = (r0[q] & 0xffffu) | (r1[q] << 16);
                *(LAS unsigned*)(Vt + (8 * c + 2 * q + 1) * SWA_VP + 4 * kp) = (r0[q] >> 16) | (r1[q] & 0xffff0000u);
            }
        }
        __syncthreads();
        const int g = w >> 1, hq = kvh * 4 + g; const float sink2 = sinks[hq] * 1.4426950408889634f;
#pragma unroll 1
        for (int qt = 0; qt < 2; ++qt) {
            const int p0 = 64 * (w & 1) + 32 * qt; const size_t tq = (size_t)(tq0 + p0 + r);
            float qv[4][8]; float ss = 0.f;
#pragma unroll
            for (int s4 = 0; s4 < 4; ++s4) { const u32x4 raw = *(const u32x4*)(SQ + tq * 512 + hq * 64 + 16 * s4 + 8 * h);
#pragma unroll
                for (int q = 0; q < 4; ++q) { qv[s4][2 * q] = bf2f(raw[q] & 0xffffu); qv[s4][2 * q + 1] = bf2f(raw[q] >> 16); } }
#pragma unroll
            for (int s4 = 0; s4 < 4; ++s4)
#pragma unroll
                for (int j = 0; j < 8; ++j) ss += qv[s4][j] * qv[s4][j];
            ss += shx(ss, 32, lane);
            const float rstd = 1.0f / sqrtf(ss * (1.f / 64.f) + EPS);
#pragma unroll
            for (int s4 = 0; s4 < 4; ++s4) { const f32x4 g0 = *(const f32x4*)(qn + 16 * s4 + 8 * h), g1 = *(const f32x4*)(qn + 16 * s4 + 8 * h + 4);
#pragma unroll
                for (int j = 0; j < 4; ++j) { qv[s4][j] = qv[s4][j] * rstd * g0[j]; qv[s4][4 + j] = qv[s4][4 + j] * rstd * g1[j]; } }
            { float pr[8];
#pragma unroll
              for (int j = 0; j < 8; ++j) pr[j] = shx(qv[0][j], 32, lane);
              const f32x4 c0 = *(const f32x4*)(RT + tq * 16), c1 = *(const f32x4*)(RT + tq * 16 + 4), s0 = *(const f32x4*)(RT + tq * 16 + 8), s1 = *(const f32x4*)(RT + tq * 16 + 12);
              const float sg = h == 0 ? -1.f : 1.f;
#pragma unroll
              for (int j = 0; j < 4; ++j) { qv[0][j] = qv[0][j] * c0[j] + sg * pr[j] * s0[j]; qv[0][4 + j] = qv[0][4 + j] * c1[j] + sg * pr[4 + j] * s1[j]; } }
            pg::bf16x8 qf[4];
#pragma unroll
            for (int s4 = 0; s4 < 4; ++s4) { u32x4 t; t.x = pk2(qv[s4][0] * QSCALE, qv[s4][1] * QSCALE); t.y = pk2(qv[s4][2] * QSCALE, qv[s4][3] * QSCALE); t.z = pk2(qv[s4][4] * QSCALE, qv[s4][5] * QSCALE); t.w = pk2(qv[s4][6] * QSCALE, qv[s4][7] * QSCALE);
                qf[s4] = __builtin_bit_cast(pg::bf16x8, t); }
            f32x16 sc[5];
#pragma unroll
            for (int kt = 0; kt < 5; ++kt) {
                f32x16 a16;
#pragma unroll
                for (int i = 0; i < 16; ++i) a16[i] = 0.f;
#pragma unroll
                for (int s4 = 0; s4 < 4; ++s4) { const pg::bf16x8 ka = *(const LAS pg::bf16x8*)(Kb + (p0 + 32 * kt + r) * SWA_KP + (16 * s4 + 8 * h) * 2);
                    a16 = __builtin_amdgcn_mfma_f32_32x32x16_bf16(ka, qf[s4], a16, 0, 0, 0); }
                sc[kt] = a16;
            }
            const int kt_lo = (n == 0) ? 4 - (p0 >> 5) : 0;
            float mx = sink2;
#pragma unroll
            for (int kt = 0; kt < 5; ++kt)
#pragma unroll
                for (int i = 0; i < 16; ++i) { const int kk = (i & 3) + 8 * (i >> 2) + 4 * h;
                    bool ok = kt >= kt_lo; if (kt == 0) ok = ok && (kk > r); if (kt == 4) ok = ok && (kk <= r);
                    const float sv = ok ? sc[kt][i] : -1e30f; sc[kt][i] = sv; mx = fmaxf(mx, sv); }
            mx = fmaxf(mx, shx(mx, 32, lane));
            float den = 0.f;
#pragma unroll
            for (int kt = 0; kt < 5; ++kt)
#pragma unroll
                for (int i = 0; i < 16; ++i) { const float p = __builtin_amdgcn_exp2f(sc[kt][i] - mx); sc[kt][i] = p; den += p; }
            den += shx(den, 32, lane); den += __builtin_amdgcn_exp2f(sink2 - mx);
            const float inv = 1.f / den;
            f32x16 o0, o1;
#pragma unroll
            for (int i = 0; i < 16; ++i) { o0[i] = 0.f; o1[i] = 0.f; }
#pragma unroll
            for (int kt = 0; kt < 5; ++kt)
#pragma unroll
                for (int s2 = 0; s2 < 2; ++s2) {
                    u32x4 t; t.x = pk2(sc[kt][8 * s2 + 0], sc[kt][8 * s2 + 1]); t.y = pk2(sc[kt][8 * s2 + 2], sc[kt][8 * s2 + 3]); t.z = pk2(sc[kt][8 * s2 + 4], sc[kt][8 * s2 + 5]); t.w = pk2(sc[kt][8 * s2 + 6], sc[kt][8 * s2 + 7]);
                    const pg::bf16x8 pf = __builtin_bit_cast(pg::bf16x8, t);
                    const int kb0 = p0 + 32 * kt + 16 * s2 + 4 * h;
                    typedef unsigned u32x2 __attribute__((ext_vector_type(2)));
                    const u32x2 a0 = *(const LAS u32x2*)(Vt + r * SWA_VP + kb0 * 2), a1 = *(const LAS u32x2*)(Vt + r * SWA_VP + (kb0 + 8) * 2);
                    const u32x2 b0 = *(const LAS u32x2*)(Vt + (32 + r) * SWA_VP + kb0 * 2), b1 = *(const LAS u32x2*)(Vt + (32 + r) * SWA_VP + (kb0 + 8) * 2);
                    u32x4 va; va.x = a0.x; va.y = a0.y; va.z = a1.x; va.w = a1.y; u32x4 vb; vb.x = b0.x; vb.y = b0.y; vb.z = b1.x; vb.w = b1.y;
                    o0 = __builtin_amdgcn_mfma_f32_32x32x16_bf16(__builtin_bit_cast(pg::bf16x8, va), pf, o0, 0, 0, 0);
                    o1 = __builtin_amdgcn_mfma_f32_32x32x16_bf16(__builtin_bit_cast(pg::bf16x8, vb), pf, o1, 0, 0, 0);
                }
            bf16* op = O + tq * 512 + hq * 64 + 4 * h;
#pragma unroll
            for (int i4 = 0; i4 < 4; ++i4) {
                const unsigned long long w0 = (unsigned long long)pk2(o0[4 * i4] * inv, o0[4 * i4 + 1] * inv) | ((unsigned long long)pk2(o0[4 * i4 + 2] * inv, o0[4 * i4 + 3] * inv) << 32);
                const unsigned long long w1 = (unsigned long long)pk2(o1[4 * i4] * inv, o1[4 * i4 + 1] * inv) | ((unsigned long long)pk2(o1[4 * i4 + 2] * inv, o1[4 * i4 + 3] * inv) << 32);
                *(unsigned long long*)(op + 8 * i4) = w0; *(unsigned long long*)(op + 32 + 8 * i4) = w1;
            }
        }
    }
    __syncthreads();
}

constexpr int GLA_GRP = 8, GLA_NG = NCH / GLA_GRP, GLA_UNITS = BATCH * GH * GLA_NG;
constexpr int GL_GA = 109568;
constexpr int GL_LA = 0, GL_SEG = 16384, GL_BEND = 18432, GL_DEC = 18688, GL_QD = 19456, GL_KI = 28672, GL_ATT = 37888, GL_KET = 47104, GL_VT = 56320, GL_OB = 75776, GL_P = 144;
typedef unsigned u32x2 __attribute__((ext_vector_type(2)));
template <bool OUT>
__device__ __forceinline__ void ph_gla_mfma(const Frame& F, int l) {
    unsigned char* ws = F.ws();
    const bf16* GQ = (const bf16*)(ws + WS_GQ); const bf16* GK = (const bf16*)(ws + WS_GK); const bf16* GV = (const bf16*)(ws + WS_GV); const bf16* GR = (const bf16*)(ws + WS_GR);
    const float* GA = (const float*)(ws + WS_GA); float* SLOC = (float*)(ws + WS_STATE); float* GDEC = (float*)(ws + WS_DECAY); bf16* GO = (bf16*)(ws + WS_GLAO);
    const float* wa2 = F.in(I_WA2) + (size_t)l * GRANK * 256; const float* ba = F.in(I_BA) + l * 256; const float* gn = F.in(I_GNORM) + l * 512;
    LAS unsigned char* L0 = F.lds;
    const int tid = F.tid, lane = F.lane, w = F.wave, L = lane & 15, q = lane >> 4;
    for (int ui = 0; ui < 2; ++ui) {
        int unit = ui == 0 ? F.bid : GLA_UNITS / 2 + (F.bid & ~15) + (15 - (F.bid & 15));
        if (F.G != GLA_UNITS / 2) { unit = F.bid + ui * F.G; }
        for (; unit < GLA_UNITS; unit += (F.G != GLA_UNITS / 2) ? 2 * F.G : GLA_UNITS) {
        const int g = unit & 15, h = (unit >> 4) & 3, b = unit >> 6;
        const int dd_ = lane & 7, sg = lane >> 3, d_ = 8 * w + dd_;
        float w2r[GRANK];
#pragma unroll
        for (int r = 0; r < GRANK; ++r) w2r[r] = wa2[r * 256 + h * 64 + d_];
        const float ba_d = ba[h * 64 + d_];
        f32x4 S[4];
#pragma unroll
        for (int t = 0; t < 4; ++t) S[t] = (f32x4){0.f, 0.f, 0.f, 0.f};
        if (OUT) {
            for (int gp = 0; gp < g; ++gp) { const int up = unit - g + gp;
#pragma unroll
                for (int t = 0; t < 4; ++t) { const f32x4 dc = *(const f32x4*)(GDEC + (size_t)up * 64 + 16 * t + 4 * q);
#pragma unroll
                    for (int rg = 0; rg < 4; ++rg) S[t][rg] = dc[rg] * S[t][rg] + SLOC[((size_t)up * 64 + 16 * t + 4 * q + rg) * 128 + 16 * w + L]; } }
        }
        float gtot = 0.f;
        const int ip_ = tid >> 4, c4_ = tid & 15, i4_ = tid >> 3, c8_ = tid & 7;
        unsigned ck[8], cq[8], nk[8], nq[8]; u32x2 cga, nga; u32x4 cv0, cv1, cg0, cg1, nv0, nv1, ng0, ng1, clah, nlah;
        cga = nga = (u32x2){0u, 0u}; clah = nlah = (u32x4){0u, 0u, 0u, 0u}; cg0 = cg1 = ng0 = ng1 = (u32x4){0u, 0u, 0u, 0u};
#pragma unroll
        for (int ii = 0; ii < 8; ++ii) { cq[ii] = 0u; nq[ii] = 0u; }
#define GLA_LSYNC() do { asm volatile("s_waitcnt lgkmcnt(0)" ::: "memory"); __builtin_amdgcn_s_barrier(); asm volatile("" ::: "memory"); } while (0)
#define GLA_FETCH(KK, QQ, V0, V1, G0, G1, GAV, LAV, tt) do { \
            _Pragma("unroll") for (int ii = 0; ii < 8; ++ii) KK[ii] = GK[(size_t)((tt) + 8 * sg + ii) * 256 + h * 64 + d_]; \
            V0 = *(const u32x4*)(GV + (size_t)((tt) + 2 * ip_) * 512 + h * 128 + 8 * c4_); V1 = *(const u32x4*)(GV + (size_t)((tt) + 2 * ip_ + 1) * 512 + h * 128 + 8 * c4_); \
            if (!OUT) GAV = *(const u32x2*)(GA + (size_t)(tt) * 16 + 2 * tid); \
            if (OUT) { LAV = *(const u32x4*)((const _Float16*)(ws + WS_LAH) + ((size_t)(((tt) >> 6) * GH + h) * 64 + d_) * 64 + 8 * sg); \
                _Pragma("unroll") for (int ii = 0; ii < 8; ++ii) QQ[ii] = GQ[(size_t)((tt) + 8 * sg + ii) * 256 + h * 64 + d_]; \
                G0 = *(const u32x4*)(GR + (size_t)((tt) + i4_) * 512 + h * 128 + 16 * c8_); G1 = *(const u32x4*)(GR + (size_t)((tt) + i4_) * 512 + h * 128 + 16 * c8_ + 8); } } while (0)
        { const int tt0 = b * SEQ + (g * GLA_GRP) * GCH; GLA_FETCH(ck, cq, cv0, cv1, cg0, cg1, cga, clah, tt0); }
        GLA_LSYNC();
        if (!OUT) *(LAS u32x2*)(L0 + GL_GA + 8 * tid) = cga;
        GLA_LSYNC();
#pragma unroll 1
        for (int c = 0; c < GLA_GRP; ++c) {
            const int t0 = b * SEQ + (g * GLA_GRP + c) * GCH;
            { const int cn = c + 1 < GLA_GRP ? c + 1 : c; const int tn = b * SEQ + (g * GLA_GRP + cn) * GCH; GLA_FETCH(nk, nq, nv0, nv1, ng0, ng1, nga, nlah, tn); }
            { float p[8]; float run = 0.f; typedef _Float16 h8 __attribute__((ext_vector_type(8)));
              if (!OUT) { h8 hv;
#pragma unroll
                for (int ii = 0; ii < 8; ++ii) { const LAS f32x4* ar = (const LAS f32x4*)(L0 + GL_GA + (8 * sg + ii) * 64); float u = ba_d;
#pragma unroll
                    for (int r4 = 0; r4 < 4; ++r4) { const f32x4 av = ar[r4]; u += av[0] * w2r[4 * r4] + av[1] * w2r[4 * r4 + 1] + av[2] * w2r[4 * r4 + 2] + av[3] * w2r[4 * r4 + 3]; }
                    const float ls = -__logf(1.f + __expf(-fmaxf(u, -80.f)));
                    const _Float16 lh = (_Float16)(ls * (1.f / 16.f)); hv[ii] = lh; run += (float)lh; p[ii] = run; }
                *(h8*)((_Float16*)(ws + WS_LAH) + ((size_t)(((b * NCH + g * GLA_GRP + c) * GH + h) * 64 + d_)) * 64 + 8 * sg) = hv;
              } else { const h8 hv = __builtin_bit_cast(h8, clah);
#pragma unroll
                for (int ii = 0; ii < 8; ++ii) { run += (float)hv[ii]; p[ii] = run; } }
              float x = run;
#pragma unroll
              for (int o = 1; o < 8; o <<= 1) { const float t = __int_as_float(__builtin_amdgcn_ds_bpermute(((lane - 8 * o) & 63) << 2, __float_as_int(x))); if (sg >= o) x += t; }
              const float off = x - run;
              const float bend = __int_as_float(__builtin_amdgcn_ds_bpermute((56 + dd_) << 2, __float_as_int(x)));
              if (sg == 7) *(LAS float*)(L0 + GL_DEC + d_ * 4) = __expf(bend);
              gtot += bend;
              float ke[8];
#pragma unroll
              for (int ii = 0; ii < 8; ++ii) { const float bb = off + p[ii], kf = bf2f(ck[ii] & 0xffffu); ke[ii] = kf * __expf(bend - bb);
                  if (OUT) { const float e = __expf(bb); const unsigned pq = pk2(bf2f(cq[ii] & 0xffffu) * e, kf * __builtin_amdgcn_rcpf(e));
                      *(LAS bf16*)(L0 + GL_QD + (8 * sg + ii) * GL_P + 2 * d_) = (bf16)(pq & 0xffffu); *(LAS bf16*)(L0 + GL_KI + (8 * sg + ii) * GL_P + 2 * d_) = (bf16)(pq >> 16); } }
              u32x4 kw; kw.x = pk2(ke[0], ke[1]); kw.y = pk2(ke[2], ke[3]); kw.z = pk2(ke[4], ke[5]); kw.w = pk2(ke[6], ke[7]);
              *(LAS u32x4*)(L0 + GL_KET + d_ * GL_P + 16 * sg) = kw; }
            { const int ip = ip_, c4 = c4_; const u32x4 v0 = cv0, v1 = cv1;
#pragma unroll
              for (int x = 0; x < 4; ++x) { *(LAS unsigned*)(L0 + GL_VT + (8 * c4 + 2 * x) * GL_P + 4 * ip) = (v0[x] & 0xffffu) | (v1[x] << 16);
                  *(LAS unsigned*)(L0 + GL_VT + (8 * c4 + 2 * x + 1) * GL_P + 4 * ip) = (v0[x] >> 16) | (v1[x] & 0xffff0000u); } }
            GLA_LSYNC();
            f32x4 ao[4];
            if (OUT) {
#pragma unroll
                for (int tt = 0; tt < 2; ++tt) { const int idx = w + 8 * tt, it = idx >> 2, jt = idx & 3; f32x4 a4 = (f32x4){0.f, 0.f, 0.f, 0.f};
#pragma unroll
                    for (int s2 = 0; s2 < 2; ++s2) { const pg::bf16x8 ka = *(const LAS pg::bf16x8*)(L0 + GL_KI + (16 * jt + L) * GL_P + (32 * s2 + 8 * q) * 2), qb = *(const LAS pg::bf16x8*)(L0 + GL_QD + (16 * it + L) * GL_P + (32 * s2 + 8 * q) * 2);
                        a4 = __builtin_amdgcn_mfma_f32_16x16x32_bf16(ka, qb, a4, 0, 0, 0); }
                    const int i = 16 * it + L, j0 = 16 * jt + 4 * q;
                    u32x2 o; o.x = pk2(j0 + 0 <= i ? a4[0] : 0.f, j0 + 1 <= i ? a4[1] : 0.f); o.y = pk2(j0 + 2 <= i ? a4[2] : 0.f, j0 + 3 <= i ? a4[3] : 0.f);
                    *(LAS u32x2*)(L0 + GL_ATT + i * GL_P + j0 * 2) = o; }
                GLA_LSYNC();
#pragma unroll
                for (int it = 0; it < 4; ++it) ao[it] = (f32x4){0.f, 0.f, 0.f, 0.f};
#pragma unroll
                for (int s2 = 0; s2 < 2; ++s2) { u32x4 sb; sb.x = pk2(S[2 * s2][0], S[2 * s2][1]); sb.y = pk2(S[2 * s2][2], S[2 * s2][3]); sb.z = pk2(S[2 * s2 + 1][0], S[2 * s2 + 1][1]); sb.w = pk2(S[2 * s2 + 1][2], S[2 * s2 + 1][3]);
                    const pg::bf16x8 bS = __builtin_bit_cast(pg::bf16x8, sb);
#pragma unroll
                    for (int it = 0; it < 4; ++it) { const u32x2 x0 = *(const LAS u32x2*)(L0 + GL_QD + (16 * it + L) * GL_P + (32 * s2 + 4 * q) * 2), x1 = *(const LAS u32x2*)(L0 + GL_QD + (16 * it + L) * GL_P + (32 * s2 + 16 + 4 * q) * 2);
                        u32x4 xa; xa.x = x0.x; xa.y = x0.y; xa.z = x1.x; xa.w = x1.y;
                        ao[it] = __builtin_amdgcn_mfma_f32_16x16x32_bf16(__builtin_bit_cast(pg::bf16x8, xa), bS, ao[it], 0, 0, 0); } }
            }
#pragma unroll
            for (int t = 0; t < 4; ++t) { const f32x4 dc = *(LAS f32x4*)(L0 + GL_DEC + (16 * t + 4 * q) * 4); S[t] = S[t] * dc; }
#pragma unroll
            for (int s2 = 0; s2 < 2; ++s2) { const pg::bf16x8 bV = *(const LAS pg::bf16x8*)(L0 + GL_VT + (16 * w + L) * GL_P + (32 * s2 + 8 * q) * 2);
                if (OUT) {
#pragma unroll
                    for (int it = 0; it < 4; ++it) { const pg::bf16x8 aa = *(const LAS pg::bf16x8*)(L0 + GL_ATT + (16 * it + L) * GL_P + (32 * s2 + 8 * q) * 2);
                        ao[it] = __builtin_amdgcn_mfma_f32_16x16x32_bf16(aa, bV, ao[it], 0, 0, 0); } }
#pragma unroll
                for (int t = 0; t < 4; ++t) { const pg::bf16x8 ka = *(const LAS pg::bf16x8*)(L0 + GL_KET + (16 * t + L) * GL_P + (32 * s2 + 8 * q) * 2);
                    S[t] = __builtin_amdgcn_mfma_f32_16x16x32_bf16(ka, bV, S[t], 0, 0, 0); } }
            if (OUT) {
#pragma unroll
                for (int it = 0; it < 4; ++it)
#pragma unroll
                    for (int rg = 0; rg < 4; ++rg) *(LAS float*)(L0 + GL_OB + ((16 * it + 4 * q + rg) * 132 + 16 * w + L) * 4) = ao[it][rg];
                GLA_LSYNC();
                { const int i = tid >> 3, c8 = tid & 7; f32x4 ov[4]; float ss = 0.f;
#pragma unroll
                  for (int x = 0; x < 4; ++x) { ov[x] = *(LAS f32x4*)(L0 + GL_OB + (i * 132 + 16 * c8 + 4 * x) * 4); ss += (ov[x][0] * ov[x][0] + ov[x][1] * ov[x][1]) + (ov[x][2] * ov[x][2] + ov[x][3] * ov[x][3]); }
                  ss += shx(ss, 1, lane); ss += shx(ss, 2, lane); ss += shx(ss, 4, lane);
                  const float rstd = 1.0f / sqrtf(ss * (1.f / 128.f) + EPS);
                  const size_t go = (size_t)(t0 + i) * 512 + h * 128 + 16 * c8;
#pragma unroll
                  for (int hh = 0; hh < 2; ++hh) { const u32x4 rr = hh ? cg1 : cg0; const f32x4 g0 = *(const f32x4*)(gn + h * 128 + 16 * c8 + 8 * hh), g1 = *(const f32x4*)(gn + h * 128 + 16 * c8 + 8 * hh + 4);
                      const f32x4 a = ov[2 * hh], bq = ov[2 * hh + 1]; u32x4 o;
                      o.x = pk2(a[0] * rstd * g0[0] * bf2f(rr.x & 0xffffu), a[1] * rstd * g0[1] * bf2f(rr.x >> 16)); o.y = pk2(a[2] * rstd * g0[2] * bf2f(rr.y & 0xffffu), a[3] * rstd * g0[3] * bf2f(rr.y >> 16));
                      o.z = pk2(bq[0] * rstd * g1[0] * bf2f(rr.z & 0xffffu), bq[1] * rstd * g1[1] * bf2f(rr.z >> 16)); o.w = pk2(bq[2] * rstd * g1[2] * bf2f(rr.w & 0xffffu), bq[3] * rstd * g1[3] * bf2f(rr.w >> 16));
                      *(u32x4*)(GO + go + 8 * hh) = o; } }
            }
            if (!OUT) { *(LAS u32x2*)(L0 + GL_GA + 8 * tid) = nga; GLA_LSYNC(); }
            cv0 = nv0; cv1 = nv1; cg0 = ng0; cg1 = ng1; cga = nga; clah = nlah;
#pragma unroll
            for (int ii = 0; ii < 8; ++ii) { ck[ii] = nk[ii]; cq[ii] = nq[ii]; }
        }
        if (!OUT) {
#pragma unroll
            for (int t = 0; t < 4; ++t)
#pragma unroll
                for (int rg = 0; rg < 4; ++rg) SLOC[((size_t)unit * 64 + 16 * t + 4 * q + rg) * 128 + 16 * w + L] = S[t][rg];
            if (sg == 0) GDEC[(size_t)unit * 64 + d_] = __expf(gtot);
        }
        }
    }
}


__device__ __forceinline__ void ph_mod(const Frame& F) {
    LAS float* cond = (LAS float*)F.lds;
    LAS float* part = cond + BATCH * D;
    for (int i = F.tid; i < BATCH * D; i += NTHREADS) cond[i] = siluf_(F.in(I_C)[i]);
    __syncthreads();
    float* mod = (float*)(F.ws() + WS_MOD);
    for (int item = F.bid; item < DEPTH * 96; item += F.G) {
        const int l = item / 96, j = (item % 96) * 64 + F.lane, k0 = F.wave * 128;
        float acc[BATCH];
#pragma unroll
        for (int b = 0; b < BATCH; ++b) acc[b] = 0.f;
        const float* w = F.in(I_WADA) + ((size_t)l * D + k0) * 6 * D + j;
#pragma unroll 8
        for (int k = 0; k < 128; ++k) { const float wv = w[(size_t)k * 6 * D];
#pragma unroll
            for (int b = 0; b < BATCH; ++b) acc[b] += cond[b * D + k0 + k] * wv; }
#pragma unroll
        for (int b = 0; b < BATCH; ++b) part[(F.wave * BATCH + b) * 64 + F.lane] = acc[b];
        __syncthreads();
        { const int b = F.wave; float sum = F.in(I_BADA)[l * 6 * D + j];
#pragma unroll
          for (int ww = 0; ww < NWAVES; ++ww) sum += part[(ww * BATCH + b) * 64 + F.lane];
          mod[(size_t)(l * BATCH + b) * 6 * D + j] = sum; }
        __syncthreads();
    }
}

constexpr int RT_CNT = 68608;
template <bool ROUTE, bool COMBINE, bool NORM, bool XBF, int XOUT>
__device__ __forceinline__ void ph_rows(const Frame& F, int l, int lc, const float* gain, int ch_sh, int ch_sc) {
    const float* xin = F.in(I_X); bf16* XB = (bf16*)(F.ws() + WS_XB);
    bf16* H = (bf16*)(F.ws() + WS_H);
    const bf16* YS = (const bf16*)(F.ws() + WS_YS); float* xo = F.out();
    if (COMBINE) moe_table(F, lc);
    const int lane = F.lane;
    const int NGW = F.G * NWAVES;
    if (ROUTE) {
        const bf16* WRT = (const bf16*)(F.ws() + WS_WRT);
        for (int i = F.tid; i < 2 * NE * (D / 8); i += NTHREADS) { const int row = i >> 7, c = i & 127; *(LAS u32x4*)(F.lds + row * 2064 + c * 16) = *(const u32x4*)(WRT + (size_t)row * D + c * 8); }
        if (F.tid < 32) *(LAS unsigned*)(F.lds + RT_CNT + 4 * F.tid) = 0u;
        __syncthreads();
    }
    for (int blk = F.bid * NWAVES + F.wave; blk < T / 32; blk += NGW) {
        const int m0 = blk * 32, b = m0 / SEQ;
        f32x4 ga[4], sh4[4], g2v[4];
#pragma unroll
        for (int j = 0; j < 4; ++j) { const int col = 4 * lane + 256 * j;
            if (NORM) { const f32x4 g = *(const f32x4*)(gain + col), s4 = *(const f32x4*)(mod_ptr(F, l, b, ch_sc) + col); ga[j] = g * (s4 + 1.f); sh4[j] = *(const f32x4*)(mod_ptr(F, l, b, ch_sh) + col); }
            if (COMBINE) g2v[j] = *(const f32x4*)(mod_ptr(F, lc, b, 5) + col); }
        u32x4 tinfo = (u32x4){0u, 0u, 0u, 0u};
        if (COMBINE) tinfo = *(const u32x4*)(F.ws() + WS_TINFO + (size_t)(m0 + (lane & 31)) * 16);
        constexpr int R = COMBINE ? 2 : 4;
        f32x4 v[R][4], vn[R][4]; unsigned long long ya[R][4], yc[R][4], yan[R][4], ycn[R][4]; float w0c[R], w1c[R], w0n[R], w1n[R];
#define ROWS_FETCH(V, YA, YC, W0, W1, rbase) do { \
            _Pragma("unroll") for (int rr = 0; rr < R; ++rr) _Pragma("unroll") for (int j = 0; j < 4; ++j) { const size_t xo_ = (size_t)(m0 + (rbase) + rr) * D + 4 * lane + 256 * j; \
                if (XBF) { const unsigned long long xw = __builtin_nontemporal_load((const unsigned long long*)(XB + xo_)); V[rr][j] = (f32x4){bf2f((unsigned)xw & 0xffffu), bf2f(((unsigned)xw) >> 16), bf2f((unsigned)(xw >> 32) & 0xffffu), bf2f((unsigned)(xw >> 48))}; } \
                else V[rr][j] = __builtin_nontemporal_load((const f32x4*)(xin + xo_)); } \
            if (COMBINE) { _Pragma("unroll") for (int rr = 0; rr < R; ++rr) { \
                const unsigned tx = __builtin_amdgcn_readlane(tinfo.x, (rbase) + rr), ty = __builtin_amdgcn_readlane(tinfo.y, (rbase) + rr); \
                W0[rr] = __uint_as_float(__builtin_amdgcn_readlane(tinfo.z, (rbase) + rr)) * (1.f / (F8_ACT * F8_WD)); W1[rr] = __uint_as_float(__builtin_amdgcn_readlane(tinfo.w, (rbase) + rr)) * (1.f / (F8_ACT * F8_WD)); \
                volatile LAS int* tb = (volatile LAS int*)(F.lds + MOE_TAB); \
                const size_t s0 = (size_t)(256 * tb[tx >> 16] + (int)(tx & 0xffffu)) * D, s1 = (size_t)(256 * tb[ty >> 16] + (int)(ty & 0xffffu)) * D; \
                _Pragma("unroll") for (int j = 0; j < 4; ++j) { YA[rr][j] = __builtin_nontemporal_load((const unsigned long long*)(YS + s0 + 4 * lane + 256 * j)); YC[rr][j] = __builtin_nontemporal_load((const unsigned long long*)(YS + s1 + 4 * lane + 256 * j)); } } } } while (0)
        ROWS_FETCH(v, ya, yc, w0c, w1c, 0);
#pragma unroll 1
        for (int r0 = 0; r0 < 32; r0 += R) {
            { const int rn = r0 + R < 32 ? r0 + R : r0; ROWS_FETCH(vn, yan, ycn, w0n, w1n, rn); }
            if (COMBINE) {
#pragma unroll
                for (int rr = 0; rr < R; ++rr) { const float w0 = w0c[rr], w1 = w1c[rr];
#pragma unroll
                    for (int j = 0; j < 4; ++j) { const size_t o = (size_t)(m0 + r0 + rr) * D + 4 * lane + 256 * j; const unsigned long long a = ya[rr][j], c = yc[rr][j];
                        v[rr][j].x += g2v[j].x * (w0 * bf2f((unsigned)a & 0xffffu) + w1 * bf2f((unsigned)c & 0xffffu)); v[rr][j].y += g2v[j].y * (w0 * bf2f(((unsigned)a) >> 16) + w1 * bf2f(((unsigned)c) >> 16));
                        v[rr][j].z += g2v[j].z * (w0 * bf2f((unsigned)(a >> 32) & 0xffffu) + w1 * bf2f((unsigned)(c >> 32) & 0xffffu)); v[rr][j].w += g2v[j].w * (w0 * bf2f((unsigned)(a >> 48)) + w1 * bf2f((unsigned)(c >> 48)));
                        if (XOUT == 2) __builtin_nontemporal_store(v[rr][j], (f32x4*)(xo + o));
                        if (XOUT == 1) *(unsigned long long*)(XB + o) = (unsigned long long)pk2(v[rr][j].x, v[rr][j].y) | ((unsigned long long)pk2(v[rr][j].z, v[rr][j].w) << 32); } }
            }
            if (NORM) {
                float ss[R];
#pragma unroll
                for (int rr = 0; rr < R; ++rr) { float s = 0.f;
#pragma unroll
                    for (int j = 0; j < 4; ++j) s += (v[rr][j].x * v[rr][j].x + v[rr][j].y * v[rr][j].y) + (v[rr][j].z * v[rr][j].z + v[rr][j].w * v[rr][j].w);
                    ss[rr] = s; }
#pragma unroll
                for (int o = 1; o < 64; o <<= 1) {
#pragma unroll
                    for (int rr = 0; rr < R; ++rr) ss[rr] += shx(ss[rr], o, lane); }
#pragma unroll
                for (int rr = 0; rr < R; ++rr) { const float rstd = 1.0f / sqrtf(ss[rr] * (1.f / D) + EPS);
#pragma unroll
                    for (int j = 0; j < 4; ++j) { v[rr][j] = v[rr][j] * rstd * ga[j] + sh4[j];
                        const unsigned long long o = (unsigned long long)pk2(v[rr][j].x, v[rr][j].y) | ((unsigned long long)pk2(v[rr][j].z, v[rr][j].w) << 32);
                        *((unsigned long long*)(H + (size_t)(m0 + r0 + rr) * D + 4 * lane + 256 * j)) = o;
                        if (!ROUTE) *(unsigned*)(F.ws() + WS_H8N + (size_t)(m0 + r0 + rr) * D + 4 * lane + 256 * j) = pk_fp8x4(F8_H * v[rr][j].x, F8_H * v[rr][j].y, F8_H * v[rr][j].z, F8_H * v[rr][j].w);
                        if (ROUTE && ((MK_FP8_MOE >> l) & 1u)) *(unsigned*)(F.ws() + WS_H8 + (size_t)(m0 + r0 + rr) * D + 4 * lane + 256 * j) = pk_fp8x4(F8_H * v[rr][j].x, F8_H * v[rr][j].y, F8_H * v[rr][j].z, F8_H * v[rr][j].w); } }
            }
#pragma unroll
            for (int rr = 0; rr < R; ++rr) { w0c[rr] = w0n[rr]; w1c[rr] = w1n[rr];
#pragma unroll
                for (int j = 0; j < 4; ++j) { v[rr][j] = vn[rr][j]; ya[rr][j] = yan[rr][j]; yc[rr][j] = ycn[rr][j]; } }
        }
#undef ROWS_FETCH
        if (ROUTE) {
            asm volatile("s_waitcnt vmcnt(0)" ::: "memory");
            const int rr_ = lane & 15, kq = lane >> 4;
            int re1[2], re2[2]; unsigned rp1[2] = {0u, 0u}, rp2[2] = {0u, 0u}; float rw1[2], rw2[2];
#pragma unroll
            for (int grp = 0; grp < 2; ++grp) {
                const int m = m0 + 16 * grp + rr_;
                f32x4 acc = (f32x4){0.f, 0.f, 0.f, 0.f};
#pragma unroll 1
                for (int hf = 0; hf < 2; ++hf) {
                    pg::bf16x8 hb[16];
#pragma unroll
                    for (int i = 0; i < 16; ++i) hb[i] = *(const pg::bf16x8*)(H + (size_t)m * D + 32 * (16 * hf + i) + 8 * kq);
#pragma unroll
                    for (int i = 0; i < 16; ++i) { const int co = (32 * (16 * hf + i) + 8 * kq) * 2;
                        const pg::bf16x8 wh = *(const LAS pg::bf16x8*)(F.lds + rr_ * 2064 + co), wlo = *(const LAS pg::bf16x8*)(F.lds + (NE + rr_) * 2064 + co);
                        acc = __builtin_amdgcn_mfma_f32_16x16x32_bf16(wh, hb[i], acc, 0, 0, 0);
                        acc = __builtin_amdgcn_mfma_f32_16x16x32_bf16(wlo, hb[i], acc, 0, 0, 0); }
                }
                float lgt[NE];
#pragma unroll
                for (int k2 = 0; k2 < 4; ++k2)
#pragma unroll
                    for (int rg = 0; rg < 4; ++rg) { const float av = rg == 0 ? acc.x : rg == 1 ? acc.y : rg == 2 ? acc.z : acc.w;
                        lgt[4 * k2 + rg] = __int_as_float(__builtin_amdgcn_ds_bpermute((rr_ + 16 * k2) << 2, __float_as_int(av))); }
                float aff[NE], sel[NE];
#pragma unroll
                for (int e = 0; e < NE; ++e) { aff[e] = sigmoidf_(lgt[e]); sel[e] = aff[e] + F.in(I_BR)[e]; }
                float best = 0.f; int bg = 0; float s0 = 0.f, s1 = 0.f, s2 = 0.f, s3 = 0.f, a0 = 0.f, a1 = 0.f, a2 = 0.f, a3 = 0.f;
#pragma unroll
                for (int g = 0; g < 4; ++g) {
                    const float x0 = sel[4 * g], x1 = sel[4 * g + 1], x2 = sel[4 * g + 2], x3 = sel[4 * g + 3];
                    const float lo01 = fminf(x0, x1), hi01 = fmaxf(x0, x1), lo23 = fminf(x2, x3), hi23 = fmaxf(x2, x3);
                    const float sc_ = fmaxf(hi01, hi23) + fmaxf(fminf(hi01, hi23), fmaxf(lo01, lo23));
                    if (g == 0 || sc_ > best) { best = sc_; bg = g; s0 = x0; s1 = x1; s2 = x2; s3 = x3; a0 = aff[4 * g]; a1 = aff[4 * g + 1]; a2 = aff[4 * g + 2]; a3 = aff[4 * g + 3]; }
                }
                int i1 = 0; float m1 = s0; if (s1 > m1) { m1 = s1; i1 = 1; } if (s2 > m1) { m1 = s2; i1 = 2; } if (s3 > m1) { m1 = s3; i1 = 3; }
                int i2 = -1; float m2 = 0.f;
                if (i1 != 0) { m2 = s0; i2 = 0; }
                if (i1 != 1 && (i2 < 0 || s1 > m2)) { m2 = s1; i2 = 1; }
                if (i1 != 2 && (i2 < 0 || s2 > m2)) { m2 = s2; i2 = 2; }
                if (i1 != 3 && (i2 < 0 || s3 > m2)) { m2 = s3; i2 = 3; }
                const float w1 = i1 == 0 ? a0 : i1 == 1 ? a1 : i1 == 2 ? a2 : a3;
                const float w2 = i2 == 0 ? a0 : i2 == 1 ? a1 : i2 == 2 ? a2 : a3;
                const float inv = 1.f / (w1 + w2);
                re1[grp] = bg * 4 + i1; re2[grp] = bg * 4 + i2; rw1[grp] = w1 * inv; rw2[grp] = w2 * inv;
                if (kq == 0) { rp1[grp] = __hip_atomic_fetch_add((LAS unsigned*)(F.lds + RT_CNT) + re1[grp], 1u, __ATOMIC_RELAXED, __HIP_MEMORY_SCOPE_WORKGROUP);
                               rp2[grp] = __hip_atomic_fetch_add((LAS unsigned*)(F.lds + RT_CNT) + re2[grp], 1u, __ATOMIC_RELAXED, __HIP_MEMORY_SCOPE_WORKGROUP); }
            }
            __syncthreads();
            if (F.tid < NE) { unsigned* cnt = (unsigned*)(F.ws() + WS_CTL) + CW_CNT + 64 * (NE * l); const unsigned c = *(LAS unsigned*)(F.lds + RT_CNT + 4 * F.tid);
                *(LAS unsigned*)(F.lds + RT_CNT + 64 + 4 * F.tid) = c ? atomicAdd(&cnt[64 * F.tid], c) : 0u; }
            __syncthreads();
            if (kq == 0) { int* tokl = (int*)(F.ws() + WS_TOKL);
#pragma unroll
                for (int grp = 0; grp < 2; ++grp) { const int m = m0 + 16 * grp + rr_;
                    const unsigned p1 = *(LAS unsigned*)(F.lds + RT_CNT + 64 + 4 * re1[grp]) + rp1[grp], p2 = *(LAS unsigned*)(F.lds + RT_CNT + 64 + 4 * re2[grp]) + rp2[grp];
                    tokl[(size_t)re1[grp] * ECAP + p1] = m; tokl[(size_t)re2[grp] * ECAP + p2] = m;
                    u32x4 ti; ti.x = ((unsigned)re1[grp] << 16) | p1; ti.y = ((unsigned)re2[grp] << 16) | p2; ti.z = __float_as_uint(rw1[grp]); ti.w = __float_as_uint(rw2[grp]);
                    *(u32x4*)(F.ws() + WS_TINFO + (size_t)m * 16) = ti; } }
        }
    }
}

constexpr int NPH_LAYER = 9, NPHASES = 2 + DEPTH * NPH_LAYER;
__global__ void __launch_bounds__(NTHREADS, 2) fwd(Args args) {
    extern __shared__ __attribute__((aligned(16))) unsigned char lds[];
    Frame F;
    F.lds = (LAS unsigned char*)lds; F.tid = threadIdx.x; F.lane = F.tid & 63; F.wave = __builtin_amdgcn_readfirstlane(F.tid >> 6);
    F.G = gridDim.x; F.bid = blockIdx.x;
    volatile LAS unsigned* MISC = (volatile LAS unsigned*)(F.lds + MISC_OFF);
    if (F.tid < 32) MISC[F.tid] = 0u;
    if (F.tid == 0) { volatile LAS unsigned long long* tb = (volatile LAS unsigned long long*)(F.lds + PTR_OFF);
#pragma unroll
        for (int i = 0; i < 22; ++i) tb[i] = (unsigned long long)args.in[i];
        tb[22] = (unsigned long long)args.out; tb[23] = (unsigned long long)args.ws; }
    __syncthreads();
    XcdBarrier bar; bar.bar = (unsigned*)(F.ws() + WS_CTL) + CW_BAR; bar.x = 0; bar.st = nullptr; bar.wave = (unsigned)F.wave;
#if !MK_PER_PHASE
    bar = xcd_barrier_post((unsigned*)(F.ws() + WS_CTL) + CW_BAR, MISC + 8, (unsigned)F.wave);
#endif
    const int lo = args.ph_lo, hi = args.ph_hi;
#define IN(k) (lo <= (k) && (k) < hi)
#define SEAM(k) do { if (IN(k) && IN((k) + 1)) xcd_barrier(bar); } while (0)
#define REP(k) for (int rep_ = 0; rep_ < (((MK_REPEAT >> (k)) & 1u) ? 2 : 1); ++rep_)
    if (IN(0)) { REP(0) { ph_mod(phase_frame(F)); } REP(1) { ph_weights(phase_frame(F)); ph_rope_table(phase_frame(F)); } } SEAM(0);
    for (int l = 0; l < DEPTH; ++l) {
        const int p0 = 1 + l * NPH_LAYER;
        if (IN(p0 + 0)) { if (l == 0) { REP(2) ph_rows<false, false, true, false, 0>(phase_frame(F), l, 0, F.in(I_NMIX) + l * D, 0, 1); } else ph_rows<false, true, true, true, 1>(phase_frame(F), l, l - 1, F.in(I_NMIX) + l * D, 0, 1); } SEAM(p0 + 0);
        if (IN(p0 + 1)) { ph_gemm1_mfma(phase_frame(F), l); ph_gemm1_gates(phase_frame(F), l); } SEAM(p0 + 1);
        if (IN(p0 + 2)) { REP(4) ph_gla_mfma<false>(phase_frame(F), l); REP(5) ph_swa_mfma(phase_frame(F), l); } SEAM(p0 + 2);
        if (IN(p0 + 3)) REP(6) ph_gla_mfma<true>(phase_frame(F), l); SEAM(p0 + 3);
        if (IN(p0 + 4)) REP(7) ph_gemm2_mfma(phase_frame(F), l); SEAM(p0 + 4);
        if (IN(p0 + 5)) { if (l == 0) { REP(8) ph_gemm3_mfma<false>(phase_frame(F), l); } else ph_gemm3_mfma<true>(phase_frame(F), l); } SEAM(p0 + 5);
        if (IN(p0 + 6)) { ph_rows<true, false, true, true, 0>(phase_frame(F), l, 0, F.in(I_NFFN) + l * D, 3, 4); } SEAM(p0 + 6);
        if (IN(p0 + 7)) { if ((MK_FP8_MOE >> l) & 1u) ph_moe_up_fp8(phase_frame(F), l); else ph_moe_up_mfma(phase_frame(F), l); } SEAM(p0 + 7);
        if (IN(p0 + 8)) { if ((MK_FP8_MOE >> l) & 1u) ph_moe_down_fp8(phase_frame(F), l); else ph_moe_down_mfma(phase_frame(F), l); } SEAM(p0 + 8);
    }
    if (IN(NPHASES - 1)) { ph_rows<false, true, false, true, 2>(phase_frame(F), 0, DEPTH - 1, nullptr, 0, 0); }
#undef REP
#undef IN
#undef SEAM
}

extern "C" void kernel_launch(void* const* d_in, const int* in_sizes, int n_in, void* d_out, int out_size, void* d_ws, size_t ws_size, hipStream_t stream) {
    static int grid = 0;
    if (grid == 0) {
        if (n_in != 22 || in_sizes[0] != T * D || out_size != T * D || ws_size < WS_END) { fprintf(stderr, "kernel_launch: unexpected shapes: n_in %d in0 %d out %d ws %zu (need %zu)\n", n_in, n_in > 0 ? in_sizes[0] : -1, out_size, ws_size, (size_t)WS_END); grid = -1; return; }
        int dev = 0, cus = 0, per_cu = 0;
        if (hipGetDevice(&dev) != hipSuccess || hipDeviceGetAttribute(&cus, hipDeviceAttributeMultiprocessorCount, dev) != hipSuccess) { grid = -1; return; }
        if (hipFuncSetAttribute((const void*)fwd, hipFuncAttributeMaxDynamicSharedMemorySize, LDS_BYTES) != hipSuccess) { fprintf(stderr, "kernel_launch: hipFuncSetAttribute failed\n"); grid = -1; return; }
        if (hipOccupancyMaxActiveBlocksPerMultiprocessor(&per_cu, (const void*)fwd, NTHREADS, LDS_BYTES) != hipSuccess || per_cu < 1) fprintf(stderr, "kernel_launch: occupancy query reports %d\n", per_cu);
        (void)hipGetLastError();
        grid = cus;
    }
    if (grid < 0) return;
    if (hipMemsetAsync((char*)d_ws + WS_CTL, 0, CTL_ZERO_BYTES, stream) != hipSuccess) return;
    Args a{};
    for (int i = 0; i < 22; ++i) a.in[i] = (const float*)d_in[i];
    a.out = (float*)d_out; a.ws = (unsigned char*)d_ws;
#if MK_PER_PHASE
    for (int p = 0; p < NPHASES; ++p) { a.ph_lo = p; a.ph_hi = p + 1; hipLaunchKernelGGL(fwd, dim3(grid), dim3(NTHREADS), LDS_BYTES, stream, a); }
#else
    a.ph_lo = 0; a.ph_hi = NPHASES; hipLaunchKernelGGL(fwd, dim3(grid), dim3(NTHREADS), LDS_BYTES, stream, a);
#endif
}
```

```cpp
#include <hip/hip_runtime.h>
#include <cstdio>
#include <cstdint>

#ifndef MK_REPEAT
#define MK_REPEAT 0u
#endif
#ifndef MK_FP8_MOE
#define MK_FP8_MOE 3u
#endif
#ifndef MK_PER_PHASE
#define MK_PER_PHASE 0
#endif

constexpr int D = 1024, BATCH = 8, SEQ = 8192, T = BATCH * SEQ, DEPTH = 2;
constexpr int GH = 4, GDK = 64, GDV = 128, GRANK = 16, GCH = 64, NCH = SEQ / GCH;
constexpr int SH = 8, SKV = 2, SHD = 64, WIN = 128;
constexpr int NE = 16, DFF = 512, ECAP = T;
constexpr int INW = 4368, NIN = 768, NGATE = 4352;
constexpr int C_GQ = 0, C_GK = 256, C_GV = 512, C_GA = 1024, C_GR = 1040, C_SQ = 1552, C_SK = 2064, C_SV = 2192, C_MA = 2320, C_MB = 3344;
constexpr float EPS = 1e-6f;
constexpr int NTHREADS = 512, NWAVES = 8;

constexpr size_t MiB = 1u << 20;
constexpr size_t WS_CTL = 0, CTL_ZERO_BYTES = 2 * MiB;
constexpr size_t WS_MOD = 1 * MiB;
constexpr size_t WS_TOKL = 2 * MiB;
constexpr size_t WS_WL = 6 * MiB;
constexpr size_t WS_GA = 10 * MiB;
constexpr size_t WS_DECAY = 14 * MiB;
constexpr size_t WS_WRT = 15 * MiB;
constexpr size_t WS_TINFO = 6 * MiB;
constexpr size_t WS_WIN_T = 16 * MiB;
constexpr size_t WS_WG_T = 34 * MiB, WS_WS_T = 36 * MiB;
constexpr size_t WS_WOUT_T = 38 * MiB;
constexpr size_t WS_WGU_T = 42 * MiB;
constexpr size_t WS_WD_T = 106 * MiB;
constexpr size_t WS_H = 138 * MiB;
constexpr size_t WS_STATE = WS_H;
constexpr size_t WS_GQ = 266 * MiB, WS_GK = 298 * MiB, WS_GV = 330 * MiB;
constexpr size_t WS_MERGED = WS_GQ;
constexpr size_t WS_GR = 394 * MiB;
constexpr size_t WS_SQ = 458 * MiB;
constexpr size_t WS_SK = 522 * MiB, WS_SV = 538 * MiB;
constexpr size_t WS_MA = 554 * MiB, WS_MB = 746 * MiB;
constexpr size_t WS_ACT = WS_MA;
constexpr size_t WS_GLAO = 810 * MiB, WS_SWAO = 154 * MiB;
constexpr size_t WS_XB = 874 * MiB;
constexpr size_t WS_ACT8 = 554 * MiB;
constexpr size_t WS_H8 = 620 * MiB;
constexpr size_t WS_H8N = 810 * MiB;
constexpr size_t WS_YS = 266 * MiB;
constexpr size_t WS_Y0 = 266 * MiB, WS_Y1 = 394 * MiB;
constexpr size_t WS_LAH = 218 * MiB;
constexpr size_t WS_ROPE = 1002 * MiB;
constexpr size_t WS_END = 1006 * MiB;

constexpr int CW_BAR = 4096;
constexpr int CW_CNT = 16384;

#define GAS __attribute__((address_space(1)))
#define LAS __attribute__((address_space(3)))
typedef unsigned short bf16;
typedef float f32x4 __attribute__((ext_vector_type(4)));
typedef unsigned u32x4 __attribute__((ext_vector_type(4)));

__device__ __forceinline__ unsigned f2bf(float f) { unsigned u = __builtin_bit_cast(unsigned, f); return (u + 0x7fffu + ((u >> 16) & 1u)) >> 16; }
__device__ __forceinline__ float bf2f(unsigned h) { return __builtin_bit_cast(float, h << 16); }
__device__ __forceinline__ float sigmoidf_(float v) { return 1.f / (1.f + __expf(-v)); }
__device__ __forceinline__ float siluf_(float v) { return v / (1.f + __expf(-v)); }
__device__ __forceinline__ float shx(float v, int o, int lane) { return __builtin_bit_cast(float, __builtin_amdgcn_ds_bpermute((lane ^ o) << 2, __builtin_bit_cast(int, v))); }
__device__ __forceinline__ float wave_sum(float v, int lane) {
#pragma unroll
    for (int o = 1; o < 64; o <<= 1) v += shx(v, o, lane);
    return v;
}

#define XB_TMO      128
#define XB_XCNT(j)  (256  + 64 * (j))
#define XB_XSUB(j)  (1280 + 64 * (j))
#define XB_XGEN(j)  (2304 + 64 * (j))
#define XB_TOP      3328
#define XB_TOPGEN   3392
#define XCD_BAR_WORDS 3456
#define XB_SPIN_CAP (1u << 24)
__device__ __forceinline__ unsigned xb_ld(unsigned* p)              { return __hip_atomic_load(p, __ATOMIC_RELAXED, __HIP_MEMORY_SCOPE_AGENT); }
__device__ __forceinline__ unsigned xb_add(unsigned* p, unsigned v) { return __hip_atomic_fetch_add(p, v, __ATOMIC_RELAXED, __HIP_MEMORY_SCOPE_AGENT); }
__device__ __forceinline__ unsigned xb_xcc_id() { return (unsigned)__builtin_amdgcn_s_getreg((3 << 11) | 20) & 0xFu; }
#define XB_SPIN(cond, bar) do { unsigned _sp = 0; while (cond) { __builtin_amdgcn_s_sleep(1); \
    if ((++_sp & 255u) == 0u) { if (xb_ld(&(bar)[XB_TMO])) break; if (_sp > XB_SPIN_CAP) { atomicAdd(&(bar)[XB_TMO], 1u); break; } } } } while (0)
struct XcdBarrier { unsigned* bar; unsigned x; volatile LAS unsigned* st; unsigned wave; };
__device__ __forceinline__ bool xb_thread0(unsigned wave) { unsigned z = 0u; asm volatile("" : "+v"(z)); return wave == 0u && __builtin_amdgcn_mbcnt_hi(~0u, __builtin_amdgcn_mbcnt_lo(~0u, z)) == 0u; }
__device__ __forceinline__ XcdBarrier xcd_barrier_post(unsigned* bar, volatile LAS unsigned* st, unsigned wave) {
    XcdBarrier b; b.bar = bar; b.x = xb_xcc_id(); b.st = st; b.wave = wave;
    if (xb_thread0(wave)) (void)xb_add(&bar[XB_XCNT(b.x)], 1u);
    return b;
}
__device__ __forceinline__ void xcd_barrier_complete(unsigned* bar, unsigned x, unsigned& nloc, unsigned& nx) {
    const unsigned G = gridDim.x * gridDim.y * gridDim.z;
    unsigned sum, cnt, mine, sp = 0u;
    for (;;) {
        sum = 0u; cnt = 0u; mine = 0u;
#pragma unroll
        for (unsigned j = 0; j < 16; ++j) { const unsigned c = xb_ld(&bar[XB_XCNT(j)]); sum += c; cnt += (c > 0u) ? 1u : 0u; mine = (j == x) ? c : mine; }
        if (sum == G) break;
        __builtin_amdgcn_s_sleep(1);
        if ((++sp & 255u) == 0u) { if (xb_ld(&bar[XB_TMO])) break; if (sp > XB_SPIN_CAP) { atomicAdd(&bar[XB_TMO], 1u); break; } }
    }
    nloc = mine > 0u ? mine : 1u; nx = cnt > 0u ? cnt : 1u;
}
__device__ __forceinline__ void xcd_barrier(const XcdBarrier& b) {
    asm volatile("s_waitcnt vmcnt(0)" ::: "memory");
    __syncthreads();
    if (xb_thread0(b.wave)) {
        unsigned* bar = b.bar;
        __builtin_amdgcn_s_waitcnt(0);
        unsigned nloc = b.st[0], nx = b.st[1];
        if (nloc == 0u) { xcd_barrier_complete(bar, b.x, nloc, nx); b.st[0] = nloc; b.st[1] = nx; }
        const unsigned old = xb_add(&bar[XB_XSUB(b.x)], 1u);
        const unsigned gen = old / nloc;
        if (old + 1u == (gen + 1u) * nloc) {
            __builtin_amdgcn_fence(__ATOMIC_RELEASE, "agent");
            asm volatile("s_waitcnt vmcnt(0)" ::: "memory");
            const unsigned og = xb_add(&bar[XB_TOP], 1u);
            const unsigned tg = og / nx;
            if (og + 1u == (tg + 1u) * nx) xb_add(&bar[XB_TOPGEN], 1u);
            else XB_SPIN(xb_ld(&bar[XB_TOPGEN]) == tg, bar);
            __builtin_amdgcn_fence(__ATOMIC_ACQUIRE, "agent");
            xb_add(&bar[XB_XGEN(b.x)], 1u);
            asm volatile("s_waitcnt vmcnt(0)" ::: "memory");
        } else {
            XB_SPIN(xb_ld(&bar[XB_XGEN(b.x)]) == gen, bar);
            __builtin_amdgcn_fence(__ATOMIC_ACQUIRE, "agent");
            asm volatile("s_waitcnt vmcnt(0)" ::: "memory");
        }
    }
    __syncthreads();
}

constexpr int LDS_BYTES = 147456;
constexpr int MISC_OFF = 131072 + 320;

struct Args { const float* in[22]; float* out; unsigned char* ws; int ph_lo, ph_hi; };

constexpr int PTR_OFF = MISC_OFF + 128;
struct Frame {
    LAS unsigned char* lds;
    int tid, lane, wave, G, bid;
    __device__ __forceinline__ unsigned long long ptr(int i) const {
        const unsigned long long v = ((volatile LAS unsigned long long*)(lds + PTR_OFF))[i];
        const unsigned lo = __builtin_amdgcn_readfirstlane((unsigned)v), hi = __builtin_amdgcn_readfirstlane((unsigned)(v >> 32));
        return ((unsigned long long)hi << 32) | lo;
    }
    __device__ __forceinline__ const float* in(int i) const { return (const float*)(const GAS float*)ptr(i); }
    __device__ __forceinline__ float* out() const { return (float*)(GAS float*)ptr(22); }
    __device__ __forceinline__ unsigned char* ws() const { return (unsigned char*)(GAS unsigned char*)ptr(23); }
};
__device__ __forceinline__ Frame phase_frame(const Frame& F) {
    Frame P = F; unsigned l = (unsigned)(unsigned long long)P.lds;
    asm volatile("" : "+s"(P.wave), "+s"(P.G), "+s"(P.bid), "+s"(l));
    unsigned z_ = 0u; asm volatile("" : "+v"(z_));
    P.lane = (int)__builtin_amdgcn_mbcnt_hi(~0u, __builtin_amdgcn_mbcnt_lo(~0u, z_));
    P.tid = P.wave * 64 + P.lane;
    asm volatile("" : "+v"(P.tid), "+v"(P.lane));
    P.lds = (LAS unsigned char*)(unsigned long long)l; return P;
}
enum { I_X = 0, I_C, I_POS, I_WADA, I_BADA, I_NMIX, I_WIN, I_WA2, I_BA, I_GNORM, I_QN, I_KN, I_SINK, I_WUG, I_WUS, I_WOUT, I_NFFN, I_WR, I_BR, I_WGATE, I_WUP, I_WDOWN };

__device__ __forceinline__ const float* mod_ptr(const Frame& F, int l, int b, int chunk) { return (const float*)(F.ws() + WS_MOD) + ((size_t)(l * BATCH + b) * 6 + chunk) * D; }
namespace pg {
typedef short bf16x8 __attribute__((ext_vector_type(8)));
constexpr int BM = 256, BK = 64, HALF = 128, HTB = HALF * BK * 2, STAGE_BYTES = 8 * HTB;
__host__ __device__ __forceinline__ int lds_byte(int r, int c) { const int st = (r >> 4) * 2 + (c >> 5), rr = r & 15, cc = c & 31, ob = rr * 64 + cc * 2; return st * 1024 + (ob ^ (((ob >> 9) & 1) << 5)); }
__host__ __device__ __forceinline__ void stage_rc(int b, int& R, int& C) { const int st = b / 1024, sb = b % 1024, swz = sb ^ (((sb >> 9) & 1) << 5); R = (st >> 1) * 16 + swz / 64; C = (st & 1) * 32 + (swz % 64) / 2; }
__host__ __device__ __forceinline__ int perm32(int rho) { const int n = rho >> 4, i = rho & 15; return 8 * (i >> 2) + 4 * n + (i & 3); }
typedef int i32x4 __attribute__((ext_vector_type(4)));
typedef int i32x8 __attribute__((ext_vector_type(8)));
__device__ __forceinline__ i32x8 pg_cat(bf16x8 lo, bf16x8 hi) { const i32x4 a = __builtin_bit_cast(i32x4, lo), b = __builtin_bit_cast(i32x4, hi); return __builtin_shufflevector(a, b, 0, 1, 2, 3, 4, 5, 6, 7); }
struct Unit { const char* A; const char* B; int pm, pn, e, j, valid, keep; };
__device__ __forceinline__ unsigned cvt_pk_bf16(float lo, float hi) { unsigned r; asm volatile("v_cvt_pk_bf16_f32 %0, %1, %2" : "=v"(r) : "v"(lo), "v"(hi)); return r; }

template <class S> __device__ __forceinline__ auto sched_wide(const S& s, const Unit& u, int) -> decltype(s.wide(u)) { return s.wide(u); }
template <class S> __device__ __forceinline__ bool sched_wide(const S&, const Unit&, long) { return false; }
template <bool GATHER, bool FP8, class Epi, class Sched, int LAYOUT = 0>
__device__ __forceinline__ void gemm_phase(LAS unsigned char* lds, const int tid, const int K, const Sched& S, const Epi& E) {
    const int wid = __builtin_amdgcn_readfirstlane(tid >> 6), lane = tid & 63, wr = wid >> 2, wc = wid & 3, fr = lane & 15, fq = lane >> 4;
    const int nt = K / BK;
    int RA[2], CA[2]; unsigned voffB[2], voffW[2];
#pragma unroll
    for (int i = 0; i < 2; ++i) { int R, C; stage_rc(tid * 16 + i * 8192, R, C); const int RbW = 64 * (R >> 5) + 16 * ((R >> 2) & 3) + 4 * ((R >> 4) & 1) + (R & 3), RbP = (R & ~31) + perm32(R & 31);
        RA[i] = R; CA[i] = C * 2; voffB[i] = (unsigned)((LAYOUT == 1 ? RbW : RbP) * K + C) * 2u; voffW[i] = (unsigned)(RbW * K + C) * 2u; }
    const size_t kstep = (size_t)(BK * 2);
    const size_t hstep = (size_t)HALF * K * 2;
    const size_t hstepW = (size_t)8 * K * 2;
#define PG_HSB(w) (LAYOUT == 1 ? hstepW : LAYOUT == 0 ? hstep : ((w) ? hstepW : hstep))
    const unsigned ldsw = (unsigned)wid * 1024u;
    const int aoff = lds_byte(wr * 64 + fr, fq * 8), boff = lds_byte(wc * 32 + fr, fq * 8);
#define PG_SA(b, h) (((b) * 2 + (h)) * HTB)
#define PG_SB(b, h) ((4 + (b) * 2 + (h)) * HTB)
#define PG_STAGEB(bufoff, gbase, w) do { _Pragma("unroll") for (int _i = 0; _i < 2; ++_i) { unsigned _o = (LAYOUT == 2 && (w)) ? voffW[_i] : voffB[_i]; asm volatile("" : "+v"(_o)); \
        __builtin_amdgcn_global_load_lds((const unsigned*)((const char*)(gbase) + _o), (LAS unsigned*)(lds + (bufoff) + ldsw + _i * 8192), 16, 0, 0); } } while (0)
#define PG_STAGEA(bufoff, gbase, o0, o1) do { unsigned _o0 = (o0), _o1 = (o1); asm volatile("" : "+v"(_o0), "+v"(_o1)); \
        __builtin_amdgcn_global_load_lds((const unsigned*)((const char*)(gbase) + _o0), (LAS unsigned*)(lds + (bufoff) + ldsw), 16, 0, 0); \
        __builtin_amdgcn_global_load_lds((const unsigned*)((const char*)(gbase) + _o1), (LAS unsigned*)(lds + (bufoff) + ldsw + 8192), 16, 0, 0); } while (0)
#define PG_LDA(dst, b, h) do { _Pragma("unroll") for (int m = 0; m < 4; ++m) { const i32x4 lo_ = *(const LAS i32x4*)(lds + PG_SA(b, h) + aoff + m * 2048), hi_ = *(const LAS i32x4*)(lds + PG_SA(b, h) + aoff + m * 2048 + 1024); \
        dst[m] = __builtin_shufflevector(lo_, hi_, 0, 1, 2, 3, 4, 5, 6, 7); } } while (0)
#define PG_LDB(dst, b, h) do { _Pragma("unroll") for (int n = 0; n < 2; ++n) { const i32x4 lo_ = *(const LAS i32x4*)(lds + PG_SB(b, h) + boff + n * 2048), hi_ = *(const LAS i32x4*)(lds + PG_SB(b, h) + boff + n * 2048 + 1024); \
        dst[n] = __builtin_shufflevector(lo_, hi_, 0, 1, 2, 3, 4, 5, 6, 7); } } while (0)
#define PG_HALF(v, k) __builtin_bit_cast(bf16x8, (k) ? __builtin_shufflevector(v, v, 4, 5, 6, 7) : __builtin_shufflevector(v, v, 0, 1, 2, 3))
#define PG_MMA(ai, bj, At, Bt) do { __builtin_amdgcn_s_setprio(1); _Pragma("unroll") for (int m = 0; m < 4; ++m) _Pragma("unroll") for (int n = 0; n < 2; ++n) { \
        if (FP8) { acc[ai][bj][m][n] = __builtin_amdgcn_mfma_scale_f32_16x16x128_f8f6f4(Bt[n], At[m], acc[ai][bj][m][n], 0, 0, 0, 0, 0, 0); } \
        else { _Pragma("unroll") for (int k = 0; k < 2; ++k) acc[ai][bj][m][n] = __builtin_amdgcn_mfma_f32_16x16x32_bf16(PG_HALF(Bt[n], k), PG_HALF(At[m], k), acc[ai][bj][m][n], 0, 0, 0); } } \
        __builtin_amdgcn_s_setprio(0); } while (0)
#define PG_WAIT_V(n) asm volatile("s_waitcnt vmcnt(" #n ")" ::: "memory")
#define PG_WAIT_L(n) asm volatile("s_waitcnt lgkmcnt(" #n ")" ::: "memory")
#define PG_BAR __builtin_amdgcn_s_barrier()
#define PG_SCHED __builtin_amdgcn_sched_barrier(0)
    Unit cur, nxt; int ui = 0;
    if (!S.next(0, cur)) return;
    f32x4 acc[2][2][4][2];
#pragma unroll
    for (int a = 0; a < 2; ++a)
#pragma unroll
        for (int b = 0; b < 2; ++b)
#pragma unroll
            for (int m = 0; m < 4; ++m)
#pragma unroll
                for (int n = 0; n < 2; ++n) acc[a][b][m][n] = (f32x4){0.f, 0.f, 0.f, 0.f};
    i32x8 At[4], B0[2], B1[2];
    unsigned vA0, vA1, vA2, vA3, vN0, vN1, vN2, vN3;
    if (GATHER) { vA0 = S.rowoff(cur, RA[0]) + CA[0]; vA1 = S.rowoff(cur, RA[1]) + CA[1]; vA2 = S.rowoff(cur, HALF + RA[0]) + CA[0]; vA3 = S.rowoff(cur, HALF + RA[1]) + CA[1]; }
    else { vA0 = (unsigned)(RA[0] * K * 2 + CA[0]); vA1 = (unsigned)(RA[1] * K * 2 + CA[1]); vA2 = vA0; vA3 = vA1; }
    vN0 = vA0; vN1 = vA1; vN2 = vA2; vN3 = vA3;
    const size_t ah = GATHER ? (size_t)0 : hstep;
    const char* cA = cur.A; const char* cB = cur.B;
    const bool w0_ = LAYOUT == 2 && sched_wide(S, cur, 0);
    PG_STAGEB(PG_SB(0, 0), cB, w0_); PG_STAGEB(PG_SB(0, 1), cB + PG_HSB(w0_), w0_); PG_STAGEA(PG_SA(0, 0), cA, vA0, vA1); PG_STAGEA(PG_SA(0, 1), cA + ah, vA2, vA3);
    if (wr == 1) PG_BAR;
    PG_WAIT_V(2); PG_BAR;
    PG_STAGEB(PG_SB(1, 0), cB + kstep, w0_); PG_STAGEA(PG_SA(1, 0), cA + kstep, vA0, vA1); PG_STAGEB(PG_SB(1, 1), cB + PG_HSB(w0_) + kstep, w0_);
    PG_WAIT_V(6); PG_BAR;
    for (;;) {
        const bool has_next = S.next(ui + 1, nxt);
        const char* nA = has_next ? nxt.A : cA; const char* nB = has_next ? nxt.B : cB;
        if (GATHER) { if (has_next) { int t2 = tid; asm volatile("" : "+v"(t2)); int R0, C0, R1, C1; stage_rc(t2 * 16, R0, C0); stage_rc(t2 * 16 + 8192, R1, C1);
                vN0 = S.rowoff(nxt, R0) + 2 * C0; vN1 = S.rowoff(nxt, R1) + 2 * C1; vN2 = S.rowoff(nxt, HALF + R0) + 2 * C0; vN3 = S.rowoff(nxt, HALF + R1) + 2 * C1; }
            else { vN0 = vA0; vN1 = vA1; vN2 = vA2; vN3 = vA3; } }
#pragma unroll 1
        for (int t = 0; t < nt; t += 2) {
            const bool last = (t == nt - 2); const bool wl_ = LAYOUT == 2 && ((last && has_next) ? sched_wide(S, nxt, 0) : sched_wide(S, cur, 0));
            const char* a1 = cA + (size_t)(t + 1) * kstep;
            const char* a2 = last ? nA : cA + (size_t)(t + 2) * kstep; const char* b2 = last ? nB : cB + (size_t)(t + 2) * kstep;
            const char* a3 = a2 + kstep; const char* b3 = b2 + kstep;
            PG_LDB(B0, 0, 0); PG_LDB(B1, 0, 1); PG_SCHED; PG_LDA(At, 0, 0); PG_STAGEA(PG_SA(1, 1), a1 + ah, vA2, vA3);
            if (GATHER && last) { vA0 = vN0; vA1 = vN1; vA2 = vN2; vA3 = vN3; }
            PG_WAIT_V(8); PG_WAIT_L(0); PG_BAR; PG_MMA(0, 0, At, B0); PG_MMA(0, 1, At, B1); PG_BAR; PG_SCHED;
            PG_LDA(At, 0, 1); PG_STAGEB(PG_SB(0, 0), b2, wl_); PG_STAGEB(PG_SB(0, 1), b2 + PG_HSB(wl_), wl_); PG_STAGEA(PG_SA(0, 0), a2, vA0, vA1);
            PG_WAIT_V(8); PG_WAIT_L(0); PG_BAR; PG_MMA(1, 0, At, B0); PG_MMA(1, 1, At, B1); PG_BAR; PG_SCHED;
            PG_LDB(B0, 1, 0); PG_LDB(B1, 1, 1); PG_SCHED; PG_LDA(At, 1, 0); PG_STAGEA(PG_SA(0, 1), a2 + ah, vA2, vA3);
            PG_WAIT_V(8); PG_WAIT_L(0); PG_BAR; PG_MMA(0, 0, At, B0); PG_MMA(0, 1, At, B1); PG_BAR; PG_SCHED;
            PG_LDA(At, 1, 1); PG_STAGEB(PG_SB(1, 0), b3, wl_); PG_STAGEB(PG_SB(1, 1), b3 + PG_HSB(wl_), wl_); PG_STAGEA(PG_SA(1, 0), a3, vA0, vA1);
            PG_WAIT_V(8); PG_WAIT_L(0); PG_BAR; PG_MMA(1, 0, At, B0); PG_MMA(1, 1, At, B1); PG_BAR; PG_SCHED;
        }
        if (wr == 0) PG_BAR;
        { unsigned z_ = 0u; asm volatile("" : "+v"(z_)); const int le_ = (int)__builtin_amdgcn_mbcnt_hi(~0u, __builtin_amdgcn_mbcnt_lo(~0u, z_));
          E(acc, cur, wr, wc, le_ & 15, le_ >> 4); }
        if (!has_next) break;
        if (!cur.keep) {
#pragma unroll
            for (int a = 0; a < 2; ++a)
#pragma unroll
                for (int b = 0; b < 2; ++b)
#pragma unroll
                    for (int m = 0; m < 4; ++m)
#pragma unroll
                        for (int n = 0; n < 2; ++n) acc[a][b][m][n] = (f32x4){0.f, 0.f, 0.f, 0.f};
        }
        cur = nxt; cA = nA; cB = nB; if (GATHER) { vA0 = vN0; vA1 = vN1; vA2 = vN2; vA3 = vN3; } ++ui;
        if (wr == 1) PG_BAR;
    }
    PG_WAIT_V(0);
    PG_BAR;
#undef PG_SA
#undef PG_SB
#undef PG_STAGEA
#undef PG_STAGEB
#undef PG_HSB
#undef PG_LDA
#undef PG_LDB
#undef PG_HALF
#undef PG_MMA
#undef PG_WAIT_V
#undef PG_WAIT_L
#undef PG_BAR
#undef PG_SCHED
}
struct DenseOrder {
    const char* A; const char* B; int K, nM, nN, nwg, G, c;
    __device__ __forceinline__ void init(const void* A_, const void* B_, int M, int N, int K_, int G_, int c_) { A = (const char*)A_; B = (const char*)B_; K = K_; nM = M / BM; nN = N / BM; nwg = nM * nN; G = G_; c = c_; }
    __device__ __forceinline__ bool tile(int i, int& pm, int& pn) const {
        const long L = (long)i * G + c; if (L >= nwg) return false;
        int wgid = (int)L; { const int q = nwg / 8, r = nwg % 8, xcd = wgid % 8, off = wgid / 8; wgid = (xcd < r ? xcd * (q + 1) : r * (q + 1) + (xcd - r) * q) + off; }
        const int nig = 8 * nN, gid = wgid / nig, fm = gid * 8, gsz = (nM - fm) < 8 ? (nM - fm) : 8;
        pm = fm + ((wgid % nig) % gsz); pn = (wgid % nig) / gsz; return true;
    }
    __device__ __forceinline__ bool next(int i, Unit& u) const {
        int pm, pn; if (!tile(i, pm, pn)) return false;
        u.pm = pm; u.pn = pn; u.e = 0; u.j = 0; u.valid = 256; u.keep = 0;
        u.A = A + (size_t)pm * BM * K * 2; u.B = B + (size_t)pn * BM * K * 2; return true;
    }
    __device__ __forceinline__ unsigned rowoff(const Unit&, int r) const { return (unsigned)(r * K * 2); }
};
template <int NM, int NN>
struct DenseOrderT {
    const char* A; const char* B; int K, G, c;
    __device__ __forceinline__ void init(const void* A_, const void* B_, int K_, int G_, int c_) { A = (const char*)A_; B = (const char*)B_; K = K_; G = G_; c = c_; }
    __device__ __forceinline__ bool tile(int i, int& pm, int& pn) const {
        constexpr int nwg = NM * NN; static_assert(nwg % 8 == 0 && NM % 8 == 0, "whole XCD chunks and whole 8-panel groups");
        const int L = i * G + c; if (L >= nwg) return false;
        const int wgid = (L % 8) * (nwg / 8) + L / 8;
        constexpr int nig = 8 * NN; const int gid = wgid / nig, rem = wgid % nig;
        pm = gid * 8 + (rem % 8); pn = rem / 8; return true;
    }
    __device__ __forceinline__ bool next(int i, Unit& u) const {
        int pm, pn; if (!tile(i, pm, pn)) return false;
        u.pm = pm; u.pn = pn; u.e = 0; u.j = 0; u.valid = 256; u.keep = 0;
        u.A = A + (size_t)pm * BM * K * 2; u.B = B + (size_t)pn * BM * K * 2; return true;
    }
    __device__ __forceinline__ unsigned rowoff(const Unit&, int r) const { return (unsigned)(r * K * 2); }
};
}

__device__ __forceinline__ unsigned pk2(float lo, float hi) { unsigned r; asm("v_cvt_pk_bf16_f32 %0, %1, %2" : "=v"(r) : "v"(lo), "v"(hi)); return r; }
__device__ __forceinline__ unsigned pk_fp8x4(float a, float b, float c, float d) {
    int p = __builtin_amdgcn_cvt_pk_fp8_f32(a, b, 0, false); p = __builtin_amdgcn_cvt_pk_fp8_f32(c, d, p, true); return (unsigned)p; }
static_assert(MK_FP8_MOE == 3u, "the fp8 gate weights of GEMM1 sit in the half of each layer's WGU_T slot that only an fp8 expert layer leaves free");
constexpr float F8_H = 8.f, F8_WGU = 128.f, F8_ACT = 4.f, F8_WD = 4.f, F8_Y = 16.f, F8_MG = 8.f, F8_WO = 128.f, F8_AO = 8.f, F8_WU = 128.f, F8_QKV = 4.f;
__device__ __forceinline__ void tr_item8(const float* W, int ldw, int src_c0, int k0, unsigned char* WT0, int K, float scale, LAS float* scr, int lane) {
    float tv[32];
#pragma unroll
    for (int i = 0; i < 32; ++i) tv[i] = __builtin_nontemporal_load(W + (size_t)(k0 + 2 * i + (lane >> 5)) * ldw + src_c0 + (lane & 31));
#pragma unroll
    for (int i = 0; i < 32; ++i) scr[(2 * i + (lane >> 5)) * 33 + (lane & 31)] = tv[i] * scale;
    asm volatile("s_waitcnt lgkmcnt(0)" ::: "memory");
    const int c = lane & 7;
#pragma unroll
    for (int j = 0; j < 4; ++j) { const int n = (lane >> 3) + 8 * j; const LAS float* sp = scr + (8 * c) * 33 + n;
        typedef unsigned u32x2_ __attribute__((ext_vector_type(2)));
        u32x2_ o; o.x = pk_fp8x4(sp[0 * 33], sp[1 * 33], sp[2 * 33], sp[3 * 33]); o.y = pk_fp8x4(sp[4 * 33], sp[5 * 33], sp[6 * 33], sp[7 * 33]);
        *(u32x2_*)(WT0 + (size_t)n * K + 8 * c) = o; }
    asm volatile("s_waitcnt lgkmcnt(0)" ::: "memory");
}
__device__ __forceinline__ void tr_item(const float* W, int ldw, int src_c0, int k0, bf16* WT0, int K, LAS float* scr, int lane) {
    float tv[32];
#pragma unroll
    for (int i = 0; i < 32; ++i) tv[i] = W[(size_t)(k0 + 2 * i + (lane >> 5)) * ldw + src_c0 + (lane & 31)];
#pragma unroll
    for (int i = 0; i < 32; ++i) scr[(2 * i + (lane >> 5)) * 33 + (lane & 31)] = tv[i];
    asm volatile("s_waitcnt lgkmcnt(0)" ::: "memory");
    const int c = lane & 7;
#pragma unroll
    for (int j = 0; j < 4; ++j) { const int n = (lane >> 3) + 8 * j; const LAS float* sp = scr + (8 * c) * 33 + n;
        u32x4 o; o.x = pk2(sp[0 * 33], sp[1 * 33]); o.y = pk2(sp[2 * 33], sp[3 * 33]); o.z = pk2(sp[4 * 33], sp[5 * 33]); o.w = pk2(sp[6 * 33], sp[7 * 33]);
        *(u32x4*)(WT0 + (size_t)n * K + 8 * c) = o; }
    asm volatile("s_waitcnt lgkmcnt(0)" ::: "memory");
}
__device__ __forceinline__ int win_src_col(int d) { return C_GR + d; }
__device__ __forceinline__ int gate_src_col(int v) {
    if (v < 1792) return v < 256 ? C_GQ + v : v < 512 ? C_GK + (v - 256) : v < 1024 ? C_GV + (v - 512) : v < 1536 ? C_SQ + (v - 1024) : v < 1664 ? C_SK + (v - 1536) : C_SV + (v - 1664);
    if (v >= 3840) return C_GR + (v - 3840);
    const int g = v - 1792; return ((g >> 7) & 1 ? C_MB : C_MA) + 128 * (g >> 8) + (g & 127);
}
__device__ __forceinline__ void ph_weights(const Frame& F) {
    LAS float* scr = (LAS float*)(F.lds + F.wave * 16384);
    const int gw = F.bid * NWAVES + F.wave, NGW = F.G * NWAVES;
    unsigned char* ws = F.ws();
    constexpr int IA = 0, IG = 16 * 136, IB1 = 8 * 32, IB3 = 16 * 32, IC = 16 * 32, ID = 8 * 32;
    constexpr int NG = DEPTH * IG, NA = DEPTH * IA, NB = DEPTH * (2 * IB1 + IB3), NC = DEPTH * NE * IC, ND = DEPTH * NE * ID;
    for (int it = gw; it < NG + NA + NB + NC + ND; it += NGW) {
        int r = it;
        if (r < NG) { const int l = r / IG, q = r % IG, kb = q / 136, nb = q % 136;
            tr_item8(F.in(I_WIN) + (size_t)l * D * INW, INW, gate_src_col(32 * nb), 64 * kb, ws + WS_WGU_T + (size_t)l * NE * 1024 * D * 2 + 16 * MiB + (size_t)(32 * nb) * D + 64 * kb, D, F8_WGU, scr, F.lane); continue; }
        r -= NG;
        if (r < NB) { const int l = r / (2 * IB1 + IB3); int q = r % (2 * IB1 + IB3);
            if (q < IB1) { const int kb = q / 32, nb = q % 32; tr_item8(F.in(I_WUG) + (size_t)l * 512 * D, D, 32 * nb, 64 * kb, ws + WS_WG_T + ((size_t)l * D + 32 * nb) * 512 + 64 * kb, 512, F8_WU, scr, F.lane); continue; }
            q -= IB1;
            if (q < IB1) { const int kb = q / 32, nb = q % 32; tr_item8(F.in(I_WUS) + (size_t)l * 512 * D, D, 32 * nb, 64 * kb, ws + WS_WS_T + ((size_t)l * D + 32 * nb) * 512 + 64 * kb, 512, F8_WU, scr, F.lane); continue; }
            q -= IB1;
            { const int kb = q / 32, nb = q % 32; tr_item8(F.in(I_WOUT) + (size_t)l * D * D, D, 32 * nb, 64 * kb, ws + WS_WOUT_T + ((size_t)l * D + 32 * nb) * D + 64 * kb, D, F8_WO, scr, F.lane); continue; } }
        r -= NB;
        if (r < NC) { const int le = r / IC, q = r % IC, kb = q / 32, nb = q % 32, drow = 32 * nb, pn = drow >> 8, up = (drow >> 7) & 1, f0 = drow & 127;
            if ((MK_FP8_MOE >> (le / NE)) & 1u) { tr_item8((up ? F.in(I_WUP) : F.in(I_WGATE)) + (size_t)le * D * DFF, DFF, 128 * pn + f0, 64 * kb,
                    ws + WS_WGU_T + (size_t)(le / NE) * NE * 1024 * D * 2 + ((size_t)(le % NE) * 1024 + drow) * D + 64 * kb, D, F8_WGU, scr, F.lane); continue; }
            tr_item((up ? F.in(I_WUP) : F.in(I_WGATE)) + (size_t)le * D * DFF, DFF, 128 * pn + f0, 64 * kb, (bf16*)(ws + WS_WGU_T) + ((size_t)le * 1024 + drow) * D + 64 * kb, D, scr, F.lane); continue; }
        r -= NC;
        { const int le = r / ID, q = r % ID, kb = q / 32, nb = q % 32;
            if ((MK_FP8_MOE >> (le / NE)) & 1u) { tr_item8(F.in(I_WDOWN) + (size_t)le * DFF * D, D, 32 * nb, 64 * kb,
                    ws + WS_WD_T + (size_t)(le / NE) * NE * 1024 * DFF * 2 + ((size_t)(le % NE) * D + 32 * nb) * DFF + 64 * kb, DFF, F8_WD, scr, F.lane); continue; }
            tr_item(F.in(I_WDOWN) + (size_t)le * DFF * D, D, 32 * nb, 64 * kb, (bf16*)(ws + WS_WD_T) + ((size_t)le * D + 32 * nb) * DFF + 64 * kb, DFF, scr, F.lane); }
    }
    for (int idx = F.bid * NTHREADS + F.tid; idx < DEPTH * 256 * (D / 8); idx += F.G * NTHREADS) {
        const int l = idx / (256 * (D / 8)), q = idx % (256 * (D / 8)), rr = q / (D / 8), k0 = (q % (D / 8)) * 8;
        typedef unsigned u32x2_ __attribute__((ext_vector_type(2)));
        u32x2_ o = (u32x2_){0u, 0u};
        if (rr < GRANK) { const float* w = F.in(I_WIN) + (size_t)l * D * INW + C_GA + rr;
            o.x = pk_fp8x4(F8_WGU * w[(size_t)(k0 + 0) * INW], F8_WGU * w[(size_t)(k0 + 1) * INW], F8_WGU * w[(size_t)(k0 + 2) * INW], F8_WGU * w[(size_t)(k0 + 3) * INW]);
            o.y = pk_fp8x4(F8_WGU * w[(size_t)(k0 + 4) * INW], F8_WGU * w[(size_t)(k0 + 5) * INW], F8_WGU * w[(size_t)(k0 + 6) * INW], F8_WGU * w[(size_t)(k0 + 7) * INW]); }
        *(u32x2_*)(ws + WS_WGU_T + (size_t)l * NE * 1024 * D * 2 + 16 * MiB + (size_t)(4352 + rr) * D + k0) = o;
    }
    __syncthreads();
}

__device__ __forceinline__ void phase_stagger(const Frame& F, unsigned ticks) {
    if (F.bid & 1) { const unsigned long long t0 = __builtin_amdgcn_s_memrealtime(); while (__builtin_amdgcn_s_memrealtime() - t0 < ticks) __builtin_amdgcn_s_sleep(16); }
}
template <bool XBF>
struct EpiG3 {
    const float* xin; bf16* xb; const float* modl;
    __device__ __forceinline__ void operator()(f32x4 (&acc)[2][2][4][2], const pg::Unit& u, int wr, int wc, int fr, int fq) const {
        const float* g = modl + ((size_t)(u.pm >> 5) * 6 + 2) * D; const int col0 = u.pn * 256 + wc * 64 + fq * 16;
        f32x4 gv[2][2];
#pragma unroll
        for (int bj = 0; bj < 2; ++bj)
#pragma unroll
            for (int n = 0; n < 2; ++n) gv[bj][n] = *(const f32x4*)(g + col0 + bj * 8 + n * 4) * (1.f / (F8_MG * F8_WO));
#pragma unroll
        for (int ai = 0; ai < 2; ++ai) {
            f32x4 xv[4][2][2]; u32x4 xh[4][2];
#pragma unroll
            for (int m = 0; m < 4; ++m) { const size_t ro = (size_t)(u.pm * 256 + ai * 128 + wr * 64 + m * 16 + fr) * D + col0;
#pragma unroll
                for (int bj = 0; bj < 2; ++bj) { if (XBF) xh[m][bj] = *(const u32x4*)(xb + ro + bj * 8);
                    else { xv[m][bj][0] = *(const f32x4*)(xin + ro + bj * 8); xv[m][bj][1] = *(const f32x4*)(xin + ro + bj * 8 + 4); } } }
            asm volatile("" ::: "memory");
#pragma unroll
            for (int m = 0; m < 4; ++m) { const size_t ro = (size_t)(u.pm * 256 + ai * 128 + wr * 64 + m * 16 + fr) * D + col0;
#pragma unroll
                for (int bj = 0; bj < 2; ++bj) { f32x4 x0, x1;
                    if (XBF) { const u32x4 h = xh[m][bj]; x0 = (f32x4){bf2f(h.x & 0xffffu), bf2f(h.x >> 16), bf2f(h.y & 0xffffu), bf2f(h.y >> 16)}; x1 = (f32x4){bf2f(h.z & 0xffffu), bf2f(h.z >> 16), bf2f(h.w & 0xffffu), bf2f(h.w >> 16)}; }
                    else { x0 = xv[m][bj][0]; x1 = xv[m][bj][1]; }
                    x0 = x0 + gv[bj][0] * acc[ai][bj][m][0]; x1 = x1 + gv[bj][1] * acc[ai][bj][m][1];
                    u32x4 o; o.x = pg::cvt_pk_bf16(x0[0], x0[1]); o.y = pg::cvt_pk_bf16(x0[2], x0[3]); o.z = pg::cvt_pk_bf16(x1[0], x1[1]); o.w = pg::cvt_pk_bf16(x1[2], x1[3]);
                    *(u32x4*)(xb + ro + bj * 8) = o; } }
        }
    }
};
struct G3Order : pg::DenseOrderT<T / 256, D / 256> {
    int rowmode;
    __device__ __forceinline__ bool next(int i, pg::Unit& u) const {
        if (!rowmode) return pg::DenseOrderT<T / 256, D / 256>::next(i, u);
        if (i >= 4) return false;
        const int pn = (i + c) & 3;
        u.pm = c; u.pn = pn; u.e = 0; u.j = 0; u.valid = 256; u.keep = 0; u.A = A + (size_t)c * pg::BM * K * 2; u.B = B + (size_t)pn * pg::BM * K * 2; return true;
    }
};
template <bool XBF>
__device__ __forceinline__ void ph_gemm3_mfma(const Frame& F, int l) {
    unsigned char* ws = F.ws();
    G3Order S; S.rowmode = (F.G == T / 256); S.init(ws + WS_MERGED, ws + WS_WOUT_T + (size_t)l * D * D, D / 2, F.G, F.bid);
    EpiG3<XBF> E{F.in(I_X), (bf16*)(ws + WS_XB), (const float*)(ws + WS_MOD) + (size_t)l * BATCH * 6 * D};
    pg::gemm_phase<false, true, EpiG3<XBF>, G3Order, 1>(F.lds, F.tid, D / 2, S, E);
}

struct EpiG1 {
    unsigned char* ws;
    __device__ __forceinline__ void operator()(f32x4 (&acc)[2][2][4][2], const pg::Unit& u, int wr, int wc, int fr, int fq) const {
        const int pn = u.pn, row0 = u.pm * 256 + wr * 64 + fr, c8 = wc * 32 + fq * 8;
        if (pn == 2) {
            if (wc == 0 && fq < 2) { float* GA = (float*)(ws + WS_GA);
#pragma unroll
                for (int ai = 0; ai < 2; ++ai)
#pragma unroll
                    for (int m = 0; m < 4; ++m) { float* p = GA + (size_t)(row0 + ai * 128 + m * 16) * 16 + fq * 8; *(f32x4*)p = acc[ai][0][m][0]; *(f32x4*)(p + 4) = acc[ai][0][m][1]; } }
            return;
        }
        bf16* b0 = (bf16*)(ws + WS_GR) + pn * 256;
#pragma unroll
        for (int ai = 0; ai < 2; ++ai)
#pragma unroll
            for (int m = 0; m < 4; ++m) { const size_t ro = (size_t)(row0 + ai * 128 + m * 16) * 512 + c8;
#pragma unroll
                for (int bj = 0; bj < 2; ++bj) { f32x4 v0 = acc[ai][bj][m][0], v1 = acc[ai][bj][m][1];
#pragma unroll
                    for (int q = 0; q < 4; ++q) { v0[q] = v0[q] * __builtin_amdgcn_rcpf(1.f + __expf(-v0[q])); v1[q] = v1[q] * __builtin_amdgcn_rcpf(1.f + __expf(-v1[q])); }
                    u32x4 w; w.x = pg::cvt_pk_bf16(v0[0], v0[1]); w.y = pg::cvt_pk_bf16(v0[2], v0[3]); w.z = pg::cvt_pk_bf16(v1[0], v1[1]); w.w = pg::cvt_pk_bf16(v1[2], v1[3]);
                    *(u32x4*)(b0 + bj * 128 + ro) = w; } }
    }
};
struct EpiG1G {
    unsigned char* ws;
    __device__ __forceinline__ void operator()(f32x4 (&acc)[2][2][4][2], const pg::Unit& u, int wr, int wc, int fr, int fq) const {
        const int row0 = u.pm * 256 + wr * 64 + fr, c8 = wc * 32 + fq * 8; constexpr float ninv = -1.f / (F8_H * F8_WGU);
        if (u.pn == 17) {
            if (wc == 0 && fq < 2) { float* GA = (float*)(ws + WS_GA);
#pragma unroll
                for (int ai = 0; ai < 2; ++ai)
#pragma unroll
                    for (int m = 0; m < 4; ++m) { float* p = GA + (size_t)(row0 + ai * 128 + m * 16) * 16 + fq * 8; *(f32x4*)p = acc[ai][0][m][0] * (-ninv); *(f32x4*)(p + 4) = acc[ai][0][m][1] * (-ninv); } }
            return;
        }
        if (u.pn >= 15) {
            unsigned char* b0 = ws + WS_GR + (u.pn - 15) * 256 + wc * 64 + fq * 16; constexpr float kr = ninv * 1.4426950408889634f;
#pragma unroll
            for (int ai = 0; ai < 2; ++ai)
#pragma unroll
                for (int m = 0; m < 4; ++m) { u32x4 w;
#pragma unroll
                    for (int bj = 0; bj < 2; ++bj) { float e[8];
#pragma unroll
                        for (int j = 0; j < 8; ++j) e[j] = acc[ai][bj][m][j >> 2][j & 3] * kr;
                        __builtin_amdgcn_sched_barrier(0);
#pragma unroll
                        for (int j = 0; j < 8; ++j) e[j] = __builtin_amdgcn_exp2f(e[j]);
                        __builtin_amdgcn_sched_barrier(0);
#pragma unroll
                        for (int j = 0; j < 8; ++j) e[j] += 1.f;
                        __builtin_amdgcn_sched_barrier(0);
#pragma unroll
                        for (int j = 0; j < 8; ++j) e[j] = __builtin_amdgcn_rcpf(e[j]);
                        __builtin_amdgcn_sched_barrier(0);
#pragma unroll
                        for (int j = 0; j < 8; ++j) e[j] *= acc[ai][bj][m][j >> 2][j & 3] * (-ninv * F8_QKV);
                        const unsigned lo = pk_fp8x4(e[0], e[1], e[2], e[3]), hi = pk_fp8x4(e[4], e[5], e[6], e[7]);
                        if (bj == 0) { w.x = lo; w.y = hi; } else { w.z = lo; w.w = hi; } }
                    *(u32x4*)(b0 + (size_t)(row0 + ai * 128 + m * 16) * 512) = w; }
            return;
        }
        if (u.pn < 6) {
            const int pn = u.pn; unsigned char* b0; int ld; float sc = F8_QKV / (F8_H * F8_WGU);
            if (pn == 0)      { b0 = ws + WS_GQ; ld = 256; sc *= 0.125f; }
            else if (pn == 1) { b0 = ws + WS_GK; ld = 256; }
            else if (pn < 4)  { b0 = ws + WS_GV + (pn - 2) * 256; ld = 512; }
            else              { b0 = ws + WS_SQ + (pn - 4) * 256; ld = 512; }
            b0 += wc * 64 + fq * 16;
#pragma unroll
            for (int ai = 0; ai < 2; ++ai)
#pragma unroll
                for (int m = 0; m < 4; ++m) { const f32x4 v0 = acc[ai][0][m][0] * sc, v1 = acc[ai][0][m][1] * sc, v2 = acc[ai][1][m][0] * sc, v3 = acc[ai][1][m][1] * sc;
                    u32x4 w; w.x = pk_fp8x4(v0[0], v0[1], v0[2], v0[3]); w.y = pk_fp8x4(v1[0], v1[1], v1[2], v1[3]); w.z = pk_fp8x4(v2[0], v2[1], v2[2], v2[3]); w.w = pk_fp8x4(v3[0], v3[1], v3[2], v3[3]);
                    *(u32x4*)(b0 + (size_t)(row0 + ai * 128 + m * 16) * ld) = w; }
            return;
        }
        if (u.pn == 6) {
            unsigned char* b0 = ws + WS_SK; unsigned char* b1 = ws + WS_SV; constexpr float sc = F8_QKV / (F8_H * F8_WGU);
            typedef unsigned u32x2_ __attribute__((ext_vector_type(2)));
#pragma unroll
            for (int ai = 0; ai < 2; ++ai)
#pragma unroll
                for (int m = 0; m < 4; ++m) { const size_t ro = (size_t)(row0 + ai * 128 + m * 16) * 128 + c8;
#pragma unroll
                    for (int bj = 0; bj < 2; ++bj) { const f32x4 v0 = acc[ai][bj][m][0] * sc, v1 = acc[ai][bj][m][1] * sc;
                        u32x2_ w; w.x = pk_fp8x4(v0[0], v0[1], v0[2], v0[3]); w.y = pk_fp8x4(v1[0], v1[1], v1[2], v1[3]);
                        *(u32x2_*)((bj ? b1 : b0) + ro) = w; } }
            return;
        }
        unsigned char* RA = ws + WS_MA + (u.pn - 7) * 128 + c8; unsigned char* SBp = ws + WS_MB + (u.pn - 7) * 128 + c8;
        constexpr float kk = ninv * 1.4426950408889634f;
#pragma unroll
        for (int ai = 0; ai < 2; ++ai)
#pragma unroll
            for (int m = 0; m < 4; ++m) { const size_t ro = (size_t)(row0 + ai * 128 + m * 16) * D; float pa[8], pb[8];
#pragma unroll
                for (int j = 0; j < 8; ++j) { pa[j] = acc[ai][0][m][j >> 2][j & 3] * kk; pb[j] = acc[ai][1][m][j >> 2][j & 3] * kk; }
                __builtin_amdgcn_sched_barrier(0);
#pragma unroll
                for (int j = 0; j < 8; ++j) { pa[j] = __builtin_amdgcn_exp2f(pa[j]); pb[j] = __builtin_amdgcn_exp2f(pb[j]); }
                __builtin_amdgcn_sched_barrier(0);
#pragma unroll
                for (int j = 0; j < 8; ++j) { pa[j] += 1.f; pb[j] += 1.f; }
                __builtin_amdgcn_sched_barrier(0);
                float ia[8], sb[8];
#pragma unroll
                for (int j = 0; j < 8; ++j) { ia[j] = __builtin_amdgcn_rcpf(pa[j]); sb[j] = __builtin_amdgcn_rcpf(pb[j]); }
                __builtin_amdgcn_sched_barrier(0);
#pragma unroll
                for (int j = 0; j < 8; ++j) ia[j] *= pb[j];
                typedef unsigned u32x2_ __attribute__((ext_vector_type(2)));
                u32x2_ w; int p_;
                p_ = __builtin_amdgcn_cvt_pk_fp8_f32(ia[0], ia[1], 0, false); w.x = (unsigned)__builtin_amdgcn_cvt_pk_fp8_f32(ia[2], ia[3], p_, true);
                p_ = __builtin_amdgcn_cvt_pk_fp8_f32(ia[4], ia[5], 0, false); w.y = (unsigned)__builtin_amdgcn_cvt_pk_fp8_f32(ia[6], ia[7], p_, true);
                *(u32x2_*)(RA + ro) = w;
                p_ = __builtin_amdgcn_cvt_pk_fp8_f32(sb[0], sb[1], 0, false); w.x = (unsigned)__builtin_amdgcn_cvt_pk_fp8_f32(sb[2], sb[3], p_, true);
                p_ = __builtin_amdgcn_cvt_pk_fp8_f32(sb[4], sb[5], 0, false); w.y = (unsigned)__builtin_amdgcn_cvt_pk_fp8_f32(sb[6], sb[7], p_, true);
                *(u32x2_*)(SBp + ro) = w; }
    }
};
struct G1Order : pg::DenseOrderT<T / 256, NGATE / 256> {
    __device__ __forceinline__ bool wide(const pg::Unit& u) const { return u.pn < 6 || u.pn == 15 || u.pn == 16; }
};
__device__ __forceinline__ void ph_gemm1_gates(const Frame& F, int l) {
    unsigned char* ws = F.ws();
    G1Order S; S.init(ws + WS_H8N, ws + WS_WGU_T + (size_t)l * NE * 1024 * D * 2 + 16 * MiB, D / 2, F.G, F.bid);
    EpiG1G E{ws};
    pg::gemm_phase<false, true, EpiG1G, G1Order, 2>(F.lds, F.tid, D / 2, S, E);
}
__device__ __forceinline__ void ph_gemm1_mfma(const Frame& F, int l) {
    unsigned char* ws = F.ws();
    pg::DenseOrderT<T / 256, NIN / 256> S; S.init(ws + WS_H, ws + WS_WIN_T + (size_t)l * NIN * D * 2, D, F.G, F.bid);
    EpiG1 E{ws};
    pg::gemm_phase<false, false>(F.lds, F.tid, D, S, E);
}
struct G2Order {
    pg::DenseOrder d; const char* A2; const char* B2; int rowmode;
    __device__ __forceinline__ bool next(int i, pg::Unit& u) const {
        int pm, pn; if (rowmode) { if (i >= 8) return false; pm = d.c; pn = ((i >> 1) + d.c) & 3; }        else if (!d.tile(i >> 1, pm, pn)) return false;
        const int seg = i & 1; u.pm = pm; u.pn = pn; u.e = seg; u.j = 0; u.valid = 256; u.keep = !seg;
        u.A = (seg ? A2 : d.A) + (size_t)pm * 256 * d.K * 2; u.B = (seg ? B2 : d.B) + (size_t)pn * 256 * d.K * 2; return true;
    }
    __device__ __forceinline__ unsigned rowoff(const pg::Unit&, int r) const { return (unsigned)(r * d.K * 2); }
};
struct EpiG2 {
    const unsigned char* MA; const unsigned char* MB; unsigned char* MG;
    __device__ __forceinline__ void operator()(f32x4 (&acc)[2][2][4][2], const pg::Unit& u, int wr, int wc, int fr, int fq) const {
        typedef float f32x2_ __attribute__((ext_vector_type(2)));
        const int row0 = u.pm * 256 + wr * 64 + fr, col0 = u.pn * 256 + wc * 64 + fq * 16;
#define G2_W(v, j) ((j) == 0 ? (v).x : (j) == 1 ? (v).y : (j) == 2 ? (v).z : (v).w)
        const unsigned char* GP = (u.e == 0) ? MA : MB; u32x4 gw[2][4];
#pragma unroll
        for (int ai = 0; ai < 2; ++ai)
#pragma unroll
            for (int m = 0; m < 4; ++m) gw[ai][m] = *(const u32x4*)(GP + (size_t)(row0 + ai * 128 + m * 16) * D + col0);
        if (u.e == 0) {
#pragma unroll
            for (int ai = 0; ai < 2; ++ai)
#pragma unroll
                for (int m = 0; m < 4; ++m)
#pragma unroll
                    for (int bj = 0; bj < 2; ++bj)
#pragma unroll
                        for (int n = 0; n < 2; ++n) { int w_ = (int)G2_W(gw[ai][m], 2 * bj + n); asm volatile("" : "+v"(w_)); const f32x2_ lo = __builtin_amdgcn_cvt_pk_f32_fp8(w_, false), hi = __builtin_amdgcn_cvt_pk_f32_fp8(w_, true);
                            acc[ai][bj][m][n][0] *= lo.x; acc[ai][bj][m][n][1] *= lo.y; acc[ai][bj][m][n][2] *= hi.x; acc[ai][bj][m][n][3] *= hi.y; }
        } else {
#pragma unroll
            for (int ai = 0; ai < 2; ++ai)
#pragma unroll
                for (int m = 0; m < 4; ++m) { u32x4 w;
#pragma unroll
                    for (int bj = 0; bj < 2; ++bj)
#pragma unroll
                        for (int n = 0; n < 2; ++n) { int w_ = (int)G2_W(gw[ai][m], 2 * bj + n); asm volatile("" : "+v"(w_)); const f32x2_ lo = __builtin_amdgcn_cvt_pk_f32_fp8(w_, false), hi = __builtin_amdgcn_cvt_pk_f32_fp8(w_, true);
                            const f32x4 v = acc[ai][bj][m][n] * (F8_MG / (F8_AO * F8_WU));
                            const unsigned pk = pk_fp8x4(v[0] * lo.x, v[1] * lo.y, v[2] * hi.x, v[3] * hi.y);
                            if (2 * bj + n == 0) w.x = pk; else if (2 * bj + n == 1) w.y = pk; else if (2 * bj + n == 2) w.z = pk; else w.w = pk; }
                    *(u32x4*)(MG + (size_t)(row0 + ai * 128 + m * 16) * D + col0) = w; }
        }
#undef G2_W
    }
};
__device__ __forceinline__ void ph_gemm2_mfma(const Frame& F, int l) {
    unsigned char* ws = F.ws();
    G2Order S; S.rowmode = (F.G == T / 256); S.d.init(ws + WS_GLAO, ws + WS_WG_T + (size_t)l * D * 512, T, D, 256, F.G, F.bid); S.A2 = (const char*)(ws + WS_SWAO); S.B2 = (const char*)(ws + WS_WS_T + (size_t)l * D * 512);
    EpiG2 E{ws + WS_MA, ws + WS_MB, ws + WS_MERGED};
    pg::gemm_phase<false, true, EpiG2, G2Order, 1>(F.lds, F.tid, 256, S, E);
}

constexpr int MOE_TAB = 131072 + 1024;
__device__ __forceinline__ void moe_table(const Frame& F, int l) {
    volatile LAS int* tb = (volatile LAS int*)(F.lds + MOE_TAB);
    if (F.tid < 64) {
        const unsigned* cnt = (const unsigned*)(F.ws() + WS_CTL) + CW_CNT + 64 * (NE * l);
        const int ce = F.tid < NE ? (int)__hip_atomic_load(cnt + 64 * F.tid, __ATOMIC_RELAXED, __HIP_MEMORY_SCOPE_AGENT) : 0;
        int inc = (ce + 255) >> 8;
#pragma unroll
        for (int o = 1; o < 16; o <<= 1) { const int t = __builtin_amdgcn_ds_bpermute(((F.lane - o) & 63) << 2, inc); if ((F.lane & 15) >= o && F.lane < 16) inc += t; }
        if (F.tid < NE) { tb[F.tid + 1] = inc; tb[32 + F.tid] = ce; }
        if (F.tid == 0) tb[0] = 0;
    }
    __syncthreads();
}
template <bool GATHER>
struct MoeOrder {
    LAS unsigned char* lds; const char* Abase; const char* Bbase; const int* tokl; int K, G, c;
    __device__ __forceinline__ bool next(int i, pg::Unit& u) const {
        volatile LAS int* tb = (volatile LAS int*)(lds + MOE_TAB);
        const int L = i * G + c, ti = L >> 2, pn = L & 3;
        if (ti >= tb[16]) return false;
        int e = 0;
#pragma unroll
        for (int k = 1; k < NE; ++k) e += (ti >= tb[k]) ? 1 : 0;
        e = __builtin_amdgcn_readfirstlane(e);
        const int j = ti - __builtin_amdgcn_readfirstlane(tb[e]), ce = __builtin_amdgcn_readfirstlane(tb[32 + e]);
        u.pm = ti; u.pn = pn; u.e = e; u.j = j; u.valid = (ce - 256 * j) < 256 ? (ce - 256 * j) : 256; u.keep = 0;
        u.A = GATHER ? Abase : Abase + (size_t)ti * 256 * K * 2;
        u.B = Bbase + ((size_t)e * 1024 + pn * 256) * K * 2; return true;
    }
    __device__ __forceinline__ unsigned rowoff(const pg::Unit& u, int r) const {
        if (!GATHER) return (unsigned)(r * K * 2);
        int tk = 0; if (r < u.valid) tk = tokl[(size_t)u.e * ECAP + 256 * u.j + r];
        return (unsigned)tk * (unsigned)(K * 2);
    }
};
struct EpiMU {
    bf16* ACT;
    __device__ __forceinline__ void operator()(f32x4 (&acc)[2][2][4][2], const pg::Unit& u, int wr, int wc, int fr, int fq) const {
#pragma unroll
        for (int ai = 0; ai < 2; ++ai)
#pragma unroll
            for (int m = 0; m < 4; ++m) { bf16* p = ACT + (size_t)(u.pm * 256 + ai * 128 + wr * 64 + m * 16 + fr) * DFF + u.pn * 128 + wc * 32 + fq * 8;
                float o[8];
#pragma unroll
                for (int n = 0; n < 2; ++n)
#pragma unroll
                    for (int q = 0; q < 4; ++q) { const float g = acc[ai][0][m][n][q]; o[n * 4 + q] = g * __builtin_amdgcn_rcpf(1.f + __expf(-g)) * acc[ai][1][m][n][q]; }
                u32x4 w; w.x = pg::cvt_pk_bf16(o[0], o[1]); w.y = pg::cvt_pk_bf16(o[2], o[3]); w.z = pg::cvt_pk_bf16(o[4], o[5]); w.w = pg::cvt_pk_bf16(o[6], o[7]);
                *(u32x4*)p = w; }
    }
};
struct EpiMD {
    bf16* YS;
    __device__ __forceinline__ void operator()(f32x4 (&acc)[2][2][4][2], const pg::Unit& u, int wr, int wc, int fr, int fq) const {
#pragma unroll
        for (int ai = 0; ai < 2; ++ai)
#pragma unroll
            for (int m = 0; m < 4; ++m) { bf16* p = YS + (size_t)(u.pm * 256 + ai * 128 + wr * 64 + m * 16 + fr) * D + u.pn * 256 + wc * 32 + fq * 8;
#pragma unroll
                for (int bj = 0; bj < 2; ++bj) { const f32x4 v0 = acc[ai][bj][m][0], v1 = acc[ai][bj][m][1];
                    u32x4 o; o.x = pg::cvt_pk_bf16(v0[0], v0[1]); o.y = pg::cvt_pk_bf16(v0[2], v0[3]); o.z = pg::cvt_pk_bf16(v1[0], v1[1]); o.w = pg::cvt_pk_bf16(v1[2], v1[3]);
                    *(u32x4*)(p + bj * 128) = o; } }
    }
};
struct EpiMU8 {
    unsigned char* ACT8;
    __device__ __forceinline__ void operator()(f32x4 (&acc)[2][2][4][2], const pg::Unit& u, int wr, int wc, int fr, int fq) const {
        constexpr float inv = 1.f / (F8_H * F8_WGU), cc = F8_ACT * inv * inv;
        constexpr float kk = -inv * 1.4426950408889634f, l2c = 18.f;
        static_assert(F8_H * F8_WGU == 1024.f && F8_ACT == 4.f, "l2c above");
#pragma unroll
        for (int ai = 0; ai < 2; ++ai)
#pragma unroll
            for (int m = 0; m < 4; ++m) { unsigned char* p = ACT8 + (size_t)(u.pm * 256 + ai * 128 + wr * 64 + m * 16 + fr) * DFF + u.pn * 128 + wc * 32 + fq * 8;
                float e[8], o[8];
#pragma unroll
                for (int j = 0; j < 8; ++j) e[j] = __builtin_fmaf(acc[ai][0][m][j >> 2][j & 3], kk, l2c);
                __builtin_amdgcn_sched_barrier(0);
#pragma unroll
                for (int j = 0; j < 8; ++j) e[j] = __builtin_amdgcn_exp2f(e[j]);
                __builtin_amdgcn_sched_barrier(0);
#pragma unroll
                for (int j = 0; j < 8; ++j) { e[j] += 1.f / cc; o[j] = acc[ai][0][m][j >> 2][j & 3] * acc[ai][1][m][j >> 2][j & 3]; }
                __builtin_amdgcn_sched_barrier(0);
#pragma unroll
                for (int j = 0; j < 8; ++j) e[j] = __builtin_amdgcn_rcpf(e[j]);
                __builtin_amdgcn_sched_barrier(0);
#pragma unroll
                for (int j = 0; j < 8; ++j) o[j] *= e[j];
                typedef unsigned u32x2_ __attribute__((ext_vector_type(2)));
                u32x2_ w; w.x = pk_fp8x4(o[0], o[1], o[2], o[3]); w.y = pk_fp8x4(o[4], o[5], o[6], o[7]);
                *(u32x2_*)p = w; }
    }
};
struct EpiMD8 {
    unsigned char* YS;
    __device__ __forceinline__ void operator()(f32x4 (&acc)[2][2][4][2], const pg::Unit& u, int wr, int wc, int fr, int fq) const {
        constexpr float sc = F8_Y / (F8_ACT * F8_WD);
#pragma unroll
        for (int ai = 0; ai < 2; ++ai)
#pragma unroll
            for (int m = 0; m < 4; ++m) { unsigned char* p = YS + (size_t)(u.pm * 256 + ai * 128 + wr * 64 + m * 16 + fr) * D + u.pn * 256 + wc * 64 + fq * 16;
                const f32x4 v0 = acc[ai][0][m][0] * sc, v1 = acc[ai][0][m][1] * sc, v2 = acc[ai][1][m][0] * sc, v3 = acc[ai][1][m][1] * sc;
                u32x4 o; o.x = pk_fp8x4(v0[0], v0[1], v0[2], v0[3]); o.y = pk_fp8x4(v1[0], v1[1], v1[2], v1[3]); o.z = pk_fp8x4(v2[0], v2[1], v2[2], v2[3]); o.w = pk_fp8x4(v3[0], v3[1], v3[2], v3[3]);
                *(u32x4*)p = o; }
    }
};
__device__ __forceinline__ int vcu_of(const Frame& F) { return (F.G % 8 == 0) ? (F.bid % 8) * (F.G / 8) + F.bid / 8 : F.bid; }
__device__ __forceinline__ void ph_moe_up_mfma(const Frame& F, int l) {
    unsigned char* ws = F.ws(); moe_table(F, l);
    MoeOrder<true> S{F.lds, (const char*)(ws + WS_H), (const char*)(ws + WS_WGU_T + (size_t)l * NE * 1024 * D * 2), (const int*)(ws + WS_TOKL), D, F.G, vcu_of(F)};
    EpiMU E{(bf16*)(ws + WS_ACT)};
    pg::gemm_phase<true, false>(F.lds, F.tid, D, S, E);
}
__device__ __forceinline__ void ph_moe_up_fp8(const Frame& F, int l) {
    unsigned char* ws = F.ws(); moe_table(F, l);
    MoeOrder<true> S{F.lds, (const char*)(ws + WS_H8), (const char*)(ws + WS_WGU_T + (size_t)l * NE * 1024 * D * 2), (const int*)(ws + WS_TOKL), D / 2, F.G, vcu_of(F)};
    EpiMU8 E{ws + WS_ACT8};
    pg::gemm_phase<true, true>(F.lds, F.tid, D / 2, S, E);
}
__device__ __forceinline__ void ph_moe_down_fp8(const Frame& F, int l) {
    unsigned char* ws = F.ws(); moe_table(F, l);
    MoeOrder<false> S{F.lds, (const char*)(ws + WS_ACT8), (const char*)(ws + WS_WD_T + (size_t)l * NE * 1024 * DFF * 2), (const int*)(ws + WS_TOKL), DFF / 2, F.G, vcu_of(F)};
    EpiMD8 E{ws + WS_YS};
    pg::gemm_phase<false, true, EpiMD8, MoeOrder<false>, 1>(F.lds, F.tid, DFF / 2, S, E);
}
__device__ __forceinline__ void ph_moe_down_mfma(const Frame& F, int l) {
    unsigned char* ws = F.ws(); moe_table(F, l);
    MoeOrder<false> S{F.lds, (const char*)(ws + WS_ACT), (const char*)(ws + WS_WD_T + (size_t)l * NE * 1024 * DFF * 2), (const int*)(ws + WS_TOKL), DFF, F.G, vcu_of(F)};
    EpiMD E{(bf16*)(ws + WS_YS)};
    pg::gemm_phase<false, false>(F.lds, F.tid, DFF, S, E);
}
__device__ __forceinline__ void ph_rope_table(const Frame& F) {
    const int* pos = (const int*)F.in(I_POS); float* RT = (float*)(F.ws() + WS_ROPE);
    for (int idx = F.bid * NTHREADS + F.tid; idx < T * 8; idx += F.G * NTHREADS) {
        const int t = idx >> 3, i = idx & 7;
        const float invf = (float)exp2(-(double)i * (1.0 / 8.0) * 18.931568569324174);
        const float ang = (float)pos[t] * invf;
        const double rev = (double)ang * 0.15915494309189535; const float fr = (float)(rev - floor(rev));
        RT[(size_t)t * 16 + i] = __builtin_amdgcn_cosf(fr); RT[(size_t)t * 16 + 8 + i] = __builtin_amdgcn_sinf(fr);
    }
    bf16* WRT = (bf16*)(F.ws() + WS_WRT);
    for (int idx = F.bid * NTHREADS + F.tid; idx < NE * D; idx += F.G * NTHREADS) { const int e = idx >> 10, k = idx & 1023; const float w = F.in(I_WR)[(size_t)k * NE + e];
        const unsigned hi = f2bf(w); WRT[idx] = (bf16)hi; WRT[NE * D + idx] = (bf16)f2bf(w - bf2f(hi)); }
}
typedef float f32x16 __attribute__((ext_vector_type(16)));
constexpr int SWA_KP = 144, SWA_VP = 520, SWA_VT_OFF = 256 * SWA_KP, SWA_OT_OFF = SWA_VT_OFF + 64 * SWA_VP;
__device__ __forceinline__ void ph_swa_mfma(const Frame& F, int l) {
    unsigned char* ws = F.ws();
    const unsigned char* SQ = ws + WS_SQ; const unsigned char* SK = ws + WS_SK; const unsigned char* SV = ws + WS_SV; unsigned char* O = ws + WS_SWAO;
    typedef unsigned u32x2s __attribute__((ext_vector_type(2))); typedef float f32x2s __attribute__((ext_vector_type(2)));
    constexpr float EPS16 = EPS * F8_QKV * F8_QKV;
    const float* RT = (const float*)(ws + WS_ROPE);
    const float* qn = F.in(I_QN) + l * SHD; const float* kn = F.in(I_KN) + l * SHD; const float* sinks = F.in(I_SINK) + l * SH;
    LAS unsigned char* Kb = F.lds; LAS unsigned char* Vt = F.lds + SWA_VT_OFF;
    const int tid = F.tid, lane = F.lane, w = F.wave, r = lane & 31, h = lane >> 5;
    constexpr float QSCALE = 0.125f * 1.4426950408889634f;
    for (int unit = F.bid; unit < BATCH * SKV * (SEQ / WIN); unit += F.G) {
        const int n = unit & 63, kvh = (unit >> 6) & 1, b = unit >> 7;
        const int tq0 = b * SEQ + n * WIN, tk0 = tq0 - WIN;
        u32x2s qr0[4], qr1[4]; f32x4 rt0[4], rt1[4];
        { const int hq_ = kvh * 4 + (w >> 1); const size_t ta = (size_t)(tq0 + 64 * (w & 1) + r), tb = ta + 32;
#pragma unroll
          for (int s4 = 0; s4 < 4; ++s4) { qr0[s4] = *(const u32x2s*)(SQ + ta * 512 + hq_ * 64 + 16 * s4 + 8 * h); qr1[s4] = *(const u32x2s*)(SQ + tb * 512 + hq_ * 64 + 16 * s4 + 8 * h);
              rt0[s4] = *(const f32x4*)(RT + ta * 16 + 4 * s4); rt1[s4] = *(const f32x4*)(RT + tb * 16 + 4 * s4); } }
        __syncthreads();
#pragma unroll
        for (int it = 0; it < 4; ++it) {
            const int key = (tid >> 3) + 64 * it, c = tid & 7; const bool valid = (n > 0) || (key >= WIN); const int tok = valid ? tk0 + key : tq0;
            const u32x2s raw = *(const u32x2s*)(SK + (size_t)tok * 128 + kvh * 64 + 8 * c);
            float v[8];
            { const f32x2s a0 = __builtin_amdgcn_cvt_pk_f32_fp8((int)raw.x, false), a1 = __builtin_amdgcn_cvt_pk_f32_fp8((int)raw.x, true), a2 = __builtin_amdgcn_cvt_pk_f32_fp8((int)raw.y, false), a3 = __builtin_amdgcn_cvt_pk_f32_fp8((int)raw.y, true);
              v[0] = a0.x; v[1] = a0.y; v[2] = a1.x; v[3] = a1.y; v[4] = a2.x; v[5] = a2.y; v[6] = a3.x; v[7] = a3.y; }
            float ss = 0.f;
#pragma unroll
            for (int j = 0; j < 8; ++j) ss += v[j] * v[j];
            ss += shx(ss, 1, lane); ss += shx(ss, 2, lane); ss += shx(ss, 4, lane);
            const float rstd = 1.0f / sqrtf(ss * (1.f / 64.f) + EPS16);
            const f32x4 g0 = *(const f32x4*)(kn + 8 * c), g1 = *(const f32x4*)(kn + 8 * c + 4);
#pragma unroll
            for (int j = 0; j < 4; ++j) { v[j] = v[j] * rstd * g0[j]; v[4 + j] = v[4 + j] * rstd * g1[j]; }
            float pr[8];
#pragma unroll
            for (int j = 0; j < 8; ++j) pr[j] = shx(v[j], 1, lane);
            if (c < 2) {
                const f32x4 c0 = *(const f32x4*)(RT + (size_t)tok * 16), c1 = *(const f32x4*)(RT + (size_t)tok * 16 + 4), s0 = *(const f32x4*)(RT + (size_t)tok * 16 + 8), s1 = *(const f32x4*)(RT + (size_t)tok * 16 + 12);
                const float sg = c == 0 ? -1.f : 1.f;
#pragma unroll
                for (int j = 0; j < 4; ++j) { v[j] = v[j] * c0[j] + sg * pr[j] * s0[j]; v[4 + j] = v[4 + j] * c1[j] + sg * pr[4 + j] * s1[j]; }
            }
            u32x4 o; o.x = pk2(v[0], v[1]); o.y = pk2(v[2], v[3]); o.z = pk2(v[4], v[5]); o.w = pk2(v[6], v[7]);
            if (!valid) o = (u32x4){0u, 0u, 0u, 0u};
            *(LAS u32x4*)(Kb + key * SWA_KP + 16 * c) = o;
        }
#pragma unroll
        for (int it = 0; it < 2; ++it) {
            const int kp = (tid >> 3) + 64 * it, c = tid & 7, key = 2 * kp; const bool valid = (n > 0) || (key >= WIN); const int tok = valid ? tk0 + key : tq0;
            u32x2s r0 = *(const u32x2s*)(SV + (size_t)tok * 128 + kvh * 64 + 8 * c), r1 = *(const u32x2s*)(SV + (size_t)(tok + 1) * 128 + kvh * 64 + 8 * c);
            if (!valid) { r0 = (u32x2s){0u, 0u}; r1 = r0; }
#pragma unroll
            for (int q = 0; q < 4; ++q) { const int w0 = (int)((q >> 1) ? r0.y : r0.x), w1 = (int)((q >> 1) ? r1.y : r1.x);
                const f32x2s e0 = (q & 1) ? __builtin_amdgcn_cvt_pk_f32_fp8(w0, true) : __builtin_amdgcn_cvt_pk_f32_fp8(w0, false), e1 = (q & 1) ? __builtin_amdgcn_cvt_pk_f32_fp8(w1, true) : __builtin_amdgcn_cvt_pk_f32_fp8(w1, false);
                *(LAS unsigned*)(Vt + (8 * c + 2 * q) * SWA_VP + 4 * kp) = pk2(e0.x, e1.x);
                *(LAS unsigned*)(Vt + (8 * c + 2 * q + 1) * SWA_VP + 4 * kp) = pk2(e0.y, e1.y);
            }
        }
        __syncthreads();
        const int g = w >> 1, hq = kvh * 4 + g; const float sink2 = sinks[hq] * 1.4426950408889634f;
#pragma unroll 1
        for (int qt = 0; qt < 2; ++qt) {
            const int p0 = 64 * (w & 1) + 32 * qt; const size_t tq = (size_t)(tq0 + p0 + r);
            float qv[4][8]; float ss = 0.f;
#pragma unroll
            for (int s4 = 0; s4 < 4; ++s4) { const u32x2s raw = qt ? qr1[s4] : qr0[s4];
                const f32x2s a0 = __builtin_amdgcn_cvt_pk_f32_fp8((int)raw.x, false), a1 = __builtin_amdgcn_cvt_pk_f32_fp8((int)raw.x, true), a2 = __builtin_amdgcn_cvt_pk_f32_fp8((int)raw.y, false), a3 = __builtin_amdgcn_cvt_pk_f32_fp8((int)raw.y, true);
                qv[s4][0] = a0.x; qv[s4][1] = a0.y; qv[s4][2] = a1.x; qv[s4][3] = a1.y; qv[s4][4] = a2.x; qv[s4][5] = a2.y; qv[s4][6] = a3.x; qv[s4][7] = a3.y; }
#pragma unroll
            for (int s4 = 0; s4 < 4; ++s4)
#pragma unroll
                for (int j = 0; j < 8; ++j) ss += qv[s4][j] * qv[s4][j];
            ss += shx(ss, 32, lane);
            const float rstd = 1.0f / sqrtf(ss * (1.f / 64.f) + EPS16);
#pragma unroll
            for (int s4 = 0; s4 < 4; ++s4) { const f32x4 g0 = *(const f32x4*)(qn + 16 * s4 + 8 * h), g1 = *(const f32x4*)(qn + 16 * s4 + 8 * h + 4);
#pragma unroll
                for (int j = 0; j < 4; ++j) { qv[s4][j] = qv[s4][j] * rstd * g0[j]; qv[s4][4 + j] = qv[s4][4 + j] * rstd * g1[j]; } }
            { float pr[8];
#pragma unroll
              for (int j = 0; j < 8; ++j) pr[j] = shx(qv[0][j], 32, lane);
              const f32x4 c0 = qt ? rt1[0] : rt0[0], c1 = qt ? rt1[1] : rt0[1], s0 = qt ? rt1[2] : rt0[2], s1 = qt ? rt1[3] : rt0[3];
              const float sg = h == 0 ? -1.f : 1.f;
#pragma unroll
              for (int j = 0; j < 4; ++j) { qv[0][j] = qv[0][j] * c0[j] + sg * pr[j] * s0[j]; qv[0][4 + j] = qv[0][4 + j] * c1[j] + sg * pr[4 + j] * s1[j]; } }
            pg::bf16x8 qf[4];
#pragma unroll
            for (int s4 = 0; s4 < 4; ++s4) { u32x4 t; t.x = pk2(qv[s4][0] * QSCALE, qv[s4][1] * QSCALE); t.y = pk2(qv[s4][2] * QSCALE, qv[s4][3] * QSCALE); t.z = pk2(qv[s4][4] * QSCALE, qv[s4][5] * QSCALE); t.w = pk2(qv[s4][6] * QSCALE, qv[s4][7] * QSCALE);
                qf[s4] = __builtin_bit_cast(pg::bf16x8, t); }
            f32x16 sc[5];
#pragma unroll
            for (int kt = 0; kt < 5; ++kt) {
                f32x16 a16;
#pragma unroll
                for (int i = 0; i < 16; ++i) a16[i] = 0.f;
#pragma unroll
                for (int s4 = 0; s4 < 4; ++s4) { const pg::bf16x8 ka = *(const LAS pg::bf16x8*)(Kb + (p0 + 32 * kt + r) * SWA_KP + (16 * s4 + 8 * h) * 2);
                    a16 = __builtin_amdgcn_mfma_f32_32x32x16_bf16(ka, qf[s4], a16, 0, 0, 0); }
                sc[kt] = a16;
            }
            const int kt_lo = (n == 0) ? 4 - (p0 >> 5) : 0;
            float mx = sink2;
#pragma unroll
            for (int kt = 0; kt < 5; ++kt)
#pragma unroll
                for (int i = 0; i < 16; ++i) { const int kk = (i & 3) + 8 * (i >> 2) + 4 * h;
                    bool ok = kt >= kt_lo; if (kt == 0) ok = ok && (kk > r); if (kt == 4) ok = ok && (kk <= r);
                    const float sv = ok ? sc[kt][i] : -1e30f; sc[kt][i] = sv; mx = fmaxf(mx, sv); }
            mx = fmaxf(mx, shx(mx, 32, lane));
            float den = 0.f;
#pragma unroll
            for (int kt = 0; kt < 5; ++kt)
#pragma unroll
                for (int i = 0; i < 16; ++i) { const float p = __builtin_amdgcn_exp2f(sc[kt][i] - mx); sc[kt][i] = p; den += p; }
            den += shx(den, 32, lane); den += __builtin_amdgcn_exp2f(sink2 - mx);
            const float inv = 1.f / den;
            f32x16 o0, o1;
#pragma unroll
            for (int i = 0; i < 16; ++i) { o0[i] = 0.f; o1[i] = 0.f; }
#pragma unroll
            for (int kt = 0; kt < 5; ++kt)
#pragma unroll
                for (int s2 = 0; s2 < 2; ++s2) {
                    u32x4 t; t.x = pk2(sc[kt][8 * s2 + 0], sc[kt][8 * s2 + 1]); t.y = pk2(sc[kt][8 * s2 + 2], sc[kt][8 * s2 + 3]); t.z = pk2(sc[kt][8 * s2 + 4], sc[kt][8 * s2 + 5]); t.w = pk2(sc[kt][8 * s2 + 6], sc[kt][8 * s2 + 7]);
                    const pg::bf16x8 pf = __builtin_bit_cast(pg::bf16x8, t);
                    const int kb0 = p0 + 32 * kt + 16 * s2 + 4 * h;
                    typedef unsigned u32x2 __attribute__((ext_vector_type(2)));
                    const u32x2 a0 = *(const LAS u32x2*)(Vt + r * SWA_VP + kb0 * 2), a1 = *(const LAS u32x2*)(Vt + r * SWA_VP + (kb0 + 8) * 2);
                    const u32x2 b0 = *(const LAS u32x2*)(Vt + (32 + r) * SWA_VP + kb0 * 2), b1 = *(const LAS u32x2*)(Vt + (32 + r) * SWA_VP + (kb0 + 8) * 2);
                    u32x4 va; va.x = a0.x; va.y = a0.y; va.z = a1.x; va.w = a1.y; u32x4 vb; vb.x = b0.x; vb.y = b0.y; vb.z = b1.x; vb.w = b1.y;
                    o0 = __builtin_amdgcn_mfma_f32_32x32x16_bf16(__builtin_bit_cast(pg::bf16x8, va), pf, o0, 0, 0, 0);
                    o1 = __builtin_amdgcn_mfma_f32_32x32x16_bf16(__builtin_bit_cast(pg::bf16x8, vb), pf, o1, 0, 0, 0);
                }
            const float inv8 = inv * (F8_AO / F8_QKV); LAS unsigned char* ot = F.lds + SWA_OT_OFF + w * (32 * 80);
#pragma unroll
            for (int i4 = 0; i4 < 4; ++i4) {
                *(LAS unsigned*)(ot + r * 80 + 4 * h + 8 * i4) = pk_fp8x4(o0[4 * i4] * inv8, o0[4 * i4 + 1] * inv8, o0[4 * i4 + 2] * inv8, o0[4 * i4 + 3] * inv8);
                *(LAS unsigned*)(ot + r * 80 + 32 + 4 * h + 8 * i4) = pk_fp8x4(o1[4 * i4] * inv8, o1[4 * i4 + 1] * inv8, o1[4 * i4 + 2] * inv8, o1[4 * i4 + 3] * inv8);
            }
            asm volatile("s_waitcnt lgkmcnt(0)" ::: "memory");
#pragma unroll
            for (int k2 = 0; k2 < 2; ++k2) { const int rw = 16 * k2 + (lane >> 2), cq4 = lane & 3;
                const u32x4 ov4 = *(const LAS u32x4*)(ot + rw * 80 + 16 * cq4);
                *(u32x4*)(O + (size_t)(tq0 + p0 + rw) * 512 + hq * 64 + 16 * cq4) = ov4; }
            asm volatile("s_waitcnt lgkmcnt(0)" ::: "memory");
        }
    }
    __syncthreads();
}

constexpr int GLA_GRP = 8, GLA_NG = NCH / GLA_GRP, GLA_UNITS = BATCH * GH * GLA_NG;
constexpr int GL_GA = 109568;
constexpr int GL_LA = 0, GL_SEG = 16384, GL_BEND = 18432, GL_DEC = 18688, GL_QD = 19456, GL_KI = 28672, GL_ATT = 37888, GL_KET = 47104, GL_VT = 56320, GL_OB = 75776, GL_P = 144;
typedef unsigned u32x2 __attribute__((ext_vector_type(2)));
template <bool OUT>
__device__ __forceinline__ void ph_gla_mfma(const Frame& F, int l) {
    unsigned char* ws = F.ws();
    const unsigned char* GQ = ws + WS_GQ; const unsigned char* GK = ws + WS_GK; const unsigned char* GV = ws + WS_GV; const unsigned char* GR = ws + WS_GR;
    typedef float f32x2g __attribute__((ext_vector_type(2)));
    constexpr float GEPS = EPS * (F8_QKV * F8_QKV * F8_QKV) * (F8_QKV * F8_QKV * F8_QKV);
    const float* GA = (const float*)(ws + WS_GA); float* SLOC = (float*)(ws + WS_STATE); float* GDEC = (float*)(ws + WS_DECAY); unsigned char* GO = ws + WS_GLAO;
    const float* wa2 = F.in(I_WA2) + (size_t)l * GRANK * 256; const float* ba = F.in(I_BA) + l * 256; const float* gn = F.in(I_GNORM) + l * 512;
    LAS unsigned char* L0 = F.lds;
    const int tid = F.tid, lane = F.lane, w = F.wave, L = lane & 15, q = lane >> 4;
    for (int ui = 0; ui < 2; ++ui) {
        int unit = ui == 0 ? F.bid : GLA_UNITS / 2 + (F.bid & ~15) + (15 - (F.bid & 15));
        if (F.G != GLA_UNITS / 2) { unit = F.bid + ui * F.G; }
        for (; unit < GLA_UNITS; unit += (F.G != GLA_UNITS / 2) ? 2 * F.G : GLA_UNITS) {
        const int g = unit & 15, h = (unit >> 4) & 3, b = unit >> 6;
        const int dd_ = lane & 7, sg = lane >> 3, d_ = 8 * w + dd_;
        float w2r[GRANK];
#pragma unroll
        for (int r = 0; r < GRANK; ++r) w2r[r] = wa2[r * 256 + h * 64 + d_];
        const float ba_d = ba[h * 64 + d_];
        f32x4 S[4];
#pragma unroll
        for (int t = 0; t < 4; ++t) S[t] = (f32x4){0.f, 0.f, 0.f, 0.f};
        if (OUT) {
            int gp = 0;
#pragma unroll 1
            for (; gp + 2 <= g; gp += 2) { const int up = unit - g + gp; f32x4 dc0[4], dc1[4]; float s0[16], s1[16];
#pragma unroll
                for (int t = 0; t < 4; ++t) { dc0[t] = *(const f32x4*)(GDEC + (size_t)up * 64 + 16 * t + 4 * q); dc1[t] = *(const f32x4*)(GDEC + (size_t)(up + 1) * 64 + 16 * t + 4 * q);
#pragma unroll
                    for (int rg = 0; rg < 4; ++rg) { s0[4 * t + rg] = SLOC[((size_t)up * 64 + 16 * t + 4 * q + rg) * 128 + 16 * w + L]; s1[4 * t + rg] = SLOC[((size_t)(up + 1) * 64 + 16 * t + 4 * q + rg) * 128 + 16 * w + L]; } }
                asm volatile("" ::: "memory");
#pragma unroll
                for (int t = 0; t < 4; ++t)
#pragma unroll
                    for (int rg = 0; rg < 4; ++rg) { S[t][rg] = dc0[t][rg] * S[t][rg] + s0[4 * t + rg]; S[t][rg] = dc1[t][rg] * S[t][rg] + s1[4 * t + rg]; } }
            for (; gp < g; ++gp) { const int up = unit - g + gp;
#pragma unroll
                for (int t = 0; t < 4; ++t) { const f32x4 dc = *(const f32x4*)(GDEC + (size_t)up * 64 + 16 * t + 4 * q);
#pragma unroll
                    for (int rg = 0; rg < 4; ++rg) S[t][rg] = dc[rg] * S[t][rg] + SLOC[((size_t)up * 64 + 16 * t + 4 * q + rg) * 128 + 16 * w + L]; } }
        }
        f32x4 gnv[4];
        if (OUT) {
#pragma unroll
            for (int x = 0; x < 4; ++x) gnv[x] = *(const f32x4*)(gn + h * 128 + 16 * (tid & 7) + 4 * x); }
        float gtot = 0.f;
        const int ip_ = tid >> 4, c4_ = tid & 15, i4_ = tid >> 3, c8_ = tid & 7;
        unsigned ck[8], cq[8], nk[8], nq[8]; u32x2 cga, nga, cv0, cv1, nv0, nv1; u32x4 cg0, ng0, clah, nlah;
        cga = nga = (u32x2){0u, 0u}; clah = nlah = (u32x4){0u, 0u, 0u, 0u}; cg0 = ng0 = (u32x4){0u, 0u, 0u, 0u};
#pragma unroll
        for (int ii = 0; ii < 8; ++ii) { cq[ii] = 0u; nq[ii] = 0u; }
#define GLA_LSYNC() do { asm volatile("s_waitcnt lgkmcnt(0)" ::: "memory"); __builtin_amdgcn_s_barrier(); asm volatile("" ::: "memory"); } while (0)
#define GLA_FETCH(KK, QQ, V0, V1, G0, GAV, LAV, tt) do { \
            _Pragma("unroll") for (int ii = 0; ii < 8; ++ii) KK[ii] = GK[(size_t)((tt) + 8 * sg + ii) * 256 + h * 64 + d_]; \
            V0 = *(const u32x2*)(GV + (size_t)((tt) + 2 * ip_) * 512 + h * 128 + 8 * c4_); V1 = *(const u32x2*)(GV + (size_t)((tt) + 2 * ip_ + 1) * 512 + h * 128 + 8 * c4_); \
            if (!OUT) GAV = *(const u32x2*)(GA + (size_t)(tt) * 16 + 2 * tid); \
            if (OUT) { LAV = *(const u32x4*)((const _Float16*)(ws + WS_LAH) + ((size_t)(((tt) >> 6) * GH + h) * 64 + d_) * 64 + 8 * sg); \
                _Pragma("unroll") for (int ii = 0; ii < 8; ++ii) QQ[ii] = GQ[(size_t)((tt) + 8 * sg + ii) * 256 + h * 64 + d_]; \
                G0 = *(const u32x4*)(GR + (size_t)((tt) + i4_) * 512 + h * 128 + 16 * c8_); } } while (0)
        { const int tt0 = b * SEQ + (g * GLA_GRP) * GCH; GLA_FETCH(ck, cq, cv0, cv1, cg0, cga, clah, tt0); }
        GLA_LSYNC();
        if (!OUT) *(LAS u32x2*)(L0 + GL_GA + 8 * tid) = cga;
        GLA_LSYNC();
#pragma unroll 1
        for (int c = 0; c < GLA_GRP; ++c) {
            const int t0 = b * SEQ + (g * GLA_GRP + c) * GCH;
            { const int cn = c + 1 < GLA_GRP ? c + 1 : c; const int tn = b * SEQ + (g * GLA_GRP + cn) * GCH; GLA_FETCH(nk, nq, nv0, nv1, ng0, nga, nlah, tn); }
            { float p[8]; float run = 0.f; typedef _Float16 h8 __attribute__((ext_vector_type(8)));
              if (!OUT) { h8 hv;
#pragma unroll
                for (int ii = 0; ii < 8; ++ii) { const LAS f32x4* ar = (const LAS f32x4*)(L0 + GL_GA + (8 * sg + ii) * 64); float u = ba_d;
#pragma unroll
                    for (int r4 = 0; r4 < 4; ++r4) { const f32x4 av = ar[r4]; u += av[0] * w2r[4 * r4] + av[1] * w2r[4 * r4 + 1] + av[2] * w2r[4 * r4 + 2] + av[3] * w2r[4 * r4 + 3]; }
                    const float ls = -__logf(1.f + __expf(-fmaxf(u, -80.f)));
                    const _Float16 lh = (_Float16)(ls * (1.f / 16.f)); hv[ii] = lh; run += (float)lh; p[ii] = run; }
                *(h8*)((_Float16*)(ws + WS_LAH) + ((size_t)(((b * NCH + g * GLA_GRP + c) * GH + h) * 64 + d_)) * 64 + 8 * sg) = hv;
              } else { const h8 hv = __builtin_bit_cast(h8, clah);
#pragma unroll
                for (int ii = 0; ii < 8; ++ii) { run += (float)hv[ii]; p[ii] = run; } }
              float x = run;
#pragma unroll
              for (int o = 1; o < 8; o <<= 1) { const float t = __int_as_float(__builtin_amdgcn_ds_bpermute(((lane - 8 * o) & 63) << 2, __float_as_int(x))); if (sg >= o) x += t; }
              const float off = x - run;
              const float bend = __int_as_float(__builtin_amdgcn_ds_bpermute((56 + dd_) << 2, __float_as_int(x)));
              if (sg == 7) *(LAS float*)(L0 + GL_DEC + d_ * 4) = __expf(bend);
              gtot += bend;
              float ke[8];
#pragma unroll
              for (int ii = 0; ii < 8; ++ii) { const float bb = off + p[ii], kf = __builtin_amdgcn_cvt_f32_fp8((int)ck[ii], 0); ke[ii] = kf * __expf(bend - bb);
                  if (OUT) { const float e = __expf(bb); const unsigned pq = pk2(__builtin_amdgcn_cvt_f32_fp8((int)cq[ii], 0) * e, kf * __builtin_amdgcn_rcpf(e));
                      *(LAS bf16*)(L0 + GL_QD + (8 * sg + ii) * GL_P + 2 * d_) = (bf16)(pq & 0xffffu); *(LAS bf16*)(L0 + GL_KI + (8 * sg + ii) * GL_P + 2 * d_) = (bf16)(pq >> 16); } }
              u32x4 kw; kw.x = pk2(ke[0], ke[1]); kw.y = pk2(ke[2], ke[3]); kw.z = pk2(ke[4], ke[5]); kw.w = pk2(ke[6], ke[7]);
              *(LAS u32x4*)(L0 + GL_KET + d_ * GL_P + 16 * sg) = kw; }
            { const int ip = ip_, c4 = c4_; const u32x2 v0 = cv0, v1 = cv1;
#pragma unroll
              for (int x = 0; x < 4; ++x) { const int w0 = (int)((x >> 1) ? v0.y : v0.x), w1 = (int)((x >> 1) ? v1.y : v1.x);
                  const f32x2g e0 = (x & 1) ? __builtin_amdgcn_cvt_pk_f32_fp8(w0, true) : __builtin_amdgcn_cvt_pk_f32_fp8(w0, false), e1 = (x & 1) ? __builtin_amdgcn_cvt_pk_f32_fp8(w1, true) : __builtin_amdgcn_cvt_pk_f32_fp8(w1, false);
                  *(LAS unsigned*)(L0 + GL_VT + (8 * c4 + 2 * x) * GL_P + 4 * ip) = pk2(e0.x, e1.x);
                  *(LAS unsigned*)(L0 + GL_VT + (8 * c4 + 2 * x + 1) * GL_P + 4 * ip) = pk2(e0.y, e1.y); } }
            GLA_LSYNC();
            f32x4 ao[4];
            if (OUT) {
#pragma unroll
                for (int tt = 0; tt < 2; ++tt) { const int idx = w + 8 * tt, it = idx >> 2, jt = idx & 3; f32x4 a4 = (f32x4){0.f, 0.f, 0.f, 0.f};
#pragma unroll
                    for (int s2 = 0; s2 < 2; ++s2) { const pg::bf16x8 ka = *(const LAS pg::bf16x8*)(L0 + GL_KI + (16 * jt + L) * GL_P + (32 * s2 + 8 * q) * 2), qb = *(const LAS pg::bf16x8*)(L0 + GL_QD + (16 * it + L) * GL_P + (32 * s2 + 8 * q) * 2);
                        a4 = __builtin_amdgcn_mfma_f32_16x16x32_bf16(ka, qb, a4, 0, 0, 0); }
                    const int i = 16 * it + L, j0 = 16 * jt + 4 * q;
                    u32x2 o; o.x = pk2(j0 + 0 <= i ? a4[0] : 0.f, j0 + 1 <= i ? a4[1] : 0.f); o.y = pk2(j0 + 2 <= i ? a4[2] : 0.f, j0 + 3 <= i ? a4[3] : 0.f);
                    *(LAS u32x2*)(L0 + GL_ATT + i * GL_P + j0 * 2) = o; }
                GLA_LSYNC();
#pragma unroll
                for (int it = 0; it < 4; ++it) ao[it] = (f32x4){0.f, 0.f, 0.f, 0.f};
#pragma unroll
                for (int s2 = 0; s2 < 2; ++s2) { u32x4 sb; sb.x = pk2(S[2 * s2][0], S[2 * s2][1]); sb.y = pk2(S[2 * s2][2], S[2 * s2][3]); sb.z = pk2(S[2 * s2 + 1][0], S[2 * s2 + 1][1]); sb.w = pk2(S[2 * s2 + 1][2], S[2 * s2 + 1][3]);
                    const pg::bf16x8 bS = __builtin_bit_cast(pg::bf16x8, sb);
#pragma unroll
                    for (int it = 0; it < 4; ++it) { const u32x2 x0 = *(const LAS u32x2*)(L0 + GL_QD + (16 * it + L) * GL_P + (32 * s2 + 4 * q) * 2), x1 = *(const LAS u32x2*)(L0 + GL_QD + (16 * it + L) * GL_P + (32 * s2 + 16 + 4 * q) * 2);
                        u32x4 xa; xa.x = x0.x; xa.y = x0.y; xa.z = x1.x; xa.w = x1.y;
                        ao[it] = __builtin_amdgcn_mfma_f32_16x16x32_bf16(__builtin_bit_cast(pg::bf16x8, xa), bS, ao[it], 0, 0, 0); } }
            }
#pragma unroll
            for (int t = 0; t < 4; ++t) { const f32x4 dc = *(LAS f32x4*)(L0 + GL_DEC + (16 * t + 4 * q) * 4); S[t] = S[t] * dc; }
#pragma unroll
            for (int s2 = 0; s2 < 2; ++s2) { const pg::bf16x8 bV = *(const LAS pg::bf16x8*)(L0 + GL_VT + (16 * w + L) * GL_P + (32 * s2 + 8 * q) * 2);
                if (OUT) {
#pragma unroll
                    for (int it = 0; it < 4; ++it) { const pg::bf16x8 aa = *(const LAS pg::bf16x8*)(L0 + GL_ATT + (16 * it + L) * GL_P + (32 * s2 + 8 * q) * 2);
                        ao[it] = __builtin_amdgcn_mfma_f32_16x16x32_bf16(aa, bV, ao[it], 0, 0, 0); } }
#pragma unroll
                for (int t = 0; t < 4; ++t) { const pg::bf16x8 ka = *(const LAS pg::bf16x8*)(L0 + GL_KET + (16 * t + L) * GL_P + (32 * s2 + 8 * q) * 2);
                    S[t] = __builtin_amdgcn_mfma_f32_16x16x32_bf16(ka, bV, S[t], 0, 0, 0); } }
            if (OUT) {
#pragma unroll
                for (int it = 0; it < 4; ++it)
#pragma unroll
                    for (int rg = 0; rg < 4; ++rg) *(LAS float*)(L0 + GL_OB + ((16 * it + 4 * q + rg) * 132 + 16 * w + L) * 4) = ao[it][rg];
                GLA_LSYNC();
                { const int i = tid >> 3, c8 = tid & 7; f32x4 ov[4]; float ss = 0.f;
#pragma unroll
                  for (int x = 0; x < 4; ++x) { ov[x] = *(LAS f32x4*)(L0 + GL_OB + (i * 132 + 16 * c8 + 4 * x) * 4); ss += (ov[x][0] * ov[x][0] + ov[x][1] * ov[x][1]) + (ov[x][2] * ov[x][2] + ov[x][3] * ov[x][3]); }
                  ss += shx(ss, 1, lane); ss += shx(ss, 2, lane); ss += shx(ss, 4, lane);
                  const float rstd = 1.0f / sqrtf(ss * (1.f / 128.f) + GEPS);
                  const size_t go = (size_t)(t0 + i) * 512 + h * 128 + 16 * c8; const float rs8 = rstd * (F8_AO / F8_QKV); u32x4 o8;
#pragma unroll
                  for (int hh = 0; hh < 2; ++hh) { const int r0w = (int)(hh ? cg0.z : cg0.x), r1w = (int)(hh ? cg0.w : cg0.y); const f32x4 g0 = gnv[2 * hh], g1 = gnv[2 * hh + 1];
                      const f32x4 a = ov[2 * hh], bq = ov[2 * hh + 1];
                      const f32x2g ra = __builtin_amdgcn_cvt_pk_f32_fp8(r0w, false), rb = __builtin_amdgcn_cvt_pk_f32_fp8(r0w, true), rc = __builtin_amdgcn_cvt_pk_f32_fp8(r1w, false), rd = __builtin_amdgcn_cvt_pk_f32_fp8(r1w, true);
                      const unsigned lo = pk_fp8x4(a[0] * rs8 * g0[0] * ra.x, a[1] * rs8 * g0[1] * ra.y, a[2] * rs8 * g0[2] * rb.x, a[3] * rs8 * g0[3] * rb.y);
                      const unsigned hi = pk_fp8x4(bq[0] * rs8 * g1[0] * rc.x, bq[1] * rs8 * g1[1] * rc.y, bq[2] * rs8 * g1[2] * rd.x, bq[3] * rs8 * g1[3] * rd.y);
                      if (hh == 0) { o8.x = lo; o8.y = hi; } else { o8.z = lo; o8.w = hi; } }
                  *(u32x4*)(GO + go) = o8; }
            }
            if (!OUT) { *(LAS u32x2*)(L0 + GL_GA + 8 * tid) = nga; GLA_LSYNC(); }
            cv0 = nv0; cv1 = nv1; cg0 = ng0; cga = nga; clah = nlah;
#pragma unroll
            for (int ii = 0; ii < 8; ++ii) { ck[ii] = nk[ii]; cq[ii] = nq[ii]; }
        }
        if (!OUT) {
#pragma unroll
            for (int t = 0; t < 4; ++t)
#pragma unroll
                for (int rg = 0; rg < 4; ++rg) SLOC[((size_t)unit * 64 + 16 * t + 4 * q + rg) * 128 + 16 * w + L] = S[t][rg];
            if (sg == 0) GDEC[(size_t)unit * 64 + d_] = __expf(gtot);
        }
        }
    }
}


__device__ __forceinline__ void ph_mod(const Frame& F) {
    LAS float* cond = (LAS float*)F.lds;
    LAS float* part = cond + BATCH * D;
    for (int i = F.tid; i < BATCH * D; i += NTHREADS) cond[i] = siluf_(F.in(I_C)[i]);
    __syncthreads();
    float* mod = (float*)(F.ws() + WS_MOD);
    for (int item = F.bid; item < DEPTH * 96; item += F.G) {
        const int l = item / 96, j = (item % 96) * 64 + F.lane, k0 = F.wave * 128;
        float acc[BATCH];
#pragma unroll
        for (int b = 0; b < BATCH; ++b) acc[b] = 0.f;
        const float* w = F.in(I_WADA) + ((size_t)l * D + k0) * 6 * D + j;
#pragma unroll 8
        for (int k = 0; k < 128; ++k) { const float wv = w[(size_t)k * 6 * D];
#pragma unroll
            for (int b = 0; b < BATCH; ++b) acc[b] += cond[b * D + k0 + k] * wv; }
#pragma unroll
        for (int b = 0; b < BATCH; ++b) part[(F.wave * BATCH + b) * 64 + F.lane] = acc[b];
        __syncthreads();
        { const int b = F.wave; float sum = F.in(I_BADA)[l * 6 * D + j];
#pragma unroll
          for (int ww = 0; ww < NWAVES; ++ww) sum += part[(ww * BATCH + b) * 64 + F.lane];
          mod[(size_t)(l * BATCH + b) * 6 * D + j] = sum; }
        __syncthreads();
    }
}

constexpr int RT_CNT = 68608;
constexpr int AL_TILE = 8 * 1040, AL_WOFF = 8 * AL_TILE;
template <bool ROUTE, bool COMBINE, bool NORM, bool XBF, int XOUT>
__device__ __forceinline__ void ph_rows(const Frame& F, int l, int lc, const float* gain, int ch_sh, int ch_sc) {
    const float* xin = F.in(I_X); bf16* XB = (bf16*)(F.ws() + WS_XB);
    bf16* H = (bf16*)(F.ws() + WS_H);
    const unsigned char* YS = F.ws() + WS_YS; float* xo = F.out();
    LAS unsigned char* alt = F.lds + F.wave * AL_TILE; LAS unsigned char* alw = F.lds + AL_WOFF;
    if (NORM && !ROUTE) {
        const unsigned char* wsrc = F.ws() + WS_WGU_T + (size_t)l * NE * 1024 * D * 2 + 16 * MiB + (size_t)4352 * D;
        { const int row = F.tid >> 5, ch = F.tid & 31; const u32x4 a0 = *(const u32x4*)(wsrc + (size_t)row * D + 32 * ch), a1 = *(const u32x4*)(wsrc + (size_t)row * D + 32 * ch + 16);
          *(LAS u32x4*)(alw + row * 1040 + 32 * ch) = a0; *(LAS u32x4*)(alw + row * 1040 + 32 * ch + 16) = a1; }
        __syncthreads();
    }
    if (COMBINE) moe_table(F, lc);
    const int lane = F.lane;
    const int NGW = F.G * NWAVES;
    if (ROUTE) {
        const bf16* WRT = (const bf16*)(F.ws() + WS_WRT);
        for (int i = F.tid; i < 2 * NE * (D / 8); i += NTHREADS) { const int row = i >> 7, c = i & 127; *(LAS u32x4*)(F.lds + row * 2064 + c * 16) = *(const u32x4*)(WRT + (size_t)row * D + c * 8); }
        if (F.tid < 32) *(LAS unsigned*)(F.lds + RT_CNT + 4 * F.tid) = 0u;
        __syncthreads();
    }
    for (int blk = F.bid * NWAVES + F.wave; blk < T / 32; blk += NGW) {
        const int m0 = blk * 32, b = m0 / SEQ;
        f32x4 ga[4], sh4[4], g2v[4];
#pragma unroll
        for (int j = 0; j < 4; ++j) { const int col = 4 * lane + 256 * j;
            if (NORM) { const f32x4 g = *(const f32x4*)(gain + col), s4 = *(const f32x4*)(mod_ptr(F, l, b, ch_sc) + col); ga[j] = g * (s4 + 1.f); sh4[j] = *(const f32x4*)(mod_ptr(F, l, b, ch_sh) + col); }
            if (COMBINE) g2v[j] = *(const f32x4*)(mod_ptr(F, lc, b, 5) + col); }
        u32x4 tinfo = (u32x4){0u, 0u, 0u, 0u};
        if (COMBINE) tinfo = *(const u32x4*)(F.ws() + WS_TINFO + (size_t)(m0 + (lane & 31)) * 16);
        constexpr int R = COMBINE ? 2 : 4;
        f32x4 v[R][4], vn[R][4]; unsigned ya[R][4], yc[R][4], yan[R][4], ycn[R][4]; float w0c[R], w1c[R], w0n[R], w1n[R];
#define ROWS_FETCH(V, YA, YC, W0, W1, rbase) do { \
            _Pragma("unroll") for (int rr = 0; rr < R; ++rr) _Pragma("unroll") for (int j = 0; j < 4; ++j) { const size_t xo_ = (size_t)(m0 + (rbase) + rr) * D + 4 * lane + 256 * j; \
                if (XBF) { const unsigned long long xw = __builtin_nontemporal_load((const unsigned long long*)(XB + xo_)); V[rr][j] = (f32x4){bf2f((unsigned)xw & 0xffffu), bf2f(((unsigned)xw) >> 16), bf2f((unsigned)(xw >> 32) & 0xffffu), bf2f((unsigned)(xw >> 48))}; } \
                else V[rr][j] = __builtin_nontemporal_load((const f32x4*)(xin + xo_)); } \
            if (COMBINE) { _Pragma("unroll") for (int rr = 0; rr < R; ++rr) { \
                const unsigned tx = __builtin_amdgcn_readlane(tinfo.x, (rbase) + rr), ty = __builtin_amdgcn_readlane(tinfo.y, (rbase) + rr); \
                W0[rr] = __uint_as_float(__builtin_amdgcn_readlane(tinfo.z, (rbase) + rr)) * (1.f / F8_Y); W1[rr] = __uint_as_float(__builtin_amdgcn_readlane(tinfo.w, (rbase) + rr)) * (1.f / F8_Y); \
                volatile LAS int* tb = (volatile LAS int*)(F.lds + MOE_TAB); \
                const size_t s0 = (size_t)(256 * tb[tx >> 16] + (int)(tx & 0xffffu)) * D, s1 = (size_t)(256 * tb[ty >> 16] + (int)(ty & 0xffffu)) * D; \
                _Pragma("unroll") for (int j = 0; j < 4; ++j) { YA[rr][j] = __builtin_nontemporal_load((const unsigned*)(YS + s0 + 4 * lane + 256 * j)); YC[rr][j] = __builtin_nontemporal_load((const unsigned*)(YS + s1 + 4 * lane + 256 * j)); } } } } while (0)
        ROWS_FETCH(v, ya, yc, w0c, w1c, 0);
#pragma unroll 1
        for (int r0 = 0; r0 < 32; r0 += R) {
            { const int rn = r0 + R < 32 ? r0 + R : r0; ROWS_FETCH(vn, yan, ycn, w0n, w1n, rn); }
            if (COMBINE) {
#pragma unroll
                for (int rr = 0; rr < R; ++rr) { const float w0 = w0c[rr], w1 = w1c[rr];
#pragma unroll
                    for (int j = 0; j < 4; ++j) { const size_t o = (size_t)(m0 + r0 + rr) * D + 4 * lane + 256 * j; typedef float f32x2_ __attribute__((ext_vector_type(2)));
                        const f32x2_ a01 = __builtin_amdgcn_cvt_pk_f32_fp8((int)ya[rr][j], false), a23 = __builtin_amdgcn_cvt_pk_f32_fp8((int)ya[rr][j], true), c01 = __builtin_amdgcn_cvt_pk_f32_fp8((int)yc[rr][j], false), c23 = __builtin_amdgcn_cvt_pk_f32_fp8((int)yc[rr][j], true);
                        v[rr][j].x += g2v[j].x * (w0 * a01.x + w1 * c01.x); v[rr][j].y += g2v[j].y * (w0 * a01.y + w1 * c01.y);
                        v[rr][j].z += g2v[j].z * (w0 * a23.x + w1 * c23.x); v[rr][j].w += g2v[j].w * (w0 * a23.y + w1 * c23.y);
                        if (XOUT == 2) __builtin_nontemporal_store(v[rr][j], (f32x4*)(xo + o));
                        if (XOUT == 1) __builtin_nontemporal_store((unsigned long long)pk2(v[rr][j].x, v[rr][j].y) | ((unsigned long long)pk2(v[rr][j].z, v[rr][j].w) << 32), (unsigned long long*)(XB + o)); } }
            }
            if (NORM) {
                float ss[R];
#pragma unroll
                for (int rr = 0; rr < R; ++rr) { float s = 0.f;
#pragma unroll
                    for (int j = 0; j < 4; ++j) s += (v[rr][j].x * v[rr][j].x + v[rr][j].y * v[rr][j].y) + (v[rr][j].z * v[rr][j].z + v[rr][j].w * v[rr][j].w);
                    ss[rr] = s; }
#pragma unroll
                for (int o = 1; o < 64; o <<= 1) {
#pragma unroll
                    for (int rr = 0; rr < R; ++rr) ss[rr] += shx(ss[rr], o, lane); }
#pragma unroll
                for (int rr = 0; rr < R; ++rr) { const float rstd = 1.0f / sqrtf(ss[rr] * (1.f / D) + EPS);
#pragma unroll
                    for (int j = 0; j < 4; ++j) { v[rr][j] = v[rr][j] * rstd * ga[j] + sh4[j];
                        if (!ROUTE) { const unsigned pk8 = pk_fp8x4(F8_H * v[rr][j].x, F8_H * v[rr][j].y, F8_H * v[rr][j].z, F8_H * v[rr][j].w);
                            *(unsigned*)(F.ws() + WS_H8N + (size_t)(m0 + r0 + rr) * D + 4 * lane + 256 * j) = pk8;
                            *(LAS unsigned*)(alt + ((r0 + rr) & 7) * 1040 + 4 * lane + 256 * j) = pk8; }
                        if (ROUTE && ((MK_FP8_MOE >> l) & 1u)) *(unsigned*)(F.ws() + WS_H8 + (size_t)(m0 + r0 + rr) * D + 4 * lane + 256 * j) = pk_fp8x4(F8_H * v[rr][j].x, F8_H * v[rr][j].y, F8_H * v[rr][j].z, F8_H * v[rr][j].w); } }
                if (!ROUTE && ((r0 + R) & 7) == 0) {
                    asm volatile("s_waitcnt lgkmcnt(0)" ::: "memory");
                    const int fr_ = lane & 15, fq_ = lane >> 4; f32x4 ac = (f32x4){0.f, 0.f, 0.f, 0.f};
#pragma unroll
                    for (int s8 = 0; s8 < 8; ++s8) { const int ko = 128 * s8 + 32 * fq_;
                        const pg::i32x4 h0 = *(const LAS pg::i32x4*)(alt + fr_ * 1040 + ko), h1 = *(const LAS pg::i32x4*)(alt + fr_ * 1040 + ko + 16), w0_ = *(const LAS pg::i32x4*)(alw + fr_ * 1040 + ko), w1_ = *(const LAS pg::i32x4*)(alw + fr_ * 1040 + ko + 16);
                        ac = __builtin_amdgcn_mfma_scale_f32_16x16x128_f8f6f4(__builtin_shufflevector(w0_, w1_, 0, 1, 2, 3, 4, 5, 6, 7), __builtin_shufflevector(h0, h1, 0, 1, 2, 3, 4, 5, 6, 7), ac, 0, 0, 0, 0, 0, 0); }
                    if (fr_ < 8) *(f32x4*)((float*)(F.ws() + WS_GA) + (size_t)(m0 + r0 + R - 8 + fr_) * 16 + 4 * fq_) = ac * (1.f / (F8_H * F8_WGU));
                    asm volatile("s_waitcnt lgkmcnt(0)" ::: "memory");
                }
            }
#pragma unroll
            for (int rr = 0; rr < R; ++rr) { w0c[rr] = w0n[rr]; w1c[rr] = w1n[rr];
#pragma unroll
                for (int j = 0; j < 4; ++j) { v[rr][j] = vn[rr][j]; ya[rr][j] = yan[rr][j]; yc[rr][j] = ycn[rr][j]; } }
        }
#undef ROWS_FETCH
        if (ROUTE) {
            asm volatile("s_waitcnt vmcnt(0)" ::: "memory");
            const int rr_ = lane & 15, kq = lane >> 4;
            int re1[2], re2[2]; unsigned rp1[2] = {0u, 0u}, rp2[2] = {0u, 0u}; float rw1[2], rw2[2];
#pragma unroll
            for (int grp = 0; grp < 2; ++grp) {
                const int m = m0 + 16 * grp + rr_;
                f32x4 acc = (f32x4){0.f, 0.f, 0.f, 0.f};
#pragma unroll 1
                for (int hf = 0; hf < 2; ++hf) {
                    pg::bf16x8 hb[16];
#pragma unroll
                    for (int i = 0; i < 16; ++i) hb[i] = *(const pg::bf16x8*)(H + (size_t)m * D + 32 * (16 * hf + i) + 8 * kq);
#pragma unroll
                    for (int i = 0; i < 16; ++i) { const int co = (32 * (16 * hf + i) + 8 * kq) * 2;
                        const pg::bf16x8 wh = *(const LAS pg::bf16x8*)(F.lds + rr_ * 2064 + co), wlo = *(const LAS pg::bf16x8*)(F.lds + (NE + rr_) * 2064 + co);
                        acc = __builtin_amdgcn_mfma_f32_16x16x32_bf16(wh, hb[i], acc, 0, 0, 0);
                        acc = __builtin_amdgcn_mfma_f32_16x16x32_bf16(wlo, hb[i], acc, 0, 0, 0); }
                }
                float lgt[NE];
#pragma unroll
                for (int k2 = 0; k2 < 4; ++k2)
#pragma unroll
                    for (int rg = 0; rg < 4; ++rg) { const float av = rg == 0 ? acc.x : rg == 1 ? acc.y : rg == 2 ? acc.z : acc.w;
                        lgt[4 * k2 + rg] = __int_as_float(__builtin_amdgcn_ds_bpermute((rr_ + 16 * k2) << 2, __float_as_int(av))); }
                float aff[NE], sel[NE];
#pragma unroll
                for (int e = 0; e < NE; ++e) { aff[e] = sigmoidf_(lgt[e]); sel[e] = aff[e] + F.in(I_BR)[e]; }
                float best = 0.f; int bg = 0; float s0 = 0.f, s1 = 0.f, s2 = 0.f, s3 = 0.f, a0 = 0.f, a1 = 0.f, a2 = 0.f, a3 = 0.f;
#pragma unroll
                for (int g = 0; g < 4; ++g) {
                    const float x0 = sel[4 * g], x1 = sel[4 * g + 1], x2 = sel[4 * g + 2], x3 = sel[4 * g + 3];
                    const float lo01 = fminf(x0, x1), hi01 = fmaxf(x0, x1), lo23 = fminf(x2, x3), hi23 = fmaxf(x2, x3);
                    const float sc_ = fmaxf(hi01, hi23) + fmaxf(fminf(hi01, hi23), fmaxf(lo01, lo23));
                    if (g == 0 || sc_ > best) { best = sc_; bg = g; s0 = x0; s1 = x1; s2 = x2; s3 = x3; a0 = aff[4 * g]; a1 = aff[4 * g + 1]; a2 = aff[4 * g + 2]; a3 = aff[4 * g + 3]; }
                }
                int i1 = 0; float m1 = s0; if (s1 > m1) { m1 = s1; i1 = 1; } if (s2 > m1) { m1 = s2; i1 = 2; } if (s3 > m1) { m1 = s3; i1 = 3; }
                int i2 = -1; float m2 = 0.f;
                if (i1 != 0) { m2 = s0; i2 = 0; }
                if (i1 != 1 && (i2 < 0 || s1 > m2)) { m2 = s1; i2 = 1; }
                if (i1 != 2 && (i2 < 0 || s2 > m2)) { m2 = s2; i2 = 2; }
                if (i1 != 3 && (i2 < 0 || s3 > m2)) { m2 = s3; i2 = 3; }
                const float w1 = i1 == 0 ? a0 : i1 == 1 ? a1 : i1 == 2 ? a2 : a3;
                const float w2 = i2 == 0 ? a0 : i2 == 1 ? a1 : i2 == 2 ? a2 : a3;
                const float inv = 1.f / (w1 + w2);
                re1[grp] = bg * 4 + i1; re2[grp] = bg * 4 + i2; rw1[grp] = w1 * inv; rw2[grp] = w2 * inv;
                if (kq == 0) { rp1[grp] = __hip_atomic_fetch_add((LAS unsigned*)(F.lds + RT_CNT) + re1[grp], 1u, __ATOMIC_RELAXED, __HIP_MEMORY_SCOPE_WORKGROUP);
                               rp2[grp] = __hip_atomic_fetch_add((LAS unsigned*)(F.lds + RT_CNT) + re2[grp], 1u, __ATOMIC_RELAXED, __HIP_MEMORY_SCOPE_WORKGROUP); }
            }
            __syncthreads();
            if (F.tid < NE) { unsigned* cnt = (unsigned*)(F.ws() + WS_CTL) + CW_CNT + 64 * (NE * l); const unsigned c = *(LAS unsigned*)(F.lds + RT_CNT + 4 * F.tid);
                *(LAS unsigned*)(F.lds + RT_CNT + 64 + 4 * F.tid) = c ? atomicAdd(&cnt[64 * F.tid], c) : 0u; }
            __syncthreads();
            if (kq == 0) { int* tokl = (int*)(F.ws() + WS_TOKL);
#pragma unroll
                for (int grp = 0; grp < 2; ++grp) { const int m = m0 + 16 * grp + rr_;
                    const unsigned p1 = *(LAS unsigned*)(F.lds + RT_CNT + 64 + 4 * re1[grp]) + rp1[grp], p2 = *(LAS unsigned*)(F.lds + RT_CNT + 64 + 4 * re2[grp]) + rp2[grp];
                    tokl[(size_t)re1[grp] * ECAP + p1] = m; tokl[(size_t)re2[grp] * ECAP + p2] = m;
                    u32x4 ti; ti.x = ((unsigned)re1[grp] << 16) | p1; ti.y = ((unsigned)re2[grp] << 16) | p2; ti.z = __float_as_uint(rw1[grp]); ti.w = __float_as_uint(rw2[grp]);
                    *(u32x4*)(F.ws() + WS_TINFO + (size_t)m * 16) = ti; } }
        }
    }
}

constexpr int RT_CB = RT_CNT + 128, RT_GA = 69632, RT_SH = RT_GA + 4096, RT_RED = RT_SH + 4096, RT_HST = RT_RED + 2048;
__device__ __forceinline__ void ph_route(const Frame& F, int l, const float* gain) {
    const bf16* XB = (const bf16*)(F.ws() + WS_XB); unsigned char* H8 = F.ws() + WS_H8;
    const int lane = F.lane, NGW = F.G * NWAVES;
    LAS float* GAt = (LAS float*)(F.lds + RT_GA); LAS float* SHt = (LAS float*)(F.lds + RT_SH); LAS float* CBt = (LAS float*)(F.lds + RT_CB); LAS float* RED = (LAS float*)(F.lds + RT_RED);
    int bcur = -1;
    for (int blk = F.bid * NWAVES + F.wave; blk < T / 32; blk += NGW) {
        const int m0 = blk * 32, b = m0 / SEQ;
        if (b != bcur) {
            bcur = b; __syncthreads();
            const float* sc = mod_ptr(F, l, b, 4); const float* shp = mod_ptr(F, l, b, 3); const float* wr = F.in(I_WR);
            if (F.tid < 32) *(LAS unsigned*)(F.lds + RT_CNT + 4 * F.tid) = 0u;
            for (int d = F.tid; d < D; d += NTHREADS) { GAt[d] = F8_H * gain[d] * (1.f + sc[d]); SHt[d] = F8_H * shp[d]; }
            for (int idx = F.tid; idx < NE * D; idx += NTHREADS) { const int k = idx >> 4, e = idx & 15; const float w = wr[idx] * (gain[k] * (1.f + sc[k]));
                const unsigned hi = f2bf(w); *(LAS bf16*)(F.lds + e * 2064 + k * 2) = (bf16)hi; *(LAS bf16*)(F.lds + (NE + e) * 2064 + k * 2) = (bf16)f2bf(w - bf2f(hi)); }
            { const int e = F.tid & 15, part = F.tid >> 4; float a = 0.f;
#pragma unroll 4
              for (int k = 32 * part; k < 32 * part + 32; ++k) a += shp[k] * wr[k * NE + e];
              RED[part * 16 + e] = a; }
            __syncthreads();
            if (F.tid < NE) { float a = 0.f; for (int p = 0; p < 32; ++p) a += RED[p * 16 + F.tid]; CBt[F.tid] = a; }
            __syncthreads();
        }
        const int rr_ = lane & 15, kq = lane >> 4;
        LAS unsigned char* hst = F.lds + RT_HST + F.wave * (16 * 272);
        int reA = 0, reB = 0; unsigned rpA = 0u, rpB = 0u; float rwA0 = 0.f, rwA1 = 0.f, rwB0 = 0.f, rwB1 = 0.f;
        u32x4 xr[32];
#pragma unroll
        for (int i = 0; i < 32; ++i) xr[i] = __builtin_nontemporal_load((const u32x4*)(XB + (size_t)(m0 + rr_) * D + 32 * i + 8 * kq));
        asm volatile("" ::: "memory");
#pragma unroll
        for (int grp = 0; grp < 2; ++grp) {
            const int m = m0 + 16 * grp + rr_;
            float ss = 0.f; f32x4 acc = (f32x4){0.f, 0.f, 0.f, 0.f};
#pragma unroll
            for (int i = 0; i < 32; ++i) { const u32x4 h = xr[i]; const int co = (32 * i + 8 * kq) * 2;
                const float x0 = bf2f(h.x & 0xffffu), x1 = bf2f(h.x >> 16), x2 = bf2f(h.y & 0xffffu), x3 = bf2f(h.y >> 16), x4 = bf2f(h.z & 0xffffu), x5 = bf2f(h.z >> 16), x6 = bf2f(h.w & 0xffffu), x7 = bf2f(h.w >> 16);
                ss += (x0 * x0 + x1 * x1) + (x2 * x2 + x3 * x3) + ((x4 * x4 + x5 * x5) + (x6 * x6 + x7 * x7));
                const pg::bf16x8 wh = *(const LAS pg::bf16x8*)(F.lds + rr_ * 2064 + co), wlo = *(const LAS pg::bf16x8*)(F.lds + (NE + rr_) * 2064 + co), hb = __builtin_bit_cast(pg::bf16x8, h);
                acc = __builtin_amdgcn_mfma_f32_16x16x32_bf16(wh, hb, acc, 0, 0, 0);
                acc = __builtin_amdgcn_mfma_f32_16x16x32_bf16(wlo, hb, acc, 0, 0, 0);
                if ((i & 3) == 3) asm volatile("" ::: "memory"); }
            ss += shx(ss, 16, lane); ss += shx(ss, 32, lane);
            const float rstd = 1.0f / sqrtf(ss * (1.f / D) + EPS);
#pragma unroll
            for (int i = 0; i < 32; ++i) { u32x4 h = xr[i]; const int c0 = 32 * i + 8 * kq;
                asm volatile("" : "+v"(h.x), "+v"(h.y), "+v"(h.z), "+v"(h.w));
                const f32x4 g0 = *(const LAS f32x4*)(GAt + c0), g1 = *(const LAS f32x4*)(GAt + c0 + 4), s0 = *(const LAS f32x4*)(SHt + c0), s1 = *(const LAS f32x4*)(SHt + c0 + 4);
                typedef unsigned u32x2_ __attribute__((ext_vector_type(2)));
                u32x2_ o;
                o.x = pk_fp8x4(bf2f(h.x & 0xffffu) * rstd * g0.x + s0.x, bf2f(h.x >> 16) * rstd * g0.y + s0.y, bf2f(h.y & 0xffffu) * rstd * g0.z + s0.z, bf2f(h.y >> 16) * rstd * g0.w + s0.w);
                o.y = pk_fp8x4(bf2f(h.z & 0xffffu) * rstd * g1.x + s1.x, bf2f(h.z >> 16) * rstd * g1.y + s1.y, bf2f(h.w & 0xffffu) * rstd * g1.z + s1.z, bf2f(h.w >> 16) * rstd * g1.w + s1.w);
                *(LAS u32x2_*)(hst + rr_ * 272 + 32 * (i & 7) + 8 * kq) = o;
                if (grp == 0) xr[i] = __builtin_nontemporal_load((const u32x4*)(XB + (size_t)(m + 16) * D + 32 * i + 8 * kq));
                if ((i & 7) == 7) {
                    asm volatile("s_waitcnt lgkmcnt(0)" ::: "memory");
#pragma unroll
                    for (int k4 = 0; k4 < 4; ++k4) { const int rw = 4 * k4 + (lane >> 4), cb = 16 * (lane & 15);
                        const u32x4 hv = *(const LAS u32x4*)(hst + rw * 272 + cb);
                        *(u32x4*)(H8 + (size_t)(m0 + 16 * grp + rw) * D + 32 * (i - 7) + cb) = hv; }
                    asm volatile("s_waitcnt lgkmcnt(0)" ::: "memory");
                }
                if ((i & 1) == 1) asm volatile("" ::: "memory"); }
            asm volatile("" ::: "memory");
            float lgt[NE];
#pragma unroll
            for (int k2 = 0; k2 < 4; ++k2)
#pragma unroll
                for (int rg = 0; rg < 4; ++rg) { const float av = rg == 0 ? acc.x : rg == 1 ? acc.y : rg == 2 ? acc.z : acc.w;
                    lgt[4 * k2 + rg] = __int_as_float(__builtin_amdgcn_ds_bpermute((rr_ + 16 * k2) << 2, __float_as_int(av))); }
            float aff[NE], sel[NE];
#pragma unroll
            for (int e = 0; e < NE; ++e) { aff[e] = sigmoidf_(lgt[e] * rstd + CBt[e]); sel[e] = aff[e] + F.in(I_BR)[e]; }
            float best = 0.f; int bg = 0; float s0 = 0.f, s1 = 0.f, s2 = 0.f, s3 = 0.f, a0 = 0.f, a1 = 0.f, a2 = 0.f, a3 = 0.f;
#pragma unroll
            for (int g = 0; g < 4; ++g) {
                const float x0 = sel[4 * g], x1 = sel[4 * g + 1], x2 = sel[4 * g + 2], x3 = sel[4 * g + 3];
                const float lo01 = fminf(x0, x1), hi01 = fmaxf(x0, x1), lo23 = fminf(x2, x3), hi23 = fmaxf(x2, x3);
                const float sc_ = fmaxf(hi01, hi23) + fmaxf(fminf(hi01, hi23), fmaxf(lo01, lo23));
                if (g == 0 || sc_ > best) { best = sc_; bg = g; s0 = x0; s1 = x1; s2 = x2; s3 = x3; a0 = aff[4 * g]; a1 = aff[4 * g + 1]; a2 = aff[4 * g + 2]; a3 = aff[4 * g + 3]; }
            }
            int i1 = 0; float m1 = s0; if (s1 > m1) { m1 = s1; i1 = 1; } if (s2 > m1) { m1 = s2; i1 = 2; } if (s3 > m1) { m1 = s3; i1 = 3; }
            int i2 = -1; float m2 = 0.f;
            if (i1 != 0) { m2 = s0; i2 = 0; }
            if (i1 != 1 && (i2 < 0 || s1 > m2)) { m2 = s1; i2 = 1; }
            if (i1 != 2 && (i2 < 0 || s2 > m2)) { m2 = s2; i2 = 2; }
            if (i1 != 3 && (i2 < 0 || s3 > m2)) { m2 = s3; i2 = 3; }
            const float w1 = i1 == 0 ? a0 : i1 == 1 ? a1 : i1 == 2 ? a2 : a3;
            const float w2 = i2 == 0 ? a0 : i2 == 1 ? a1 : i2 == 2 ? a2 : a3;
            const float inv = 1.f / (w1 + w2);
            const int e1 = bg * 4 + i1, e2 = bg * 4 + i2; unsigned q1 = 0u, q2 = 0u;
            if (kq == 0) { q1 = __hip_atomic_fetch_add((LAS unsigned*)(F.lds + RT_CNT) + e1, 1u, __ATOMIC_RELAXED, __HIP_MEMORY_SCOPE_WORKGROUP);
                           q2 = __hip_atomic_fetch_add((LAS unsigned*)(F.lds + RT_CNT) + e2, 1u, __ATOMIC_RELAXED, __HIP_MEMORY_SCOPE_WORKGROUP); }
            if (grp == 0) { reA = e1 | (e2 << 8); rpA = q1 | (q2 << 16); rwA0 = w1 * inv; rwA1 = w2 * inv; } else { reB = e1 | (e2 << 8); rpB = q1 | (q2 << 16); rwB0 = w1 * inv; rwB1 = w2 * inv; }
        }
        __syncthreads();
        if (F.tid < NE) { unsigned* cnt = (unsigned*)(F.ws() + WS_CTL) + CW_CNT + 64 * (NE * l); const unsigned c = *(LAS unsigned*)(F.lds + RT_CNT + 4 * F.tid);
            *(LAS unsigned*)(F.lds + RT_CNT + 64 + 4 * F.tid) = c ? atomicAdd(&cnt[64 * F.tid], c) : 0u; *(LAS unsigned*)(F.lds + RT_CNT + 4 * F.tid) = 0u; }
        __syncthreads();
        if (kq == 0) { int* tokl = (int*)(F.ws() + WS_TOKL);
#pragma unroll
            for (int grp = 0; grp < 2; ++grp) { const int m = m0 + 16 * grp + rr_; const int re = grp ? reB : reA; const unsigned rp = grp ? rpB : rpA; const int e1 = re & 255, e2 = re >> 8;
                const unsigned p1 = *(LAS unsigned*)(F.lds + RT_CNT + 64 + 4 * e1) + (rp & 0xffffu), p2 = *(LAS unsigned*)(F.lds + RT_CNT + 64 + 4 * e2) + (rp >> 16);
                tokl[(size_t)e1 * ECAP + p1] = m; tokl[(size_t)e2 * ECAP + p2] = m;
                u32x4 ti; ti.x = ((unsigned)e1 << 16) | p1; ti.y = ((unsigned)e2 << 16) | p2; ti.z = __float_as_uint(grp ? rwB0 : rwA0); ti.w = __float_as_uint(grp ? rwB1 : rwA1);
                *(u32x4*)(F.ws() + WS_TINFO + (size_t)m * 16) = ti; } }
    }
}

constexpr int NPH_LAYER = 9, NPHASES = 2 + DEPTH * NPH_LAYER;
__global__ void __launch_bounds__(NTHREADS, 2) fwd(Args args) {
    extern __shared__ __attribute__((aligned(16))) unsigned char lds[];
    Frame F;
    F.lds = (LAS unsigned char*)lds; F.tid = threadIdx.x; F.lane = F.tid & 63; F.wave = __builtin_amdgcn_readfirstlane(F.tid >> 6);
    F.G = gridDim.x; F.bid = blockIdx.x;
    volatile LAS unsigned* MISC = (volatile LAS unsigned*)(F.lds + MISC_OFF);
    if (F.tid < 32) MISC[F.tid] = 0u;
    if (F.tid == 0) { volatile LAS unsigned long long* tb = (volatile LAS unsigned long long*)(F.lds + PTR_OFF);
#pragma unroll
        for (int i = 0; i < 22; ++i) tb[i] = (unsigned long long)args.in[i];
        tb[22] = (unsigned long long)args.out; tb[23] = (unsigned long long)args.ws; }
    __syncthreads();
    XcdBarrier bar; bar.bar = (unsigned*)(F.ws() + WS_CTL) + CW_BAR; bar.x = 0; bar.st = nullptr; bar.wave = (unsigned)F.wave;
#if !MK_PER_PHASE
    bar = xcd_barrier_post((unsigned*)(F.ws() + WS_CTL) + CW_BAR, MISC + 8, (unsigned)F.wave);
#endif
    __builtin_amdgcn_s_setreg((23 << 6) | 1, 1);
    const int lo = args.ph_lo, hi = args.ph_hi;
#define IN(k) (lo <= (k) && (k) < hi)
#define SEAM(k) do { if (IN(k) && IN((k) + 1)) xcd_barrier(bar); } while (0)
#define SEAM_ROW(k) do { if (IN(k) && IN((k) + 1)) { if (F.G == T / 256) { asm volatile("s_waitcnt vmcnt(0)" ::: "memory"); __syncthreads(); } else xcd_barrier(bar); } } while (0)
#define REP(k) for (int rep_ = 0; rep_ < (((MK_REPEAT >> (k)) & 1u) ? 2 : 1); ++rep_)
    if (IN(0)) { REP(0) { ph_mod(phase_frame(F)); } REP(1) { ph_weights(phase_frame(F)); ph_rope_table(phase_frame(F)); } } SEAM(0);
    for (int l = 0; l < DEPTH; ++l) {
        const int p0 = 1 + l * NPH_LAYER;
        if (IN(p0 + 0)) { if (l == 0) { REP(2) ph_rows<false, false, true, false, 0>(phase_frame(F), l, 0, F.in(I_NMIX) + l * D, 0, 1); } else ph_rows<false, true, true, true, 1>(phase_frame(F), l, l - 1, F.in(I_NMIX) + l * D, 0, 1); } SEAM(p0 + 0);
        if (IN(p0 + 1)) { ph_gemm1_gates(phase_frame(F), l); } SEAM(p0 + 1);
        if (IN(p0 + 2)) { REP(4) ph_gla_mfma<false>(phase_frame(F), l); REP(5) ph_swa_mfma(phase_frame(F), l); } SEAM(p0 + 2);
        if (IN(p0 + 3)) REP(6) ph_gla_mfma<true>(phase_frame(F), l); SEAM(p0 + 3);
        if (IN(p0 + 4)) REP(7) ph_gemm2_mfma(phase_frame(F), l); SEAM_ROW(p0 + 4);
        if (IN(p0 + 5)) { if (l == 0) { REP(8) ph_gemm3_mfma<false>(phase_frame(F), l); } else ph_gemm3_mfma<true>(phase_frame(F), l); } SEAM_ROW(p0 + 5);
        if (IN(p0 + 6)) { ph_route(phase_frame(F), l, F.in(I_NFFN) + l * D); } SEAM(p0 + 6);
        if (IN(p0 + 7)) { if ((MK_FP8_MOE >> l) & 1u) ph_moe_up_fp8(phase_frame(F), l); else ph_moe_up_mfma(phase_frame(F), l); } SEAM(p0 + 7);
        if (IN(p0 + 8)) { if ((MK_FP8_MOE >> l) & 1u) ph_moe_down_fp8(phase_frame(F), l); else ph_moe_down_mfma(phase_frame(F), l); } SEAM(p0 + 8);
    }
    if (IN(NPHASES - 1)) { ph_rows<false, true, false, true, 2>(phase_frame(F), 0, DEPTH - 1, nullptr, 0, 0); }
#undef REP
#undef IN
#undef SEAM
}

extern "C" void kernel_launch(void* const* d_in, const int* in_sizes, int n_in, void* d_out, int out_size, void* d_ws, size_t ws_size, hipStream_t stream) {
    static int grid = 0;
    if (grid == 0) {
        if (n_in != 22 || in_sizes[0] != T * D || out_size != T * D || ws_size < WS_END) { fprintf(stderr, "kernel_launch: unexpected shapes: n_in %d in0 %d out %d ws %zu (need %zu)\n", n_in, n_in > 0 ? in_sizes[0] : -1, out_size, ws_size, (size_t)WS_END); grid = -1; return; }
        int dev = 0, cus = 0, per_cu = 0;
        if (hipGetDevice(&dev) != hipSuccess || hipDeviceGetAttribute(&cus, hipDeviceAttributeMultiprocessorCount, dev) != hipSuccess) { grid = -1; return; }
        if (hipFuncSetAttribute((const void*)fwd, hipFuncAttributeMaxDynamicSharedMemorySize, LDS_BYTES) != hipSuccess) { fprintf(stderr, "kernel_launch: hipFuncSetAttribute failed\n"); grid = -1; return; }
        if (hipOccupancyMaxActiveBlocksPerMultiprocessor(&per_cu, (const void*)fwd, NTHREADS, LDS_BYTES) != hipSuccess || per_cu < 1) fprintf(stderr, "kernel_launch: occupancy query reports %d\n", per_cu);
        (void)hipGetLastError();
        grid = cus;
    }
    if (grid < 0) return;
    if (hipMemsetAsync((char*)d_ws + WS_CTL, 0, CTL_ZERO_BYTES, stream) != hipSuccess) return;
    Args a{};
    for (int i = 0; i < 22; ++i) a.in[i] = (const float*)d_in[i];
    a.out = (float*)d_out; a.ws = (unsigned char*)d_ws;
#if MK_PER_PHASE
    for (int p = 0; p < NPHASES; ++p) { a.ph_lo = p; a.ph_hi = p + 1; hipLaunchKernelGGL(fwd, dim3(grid), dim3(NTHREADS), LDS_BYTES, stream, a); }
#else
    a.ph_lo = 0; a.ph_hi = NPHASES; hipLaunchKernelGGL(fwd, dim3(grid), dim3(NTHREADS), LDS_BYTES, stream, a);
#endif
}
```
